# Optimizing an MI355X kernel written in HIP

```python
import math
import numpy as np
import jax
import jax.numpy as jnp
from jax import lax

D_MODEL = 2048
BATCH = 4
SEQ = 4096
DEPTH = 2

HEAD_DIM = 64
BLK = 128
ROPE_THETA = 10000.0
PLE_DIM = 256
LN_EPS = 1e-5

NSA_HQ = 8
NSA_HKV = 2
NSA_G = NSA_HQ // NSA_HKV
NSA_CMP_L = 32
NSA_CMP_D = 16
NSA_SEL_L = 64
NSA_TOPN = 16
NSA_WIN = 512
NSA_CMP_HIDDEN = 256
NSA_FORCE = 1e9
SWA_HQ = 8
SWA_HKV = 2
SWA_G = SWA_HQ // SWA_HKV
SWA_WIN = 128
FOX_H = 8
DIFF_H = 8
DIFF_SUB = HEAD_DIM // 2

N_BRANCH = 4
BRANCH_W = 8 * HEAD_DIM

D_FF = 5504
N_EXPERTS = 8
TOP_K = 2
D_FF_EXPERT = 7168
N_DENSE = (DEPTH + 1) // 2
N_MOE = DEPTH // 2

ALPHA = (2.0 * DEPTH) ** 0.25
BETA = (8.0 * DEPTH) ** -0.25

IN_SPLITS = (
    ("a_q", NSA_HQ * HEAD_DIM), ("a_kc", NSA_HKV * HEAD_DIM), ("a_vc", NSA_HKV * HEAD_DIM),
    ("a_ks", NSA_HKV * HEAD_DIM), ("a_vs", NSA_HKV * HEAD_DIM),
    ("a_kw", NSA_HKV * HEAD_DIM), ("a_vw", NSA_HKV * HEAD_DIM), ("a_g", NSA_HQ * 3),
    ("b_q", SWA_HQ * HEAD_DIM), ("b_k", SWA_HKV * HEAD_DIM), ("b_v", SWA_HKV * HEAD_DIM),
    ("c_q", FOX_H * HEAD_DIM), ("c_k", FOX_H * HEAD_DIM), ("c_v", FOX_H * HEAD_DIM), ("c_f", FOX_H),
    ("d_q", DIFF_H * HEAD_DIM), ("d_k", DIFF_H * HEAD_DIM), ("d_v", DIFF_H * HEAD_DIM),
    ("merge_gate", N_BRANCH * D_MODEL),
)
IN_COLS = sum(w for _, w in IN_SPLITS)

kernel_name = "hybrid_nsa_swa_fox_diff_deepnorm_moe"


def split_columns(proj):
    out = {}
    off = 0
    for name, width in IN_SPLITS:
        out[name] = proj[..., off:off + width]
        off += width
    return out


def layer_norm(x, g, b):
    xf = x.astype(jnp.float32)
    mu = jnp.mean(xf, axis=-1, keepdims=True)
    var = jnp.mean(jnp.square(xf - mu), axis=-1, keepdims=True)
    return ((xf - mu) * lax.rsqrt(var + LN_EPS) * g + b).astype(x.dtype)


def rms_norm(x, g):
    xf = x.astype(jnp.float32)
    return (xf * lax.rsqrt(jnp.mean(jnp.square(xf), axis=-1, keepdims=True) + LN_EPS) * g).astype(x.dtype)


def rope_tables(positions, dim):
    inv = 1.0 / (ROPE_THETA ** (jnp.arange(0, dim, 2, dtype=jnp.float32) / dim))
    ang = positions.astype(jnp.float32)[..., None] * inv
    return jnp.cos(ang), jnp.sin(ang)


def apply_rope(x, cos, sin):
    x1, x2 = jnp.split(x, 2, axis=-1)
    c = cos[:, :, None, :].astype(x.dtype)
    s = sin[:, :, None, :].astype(x.dtype)
    return jnp.concatenate([x1 * c - x2 * s, x2 * c + x1 * s], axis=-1)


def banded_attention(q, k, v, window, sinks=None):
    B, S, Hkv, G, D = q.shape
    nb = S // BLK
    npre = window // BLK
    pad = ((0, 0), (npre * BLK, 0), (0, 0), (0, 0))
    kb = jnp.pad(k, pad).reshape(B, nb + npre, BLK, Hkv, D)
    vb = jnp.pad(v, pad).reshape(B, nb + npre, BLK, Hkv, D)
    kband = jnp.concatenate([kb[:, i:i + nb] for i in range(npre + 1)], axis=2)
    vband = jnp.concatenate([vb[:, i:i + nb] for i in range(npre + 1)], axis=2)
    qb = q.reshape(B, nb, BLK, Hkv, G, D)
    s = jnp.einsum('bnqhgd,bnkhd->bnhgqk', qb, kband,
                   preferred_element_type=jnp.float32) * (D ** -0.5)
    nk = (npre + 1) * BLK
    qi = jnp.arange(BLK)[:, None]
    ki = jnp.arange(nk)[None, :]
    diff = npre * BLK + qi - ki
    s_pos = jnp.arange(nb)[:, None, None] * BLK - npre * BLK + ki[None]
    mask = (diff >= 0)[None] & (diff < window)[None] & (s_pos >= 0)
    s = jnp.where(mask[None, :, None, None], s, -jnp.inf)
    if sinks is None:
        p = jax.nn.softmax(s, axis=-1)
    else:
        sk = sinks.astype(jnp.float32)[:, :, None, None]
        m = jnp.maximum(jnp.max(s, axis=-1, keepdims=True), sk)
        e = jnp.exp(s - m)
        p = e / (jnp.sum(e, axis=-1, keepdims=True) + jnp.exp(sk - m))
    o = jnp.einsum('bnhgqk,bnkhd->bnqhgd', p.astype(v.dtype), vband)
    return o.reshape(B, S, Hkv, G, D)


def nsa_compress(x, pe, w1, b1, w2):
    B, S, H, D = x.shape
    n_cmp = (S - NSA_CMP_L) // NSA_CMP_D + 1
    idx = np.arange(n_cmp)[:, None] * NSA_CMP_D + np.arange(NSA_CMP_L)[None, :]
    blocks = x[:, idx] + pe[None, None, :, None, :]
    flat = blocks.transpose(0, 1, 3, 2, 4).reshape(B, n_cmp, H, NSA_CMP_L * D)
    return jax.nn.gelu(flat @ w1 + b1) @ w2


def selection_map(n_cmp, n_sel):
    ci = np.arange(n_cmp)[:, None] * NSA_CMP_D
    sj = np.arange(n_sel)[None, :] * NSA_SEL_L
    ov = np.clip(np.minimum(ci + NSA_CMP_L, sj + NSA_SEL_L) - np.maximum(ci, sj), 0, None)
    return (ov / NSA_CMP_D).astype(np.float32)


def nsa_attention(q, k_c, v_c, k_s, v_s, k_w, v_w, gates):
    B, S, Hkv, G, D = q.shape
    scale = D ** -0.5
    n_cmp = k_c.shape[1]
    n_sel = S // NSA_SEL_L
    topn = min(NSA_TOPN, n_sel)
    t = jnp.arange(S)
    s = jnp.einsum('bthgd,bihd->bhgti', q, k_c, preferred_element_type=jnp.float32) * scale
    cmask = (jnp.arange(n_cmp) * NSA_CMP_D + NSA_CMP_L - 1)[None, :] <= t[:, None]
    p_cmp = jnp.where(cmask, jax.nn.softmax(jnp.where(cmask, s, -1e30), axis=-1), 0.0)
    o_cmp = jnp.einsum('bhgti,bihd->bthgd', p_cmp.astype(v_c.dtype), v_c)
    imp = jnp.einsum('bhgti,ij->bhtj', p_cmp, jnp.asarray(selection_map(n_cmp, n_sel)))
    cur = (t // NSA_SEL_L)[:, None]
    j = jnp.arange(n_sel)[None, :]
    forced = (j == 0) | (j == cur) | (j == cur - 1)
    imp = jnp.where(forced, NSA_FORCE, jnp.where(j > cur, -NSA_FORCE, imp))
    _, sel_idx = lax.top_k(imp, topn)
    kblk = k_s.reshape(B, n_sel, NSA_SEL_L, Hkv, D).transpose(0, 3, 1, 2, 4)
    vblk = v_s.reshape(B, n_sel, NSA_SEL_L, Hkv, D).transpose(0, 3, 1, 2, 4)
    nb = S // BLK
    qb = q.reshape(B, nb, BLK, Hkv, G, D).swapaxes(0, 1)
    ib = sel_idx.reshape(B, Hkv, nb, BLK, topn).transpose(2, 0, 1, 3, 4)
    gather = jax.vmap(jax.vmap(lambda blocks, ix: blocks[ix]))

    def sel_block(args):
        n, qi, ix = args
        kg = gather(kblk, ix)
        vg = gather(vblk, ix)
        sc = jnp.einsum('bqhgd,bhqnld->bhgqnl', qi, kg, preferred_element_type=jnp.float32) * scale
        tq = n * BLK + jnp.arange(BLK)
        kpos = ix[..., None] * NSA_SEL_L + jnp.arange(NSA_SEL_L)
        mask = kpos <= tq[None, None, :, None, None]
        sc = jnp.where(mask[:, :, None], sc, -jnp.inf)
        p = jax.nn.softmax(sc.reshape(B, Hkv, G, BLK, topn * NSA_SEL_L), axis=-1)
        p = p.reshape(B, Hkv, G, BLK, topn, NSA_SEL_L)
        return jnp.einsum('bhgqnl,bhqnld->bqhgd', p.astype(vg.dtype), vg)

    o_slc = lax.map(sel_block, (jnp.arange(nb), qb, ib)).swapaxes(0, 1).reshape(B, S, Hkv, G, D)
    o_win = banded_attention(q, k_w, v_w, NSA_WIN)
    o = gates[..., 0:1] * o_cmp + gates[..., 1:2] * o_slc + gates[..., 2:3] * o_win
    return o.reshape(B, S, Hkv * G * D)


def fox_attention(q, k, v, f_logit):
    B, S, H, D = q.shape
    nb = S // BLK
    cum = jnp.cumsum(jax.nn.log_sigmoid(f_logit.astype(jnp.float32)), axis=1)
    cum_t = cum.transpose(0, 2, 1)
    kpos = jnp.arange(S)
    qb = q.reshape(B, nb, BLK, H, D).swapaxes(0, 1)
    cb = cum_t.reshape(B, H, nb, BLK).transpose(2, 0, 1, 3)

    def block(args):
        n, qi, ci = args
        s = jnp.einsum('bqhd,bkhd->bhqk', qi, k, preferred_element_type=jnp.float32) * (D ** -0.5)
        s = s + (ci[..., :, None] - cum_t[..., None, :])
        mask = kpos[None, :] <= (n * BLK + jnp.arange(BLK))[:, None]
        p = jax.nn.softmax(jnp.where(mask, s, -jnp.inf), axis=-1)
        return jnp.einsum('bhqk,bkhd->bqhd', p.astype(v.dtype), v)

    o = lax.map(block, (jnp.arange(nb), qb, cb))
    return o.swapaxes(0, 1).reshape(B, S, H * D)


def diff_attention(q, k, v, lam, lam_init, gain):
    B, S, H, _, Ds = q.shape
    Dv = v.shape[-1]
    nb = S // BLK
    kpos = jnp.arange(S)
    qb = q.reshape(B, nb, BLK, H, 2, Ds).swapaxes(0, 1)

    def block(args):
        n, qi = args
        s = jnp.einsum('bqhcd,bkhcd->bchqk', qi, k, preferred_element_type=jnp.float32) * (Ds ** -0.5)
        mask = kpos[None, :] <= (n * BLK + jnp.arange(BLK))[:, None]
        p = jax.nn.softmax(jnp.where(mask, s, -jnp.inf), axis=-1)
        a = p[:, 0] - lam * p[:, 1]
        return jnp.einsum('bhqk,bkhd->bqhd', a.astype(v.dtype), v)

    o = lax.map(block, (jnp.arange(nb), qb)).swapaxes(0, 1).reshape(B, S, H, Dv)
    o = rms_norm(o, gain) * (1.0 - lam_init)
    return o.reshape(B, S, H * Dv)


def token_mixer(h, cos, sin, cos_d, sin_d, w_in, cmp_pe, cmp_w1, cmp_b1, cmp_w2,
                sinks, fox_bf, diff_lambda, diff_gain, lam_init, w_branch, w_out):
    B, S, _ = h.shape
    c = split_columns(h @ w_in)

    def heads(t, n):
        return t.reshape(B, S, n, HEAD_DIM)

    qa = apply_rope(heads(c['a_q'], NSA_HQ), cos, sin).reshape(B, S, NSA_HKV, NSA_G, HEAD_DIM)
    kc = nsa_compress(apply_rope(heads(c['a_kc'], NSA_HKV), cos, sin), cmp_pe[0], cmp_w1[0], cmp_b1[0], cmp_w2[0])
    vc = nsa_compress(heads(c['a_vc'], NSA_HKV), cmp_pe[1], cmp_w1[1], cmp_b1[1], cmp_w2[1])
    ks = apply_rope(heads(c['a_ks'], NSA_HKV), cos, sin)
    kw = apply_rope(heads(c['a_kw'], NSA_HKV), cos, sin)
    ga = jax.nn.sigmoid(c['a_g'].reshape(B, S, NSA_HKV, NSA_G, 3))
    o_a = nsa_attention(qa, kc, vc, ks, heads(c['a_vs'], NSA_HKV), kw, heads(c['a_vw'], NSA_HKV), ga)
    qb = apply_rope(heads(c['b_q'], SWA_HQ), cos, sin).reshape(B, S, SWA_HKV, SWA_G, HEAD_DIM)
    kb = apply_rope(heads(c['b_k'], SWA_HKV), cos, sin)
    o_b = banded_attention(qb, kb, heads(c['b_v'], SWA_HKV), SWA_WIN,
                           sinks.reshape(SWA_HKV, SWA_G)).reshape(B, S, SWA_HQ * HEAD_DIM)
    o_c = fox_attention(heads(c['c_q'], FOX_H), heads(c['c_k'], FOX_H), heads(c['c_v'], FOX_H),
                        c['c_f'] + fox_bf)
    qd = apply_rope(c['d_q'].reshape(B, S, DIFF_H * 2, DIFF_SUB), cos_d, sin_d).reshape(B, S, DIFF_H, 2, DIFF_SUB)
    kd = apply_rope(c['d_k'].reshape(B, S, DIFF_H * 2, DIFF_SUB), cos_d, sin_d).reshape(B, S, DIFF_H, 2, DIFF_SUB)
    lf = diff_lambda.astype(jnp.float32)
    lam = jnp.exp(jnp.sum(lf[0] * lf[1])) - jnp.exp(jnp.sum(lf[2] * lf[3])) + lam_init
    o_d = diff_attention(qd, kd, heads(c['d_v'], DIFF_H), lam, lam_init, diff_gain)
    branches = jnp.stack([o_a, o_b, o_c, o_d], axis=2)
    up = jnp.einsum('bsnc,ncd->bsnd', branches, w_branch)
    gates = jax.nn.sigmoid(c['merge_gate'].reshape(B, S, N_BRANCH, D_MODEL))
    merged = jnp.sum(gates * up, axis=2)
    return merged @ w_out


def swiglu(h, wg, wu, wd):
    return (jax.nn.silu(h @ wg) * (h @ wu)) @ wd


def moe_ffn(h, w_router, b_router, wg, wu, wd):
    logits = (h @ w_router).astype(jnp.float32) + b_router.astype(jnp.float32)
    top_v, top_i = lax.top_k(logits, TOP_K)
    top_w = jax.nn.softmax(top_v, axis=-1)
    combine = jnp.sum(jax.nn.one_hot(top_i, N_EXPERTS, dtype=jnp.float32) * top_w[..., None], axis=-2)
    y = jnp.zeros_like(h)
    for e in range(N_EXPERTS):
        y = y + combine[..., e:e + 1].astype(h.dtype) * swiglu(h, wg[e], wu[e], wd[e])
    return y


def _nrm(k, shape, scale):
    return jax.random.normal(k, shape, jnp.float32) * scale


def setup_inputs(seed: int = 0) -> dict:
    key = jax.random.key(seed)
    ks = jax.random.split(key, 32)
    D = D_MODEL
    return {
        "x": _nrm(ks[0], (BATCH, SEQ, D), 1.0),
        "p": _nrm(ks[1], (DEPTH, BATCH, SEQ, PLE_DIM), 1.0),
        "positions": jax.random.randint(ks[2], (BATCH, 1), 0, 1024, dtype=jnp.int32)
                     + jnp.arange(SEQ, dtype=jnp.int32)[None, :],
        "w_in": _nrm(ks[3], (DEPTH, D, IN_COLS), D ** -0.5),
        "nsa_cmp_pe": _nrm(ks[4], (DEPTH, 2, NSA_CMP_L, HEAD_DIM), 0.02),
        "nsa_cmp_w1": _nrm(ks[5], (DEPTH, 2, NSA_CMP_L * HEAD_DIM, NSA_CMP_HIDDEN), (NSA_CMP_L * HEAD_DIM) ** -0.5),
        "nsa_cmp_b1": _nrm(ks[6], (DEPTH, 2, NSA_CMP_HIDDEN), 0.01),
        "nsa_cmp_w2": _nrm(ks[7], (DEPTH, 2, NSA_CMP_HIDDEN, HEAD_DIM), NSA_CMP_HIDDEN ** -0.5),
        "swa_sinks": _nrm(ks[8], (DEPTH, SWA_HQ), 0.5),
        "fox_bf": 3.0 + _nrm(ks[9], (DEPTH, FOX_H), 0.1),
        "diff_lambda": _nrm(ks[10], (DEPTH, 4, DIFF_SUB), 0.1),
        "diff_gain": 1.0 + _nrm(ks[11], (DEPTH, HEAD_DIM), 0.01),
        "w_branch": _nrm(ks[12], (DEPTH, N_BRANCH, BRANCH_W, D), BETA * BRANCH_W ** -0.5),
        "w_out": _nrm(ks[13], (DEPTH, D, D), BETA * D ** -0.5),
        "ln1_g": 1.0 + _nrm(ks[14], (DEPTH, D), 0.01),
        "ln1_b": _nrm(ks[15], (DEPTH, D), 0.01),
        "ffn_wg": _nrm(ks[16], (N_DENSE, D, D_FF), D ** -0.5),
        "ffn_wu": _nrm(ks[17], (N_DENSE, D, D_FF), D ** -0.5),
        "ffn_wd": _nrm(ks[18], (N_DENSE, D_FF, D), BETA * D_FF ** -0.5),
        "moe_router": _nrm(ks[19], (N_MOE, D, N_EXPERTS), D ** -0.5),
        "moe_router_b": _nrm(ks[20], (N_MOE, N_EXPERTS), 0.01),
        "moe_wg": _nrm(ks[21], (N_MOE, N_EXPERTS, D, D_FF_EXPERT), D ** -0.5),
        "moe_wu": _nrm(ks[22], (N_MOE, N_EXPERTS, D, D_FF_EXPERT), D ** -0.5),
        "moe_wd": _nrm(ks[23], (N_MOE, N_EXPERTS, D_FF_EXPERT, D), BETA * D_FF_EXPERT ** -0.5),
        "ple_proj": _nrm(ks[24], (DEPTH, PLE_DIM, D), BETA * PLE_DIM ** -0.5),
        "ple_gate": _nrm(ks[25], (DEPTH, D, D), D ** -0.5),
        "ln2_g": 1.0 + _nrm(ks[26], (DEPTH, D), 0.01),
        "ln2_b": _nrm(ks[27], (DEPTH, D), 0.01),
    }


def reference(x, p, positions, w_in, nsa_cmp_pe, nsa_cmp_w1, nsa_cmp_b1, nsa_cmp_w2,
              swa_sinks, fox_bf, diff_lambda, diff_gain, w_branch, w_out, ln1_g, ln1_b,
              ffn_wg, ffn_wu, ffn_wd, moe_router, moe_router_b, moe_wg, moe_wu, moe_wd,
              ple_proj, ple_gate, ln2_g, ln2_b):
    cos, sin = rope_tables(positions, HEAD_DIM)
    cos_d, sin_d = rope_tables(positions, DIFF_SUB)
    h = x
    for i in range(DEPTH):
        lam_init = 0.8 - 0.6 * math.exp(-0.3 * i)
        mix = token_mixer(h, cos, sin, cos_d, sin_d, w_in[i], nsa_cmp_pe[i], nsa_cmp_w1[i],
                          nsa_cmp_b1[i], nsa_cmp_w2[i], swa_sinks[i], fox_bf[i], diff_lambda[i],
                          diff_gain[i], lam_init, w_branch[i], w_out[i])
        h = layer_norm(ALPHA * h + mix, ln1_g[i], ln1_b[i])
        if i % 2 == 0:
            f = swiglu(h, ffn_wg[i // 2], ffn_wu[i // 2], ffn_wd[i // 2])
        else:
            f = moe_ffn(h, moe_router[i // 2], moe_router_b[i // 2], moe_wg[i // 2], moe_wu[i // 2], moe_wd[i // 2])
        ple = jax.nn.sigmoid(h @ ple_gate[i]) * (p[i] @ ple_proj[i])
        h = layer_norm(ALPHA * h + f + ple, ln2_g[i], ln2_b[i])
    return h
```

```cpp
#include <hip/hip_runtime.h>
#include <cstdio>
#include <cstdint>

#ifndef MK_PER_PHASE
#define MK_PER_PHASE 0
#endif

#define LAS __attribute__((address_space(3)))
#define GAS __attribute__((address_space(1)))
typedef unsigned short bf16_t;
typedef short bf16x8 __attribute__((ext_vector_type(8)));
typedef float f32x2 __attribute__((ext_vector_type(2)));
typedef float f32x4 __attribute__((ext_vector_type(4)));
typedef float f32x16 __attribute__((ext_vector_type(16)));
typedef unsigned u32x2 __attribute__((ext_vector_type(2)));
typedef unsigned u32x4 __attribute__((ext_vector_type(4)));
typedef GAS unsigned gu32;

constexpr int NB = 4, SEQ = 4096, DM = 2048, MTOK = NB * SEQ, NLAYER = 2;
constexpr int INC = 13344;
constexpr int DFF = 5504, NEXP = 8, DFE = 7168, PLE = 256;
constexpr int NA = 13312;
constexpr float ALPHA = 1.41421356237309515f;
constexpr float LN_EPS = 1e-5f;
constexpr float LOG2E = 1.4426950408889634f;
constexpr float QS64 = 0.125f * LOG2E;
constexpr float QS32 = 0.17677669529663687f * LOG2E;
constexpr int MOE_ROWS = 2 * MTOK + NEXP * 256;
constexpr int MOE_PANELS = MOE_ROWS / 256;

constexpr int SRC_AQ = 0, SRC_AKC = 512, SRC_AVC = 640, SRC_AKS = 768, SRC_AVS = 896, SRC_AKW = 1024, SRC_AVW = 1152, SRC_AG = 1280,
              SRC_BQ = 1304, SRC_BK = 1816, SRC_BV = 1944, SRC_CQ = 2072, SRC_CK = 2584, SRC_CV = 3096, SRC_CF = 3608,
              SRC_DQ = 3616, SRC_DK = 4128, SRC_DV = 4640, SRC_MG = 5152;

constexpr size_t al256(size_t x) { return (x + 255) & ~(size_t)255; }
constexpr size_t WS_CTL = 0, CTL_BYTES = 1u << 20;
constexpr size_t SZ_WA = (size_t)NA * DM * 2, SZ_WS = 32 * DM * 2, SZ_WC1 = 256 * 2048 * 2, SZ_WB = (size_t)4 * DM * 512 * 2, SZ_WO = (size_t)DM * DM * 2,
                 SZ_WFGU = (size_t)2 * DFF * DM * 2, SZ_WFD = (size_t)DM * DFF * 2, SZ_WMGU = (size_t)NEXP * 2 * DFE * DM  , SZ_WMD = (size_t)NEXP * DM * DFE  ,
                 SZ_WPG = (size_t)DM * DM * 2, SZ_WPP = (size_t)DM * PLE * 2;
constexpr size_t WS_WA = WS_CTL + CTL_BYTES;
constexpr size_t WS_WS = WS_WA + 2 * SZ_WA;
constexpr size_t WS_WC1 = WS_WS + 2 * SZ_WS;
constexpr size_t WS_CVEC = WS_WC1 + 4 * SZ_WC1;
constexpr size_t WS_WB = WS_CVEC + 4096;
constexpr size_t WS_WO = WS_WB + 2 * SZ_WB;
constexpr size_t WS_WFGU = WS_WO + 2 * SZ_WO;
constexpr size_t WS_WFD = WS_WFGU + SZ_WFGU;
constexpr size_t WS_WMGU = WS_WFD + SZ_WFD;
constexpr size_t WS_WMD = WS_WMGU + SZ_WMGU;
constexpr size_t WS_WPG = WS_WMD + SZ_WMD;
constexpr size_t WS_WPP = WS_WPG + 2 * SZ_WPG;
constexpr size_t WS_WAG8 = WS_WPP + 2 * SZ_WPP;
constexpr size_t SZ_WAG8 = (size_t)8192 * DM;
constexpr size_t WS_HB8 = WS_WAG8 + 2 * SZ_WAG8;
constexpr size_t WS_ROPE64 = WS_HB8 + (size_t)MTOK * DM;
constexpr size_t WS_ROPE32 = WS_ROPE64 + (size_t)MTOK * 64 * 4;
constexpr size_t WS_PB16 = WS_ROPE32 + (size_t)MTOK * 32 * 4;
constexpr size_t WS_GA = WS_PB16 + (size_t)2 * MTOK * PLE * 2;
constexpr size_t WS_CUM = WS_GA + (size_t)MTOK * 32 * 4;
constexpr size_t WS_KC = WS_CUM + (size_t)NB * 8 * SEQ * 4;
constexpr size_t WS_VCT = WS_KC + (size_t)NB * 2 * 256 * 64 * 2;
constexpr size_t WS_ROUTE = WS_VCT + (size_t)NB * 2 * 256 * 64 * 2;
constexpr size_t RT_E = 0, RT_W = (size_t)MTOK * 2 * 4, RT_CNT = RT_W + (size_t)MTOK * 2 * 4, RT_TOKSROW = RT_CNT + 256 * 8 * 4,
                 RT_SROWW = RT_TOKSROW + (size_t)MTOK * 2 * 4, RT_PANEL = RT_SROWW + (size_t)MOE_ROWS * 4, RT_END = RT_PANEL + 1024;
constexpr size_t WS_HF = al256(WS_ROUTE + RT_END);
constexpr size_t WS_HB = WS_HF + (size_t)2 * MTOK * DM * 4;
constexpr size_t WS_R = WS_HB + (size_t)2 * MTOK * DM * 2;
constexpr size_t R_AQ = 0, SZ_Q = (size_t)MTOK * 512 * 2, SZ_K2 = (size_t)MTOK * 128 * 2;
constexpr size_t R_BQ = R_AQ + SZ_Q, R_CQ = R_BQ + SZ_Q, R_DQ = R_CQ + SZ_Q, R_CK = R_DQ + SZ_Q, R_DK = R_CK + SZ_Q;
constexpr size_t R_AKC = R_DK + SZ_Q, R_AKS = R_AKC + SZ_K2, R_AKW = R_AKS + SZ_K2, R_BK = R_AKW + SZ_K2, R_AVC = R_BK + SZ_K2;
constexpr size_t R_AVST = R_AVC + SZ_K2, R_AVWT = R_AVST + SZ_K2, R_BVT = R_AVWT + SZ_K2, R_CVT = R_BVT + SZ_K2, R_DVT = R_CVT + SZ_Q;
constexpr size_t R_QKV_END = R_DVT + SZ_Q;
constexpr size_t R_PART = 0;
static_assert((size_t)MTOK * DM * 4 <= R_QKV_END, "merge partial fits over the qkv set");
constexpr size_t R_GATES = R_QKV_END;
constexpr size_t R_PRE = R_GATES;
constexpr size_t R_BR = R_GATES + (size_t)MTOK * 8192 * 2;
constexpr size_t R_MERGED = R_BR + (size_t)MTOK * DM * 2;
constexpr size_t R_MERGED8 = R_MERGED + (size_t)MTOK * DM * 2;
constexpr size_t R_MIX_END = R_MERGED8 + (size_t)MTOK * DM;
constexpr size_t R_ACT = 0;
constexpr size_t R_PLE = R_ACT + (size_t)MTOK * DFF * 2;
constexpr size_t R_PTMP = R_PLE + (size_t)MTOK * DM * 2;
constexpr size_t R_PRE2 = R_PTMP + (size_t)MTOK * DM * 2;
constexpr size_t R_FFN_END = R_PRE2 + (size_t)MTOK * DM * 4;
constexpr size_t R_HS = 0;
constexpr size_t R_ACTS = R_HS + (size_t)MOE_ROWS * DM;
constexpr size_t R_YS = R_ACTS + (size_t)MOE_ROWS * DFE;
constexpr size_t R_MOE_END = R_YS + (size_t)MOE_ROWS * DM * 2;
#ifndef QKV_FP8
#define QKV_FP8 1
#endif
#ifndef PD_FP8
#define PD_FP8 1
#endif
constexpr float BR8_SCALE = 16.f, WB_SCALE = 32.f;
#ifndef PRE_BF16
#define PRE_BF16 1
#endif
#ifndef RES_BF16
#define RES_BF16 1
#endif
#ifndef PLE0_FP8
#define PLE0_FP8 1
#endif
#ifndef DENSE_DOWN_FP8
#define DENSE_DOWN_FP8 0
#endif
constexpr float WA_SCALE = 32.f;
constexpr int DFF8 = 5632;
constexpr float WFD_SCALE = 128.f;
constexpr float MOE_WGU_SCALE = 32.f, MOE_WD_SCALE = 128.f, GATE_W_SCALE = 32.f, WO_SCALE = 64.f, MERGED8_SCALE = 4.f, PG_SCALE = 32.f;
constexpr size_t R_SIZE = R_MOE_END > R_MIX_END ? (R_MOE_END > R_FFN_END ? R_MOE_END : R_FFN_END) : (R_MIX_END > R_FFN_END ? R_MIX_END : R_FFN_END);
constexpr size_t WS_END = WS_R + R_SIZE;

constexpr int CW_TMO = 0;
constexpr int CW_ATTQ = 64;
constexpr int CW_PBDONE = 1024;
constexpr int CW_BAR = 4096;
constexpr int DEFTAB_OFF = 65536;

constexpr int LDS_BYTES = 147456;
constexpr int RING_BYTES = 131072;
constexpr int MISC_OFF = RING_BYTES + 320;
constexpr int NWAVES = 8, NTHREADS = 512;

typedef __bf16 bf16x2_t __attribute__((ext_vector_type(2)));
__device__ __forceinline__ unsigned cvt_pk_bf16(float lo, float hi) { const f32x2 v = {lo, hi}; const bf16x2_t b = __builtin_convertvector(v, bf16x2_t); return __builtin_bit_cast(unsigned, b); }
__device__ __forceinline__ float bf2f(unsigned short b) { return __uint_as_float((unsigned)b << 16); }
__device__ __forceinline__ float bflo(unsigned w) { return __uint_as_float(w << 16); }
__device__ __forceinline__ float bfhi(unsigned w) { return __uint_as_float(w & 0xffff0000u); }
__device__ __forceinline__ bf16_t f2bf(float f) { return (bf16_t)(cvt_pk_bf16(f, 0.f) & 0xffffu); }
__device__ __forceinline__ float fast_exp2(float x) { return __builtin_amdgcn_exp2f(x); }
__device__ __forceinline__ float fast_rcp(float x) { return __builtin_amdgcn_rcpf(x); }
__device__ __forceinline__ float sigmoidf_(float x) { return fast_rcp(1.f + fast_exp2(-x * LOG2E)); }
__device__ __forceinline__ float wave_sum(float v) {
#pragma unroll
    for (int o = 1; o < 64; o <<= 1) v += __shfl_xor(v, o);
    return v;
}
__device__ __forceinline__ int lane_id() { int l; asm volatile("v_mbcnt_lo_u32_b32 %0, -1, 0\n\tv_mbcnt_hi_u32_b32 %0, -1, %0" : "=v"(l)); return l; }
__device__ __forceinline__ int perm23(int t) { return (t & ~12) | ((t & 4) << 1) | ((t & 8) >> 1); }
#define LDS_WAIT() asm volatile("s_waitcnt lgkmcnt(0)" ::: "memory")
#define VM_WAIT() asm volatile("s_waitcnt vmcnt(0)" ::: "memory")

#define XB_TMO      128
#define XB_XCNT(j)  (256  + 64 * (j))
#define XB_XSUB(j)  (1280 + 64 * (j))
#define XB_XGEN(j)  (2304 + 64 * (j))
#define XB_TOP      3328
#define XB_TOPGEN   3392
#define XCD_BAR_WORDS 3456
#define XB_SPIN_CAP (1u << 18)
__device__ __forceinline__ unsigned xb_ld(unsigned* p)              { return __hip_atomic_load(p, __ATOMIC_RELAXED, __HIP_MEMORY_SCOPE_AGENT); }
__device__ __forceinline__ unsigned xb_add(unsigned* p, unsigned v) { return __hip_atomic_fetch_add(p, v, __ATOMIC_RELAXED, __HIP_MEMORY_SCOPE_AGENT); }
__device__ __forceinline__ unsigned xb_xcc_id() { return (unsigned)__builtin_amdgcn_s_getreg((3 << 11) | 20) & 0xFu; }
#define XB_SPIN(cond, bar) do { unsigned _sp = 0; while (cond) { __builtin_amdgcn_s_sleep(1); \
    if ((++_sp & 255u) == 0u) { if (xb_ld(&(bar)[XB_TMO])) break; if (_sp > XB_SPIN_CAP) { atomicAdd(&(bar)[XB_TMO], 1u); break; } } } } while (0)
struct XcdBarrier { unsigned* bar; unsigned x; volatile LAS unsigned* st; };
__device__ __forceinline__ XcdBarrier xcd_barrier_post(unsigned* bar, volatile LAS unsigned* st) {
    XcdBarrier b; b.bar = bar; b.x = xb_xcc_id(); b.st = st;
    if (threadIdx.x == 0) (void)xb_add(&bar[XB_XCNT(b.x)], 1u);
    return b;
}
__device__ __forceinline__ void xcd_barrier_complete(unsigned* bar, unsigned x, unsigned& nloc, unsigned& nx) {
    const unsigned G = gridDim.x * gridDim.y * gridDim.z;
    unsigned sum, cnt, mine, sp = 0u;
    for (;;) {
        sum = 0u; cnt = 0u; mine = 0u;
#pragma unroll
        for (unsigned j = 0; j < 16; ++j) { const unsigned c = xb_ld(&bar[XB_XCNT(j)]); sum += c; cnt += (c > 0u) ? 1u : 0u; mine = (j == x) ? c : mine; }
        if (sum == G) break;
        __builtin_amdgcn_s_sleep(1);
        if ((++sp & 255u) == 0u) { if (xb_ld(&bar[XB_TMO])) break; if (sp > XB_SPIN_CAP) { atomicAdd(&bar[XB_TMO], 1u); break; } }
    }
    nloc = mine > 0u ? mine : 1u; nx = cnt > 0u ? cnt : 1u;
}
__device__ __noinline__ void xcd_barrier_impl(unsigned* bar_, unsigned x_, volatile LAS unsigned* st_) {
    XcdBarrier b; b.bar = bar_; b.x = x_; b.st = st_;
    asm volatile("s_waitcnt vmcnt(0)" ::: "memory");
    __syncthreads();
    if (threadIdx.x == 0) {
        unsigned* bar = b.bar;
        __builtin_amdgcn_s_waitcnt(0);
        unsigned nloc = b.st[0], nx = b.st[1];
        if (nloc == 0u) { xcd_barrier_complete(bar, b.x, nloc, nx); b.st[0] = nloc; b.st[1] = nx; }
        const unsigned old = xb_add(&bar[XB_XSUB(b.x)], 1u);
        const unsigned gen = old / nloc;
        if (old + 1u == (gen + 1u) * nloc) {
            __builtin_amdgcn_fence(__ATOMIC_RELEASE, "agent");
            asm volatile("s_waitcnt vmcnt(0)" ::: "memory");
            const unsigned og = xb_add(&bar[XB_TOP], 1u);
            const unsigned tg = og / nx;
            if (og + 1u == (tg + 1u) * nx) xb_add(&bar[XB_TOPGEN], 1u);
            else XB_SPIN(xb_ld(&bar[XB_TOPGEN]) == tg, bar);
            __builtin_amdgcn_fence(__ATOMIC_ACQUIRE, "agent");
            xb_add(&bar[XB_XGEN(b.x)], 1u);
            asm volatile("s_waitcnt vmcnt(0)" ::: "memory");
        } else {
            XB_SPIN(xb_ld(&bar[XB_XGEN(b.x)]) == gen, bar);
            __builtin_amdgcn_fence(__ATOMIC_ACQUIRE, "agent");
            asm volatile("s_waitcnt vmcnt(0)" ::: "memory");
        }
    }
    __syncthreads();
}

namespace pg8 {
typedef int v4i_t __attribute__((ext_vector_type(4))); typedef int v8i_t __attribute__((ext_vector_type(8)));
constexpr int BM = 256, BK = 64, HALF = 128, HTB = HALF * BK * 2, STAGE_BYTES = 8 * HTB, NXCD = 8, WGM = 8;
__host__ __device__ __forceinline__ int lds_byte(int r, int c) { const int st = (r >> 4) * 2 + (c >> 5), rr = r & 15, cc = c & 31, ob = rr * 64 + cc * 2; return st * 1024 + (ob ^ (((ob >> 9) & 1) << 5)); }
__host__ __device__ __forceinline__ void stage_rc(int b, int& R, int& C) { const int st = b / 1024, sb = b % 1024, swz = sb ^ (((sb >> 9) & 1) << 5); R = (st >> 1) * 16 + swz / 64; C = (st & 1) * 32 + (swz % 64) / 2; }
__host__ __device__ __forceinline__ int perm32(int rho) { const int n = rho >> 4, i = rho & 15; return 8 * (i >> 2) + 4 * n + (i & 3); }

struct Unit { int pm, pn, aux; const char* a; const char* b; };

__device__ __forceinline__ bool tile_of(int i, int G, int c, int nM, int nN, int& pm, int& pn) {
    const int nwg = nM * nN; const long L = (long)i * G + c; if (L >= nwg) return false;
    int wgid = (int)L; { const int q = nwg / NXCD, r = nwg % NXCD, xcd = wgid % NXCD, off = wgid / NXCD; wgid = (xcd < r ? xcd * (q + 1) : r * (q + 1) + (xcd - r) * q) + off; }
    const int nig = WGM * nN, gid = wgid / nig, fm = gid * WGM, gsz = (nM - fm) < WGM ? (nM - fm) : WGM;
    pm = fm + ((wgid % nig) % gsz); pn = (wgid % nig) / gsz; return true;
}
struct StaticOrder {
    const bf16_t* A; const bf16_t* Bt; int lda, ldb, nM, nN, G, c;
    __device__ __forceinline__ bool next(int i, Unit& u) const {
        if (!tile_of(i, G, c, nM, nN, u.pm, u.pn)) return false;
        u.aux = 0; u.a = (const char*)(A + (size_t)u.pm * BM * lda); u.b = (const char*)(Bt + (size_t)u.pn * BM * ldb); return true;
    }
};
struct StaticOrder8 {
    const unsigned char* A; const unsigned char* Bt; int lda, ldb, nM, nN, G, c;
    __device__ __forceinline__ bool next(int i, Unit& u) const {
        if (!tile_of(i, G, c, nM, nN, u.pm, u.pn)) return false;
        u.aux = 0; u.a = (const char*)(A + (size_t)u.pm * BM * lda); u.b = (const char*)(Bt + (size_t)u.pn * BM * ldb); return true;
    }
};
struct MergeOrder {
    const bf16_t* BR; const bf16_t* WbT; int G, c;
    __device__ __forceinline__ bool next(int i, Unit& u) const {
        if (!tile_of(i >> 2, G, c, MTOK / BM, DM / BM, u.pm, u.pn)) return false;
        const int n = i & 3; u.aux = n; u.a = (const char*)(BR + (size_t)u.pm * BM * DM + n * 512); u.b = (const char*)(WbT + (size_t)n * DM * 512 + (size_t)u.pn * BM * 512); return true;
    }
};
struct MergeOrder8 {
    const unsigned char* BR; const unsigned char* WbT; int G, c;
    __device__ __forceinline__ bool next(int i, Unit& u) const {
        if (!tile_of(i >> 2, G, c, MTOK / BM, DM / BM, u.pm, u.pn)) return false;
        const int n = i & 3; u.aux = n; u.a = (const char*)(BR + (size_t)u.pm * BM * DM + n * 512); u.b = (const char*)(WbT + (size_t)n * DM * 512 + (size_t)u.pn * BM * 512); return true;
    }
};
struct MoeOrder {
    const unsigned char* A; const unsigned char* W; const int* panel; int lda, ldb, nN, G, c;
    __device__ __forceinline__ bool next(int i, Unit& u) const {
        const int nP = panel[0]; const long L = (long)i * G + c; if (L >= (long)nP * nN) return false;
        const int nig = WGM * nN, gid = (int)(L / nig), within = (int)(L % nig), fm = gid * WGM, gsz = (nP - fm) < WGM ? (nP - fm) : WGM;
        u.pm = fm + within % gsz; u.pn = within / gsz; const int e = panel[1 + u.pm]; u.aux = e;
        u.a = (const char*)(A + (size_t)u.pm * BM * lda); u.b = (const char*)(W + ((size_t)e * nN + u.pn) * BM * ldb); return true;
    }
};

template <class Epi, class Sched, bool FP8 = false, bool CHAIN = false>
__device__ __forceinline__ void gemm_phase(LAS unsigned char* lds, const int tid, const int K, const int lda, const int ldb, const Sched& S, const Epi& E) {
    constexpr int ES = FP8 ? 1 : 2;
    const int wid = __builtin_amdgcn_readfirstlane(tid >> 6), lane = tid & 63, wr = wid >> 2, wc = wid & 3, fr = lane & 15, fq = lane >> 4;
    const int nt = K * ES / 128;
    unsigned voffA[2], voffB[2];
#pragma unroll
    for (int i = 0; i < 2; ++i) { int R, C; stage_rc(tid * 16 + i * 8192, R, C); const int Rb = (R & ~31) + perm32(R & 31);
        voffA[i] = (unsigned)(R * lda * ES + C * 2); voffB[i] = (unsigned)(Rb * ldb * ES + C * 2); }
    const size_t kstep = (size_t)(BK * 2);
    const size_t hstepA = (size_t)HALF * lda * ES, hstepB = (size_t)HALF * ldb * ES;
    const unsigned ldsw = (unsigned)wid * 1024u;
    const int aoff = lds_byte(wr * 64 + fr, fq * 8), boff = lds_byte(wc * 32 + fr, fq * 8);
#define PG8_SA(b, h) (((b) * 2 + (h)) * HTB)
#define PG8_SB(b, h) ((4 + (b) * 2 + (h)) * HTB)
#define PG8_STAGE(bufoff, gbase, voff) do { _Pragma("unroll") for (int _i = 0; _i < 2; ++_i) \
        __builtin_amdgcn_global_load_lds((const unsigned*)((const char*)(gbase) + (voff)[_i]), (LAS unsigned*)(lds + (bufoff) + ldsw + _i * 8192), 16, 0, 0); } while (0)
#define PG8_LDA(dst, b, h) do { _Pragma("unroll") for (int m = 0; m < 4; ++m) { const v4i_t lo_ = *(const LAS v4i_t*)(lds + PG8_SA(b, h) + aoff + m * 2048), hi_ = *(const LAS v4i_t*)(lds + PG8_SA(b, h) + aoff + m * 2048 + 1024); \
        dst[m] = __builtin_shufflevector(lo_, hi_, 0, 1, 2, 3, 4, 5, 6, 7); } } while (0)
#define PG8_LDB(dst, b, h) do { _Pragma("unroll") for (int n = 0; n < 2; ++n) { const v4i_t lo_ = *(const LAS v4i_t*)(lds + PG8_SB(b, h) + boff + n * 2048), hi_ = *(const LAS v4i_t*)(lds + PG8_SB(b, h) + boff + n * 2048 + 1024); \
        dst[n] = __builtin_shufflevector(lo_, hi_, 0, 1, 2, 3, 4, 5, 6, 7); } } while (0)
#define PG8_MMA(ai, bj, At, Bt) do { __builtin_amdgcn_s_setprio(1); _Pragma("unroll") for (int m = 0; m < 4; ++m) _Pragma("unroll") for (int n = 0; n < 2; ++n) { \
        if constexpr (FP8) asm volatile("v_mfma_scale_f32_16x16x128_f8f6f4 %0, %1, %2, %0, %3, %3 op_sel_hi:[0,0,0]" : "+v"(acc[ai][bj][m][n]) : "v"(Bt[n]), "v"(At[m]), "v"(0x7f7f7f7f));   \
        else { acc[ai][bj][m][n] = __builtin_amdgcn_mfma_f32_16x16x32_bf16(__builtin_bit_cast(bf16x8, __builtin_shufflevector(Bt[n], Bt[n], 0, 1, 2, 3)), __builtin_bit_cast(bf16x8, __builtin_shufflevector(At[m], At[m], 0, 1, 2, 3)), acc[ai][bj][m][n], 0, 0, 0); \
               acc[ai][bj][m][n] = __builtin_amdgcn_mfma_f32_16x16x32_bf16(__builtin_bit_cast(bf16x8, __builtin_shufflevector(Bt[n], Bt[n], 4, 5, 6, 7)), __builtin_bit_cast(bf16x8, __builtin_shufflevector(At[m], At[m], 4, 5, 6, 7)), acc[ai][bj][m][n], 0, 0, 0); } } __builtin_amdgcn_s_setprio(0); } while (0)
#define PG8_WAIT_V(n) asm volatile("s_waitcnt vmcnt(" #n ")" ::: "memory")
#define PG8_WAIT_L(n) asm volatile("s_waitcnt lgkmcnt(" #n ")" ::: "memory")
#define PG8_BAR __builtin_amdgcn_s_barrier()
#define PG8_SCHED __builtin_amdgcn_sched_barrier(0)
    Unit cur, nxt; int ui = 0;
    if (!S.next(0, cur)) return;
    f32x4 acc[2][2][4][2];
#pragma unroll
    for (int a = 0; a < 2; ++a)
#pragma unroll
        for (int b = 0; b < 2; ++b)
#pragma unroll
            for (int m = 0; m < 4; ++m)
#pragma unroll
                for (int n = 0; n < 2; ++n) acc[a][b][m][n] = (f32x4){0.f, 0.f, 0.f, 0.f};
    v8i_t At[4], B0[2], B1[2];
    const char* cA = cur.a; const char* cB = cur.b;
    PG8_STAGE(PG8_SB(0, 0), cB, voffB); PG8_STAGE(PG8_SB(0, 1), cB + hstepB, voffB); PG8_STAGE(PG8_SA(0, 0), cA, voffA); PG8_STAGE(PG8_SA(0, 1), cA + hstepA, voffA);
    if (wr == 1) PG8_BAR;
    PG8_WAIT_V(2); PG8_BAR;
    PG8_STAGE(PG8_SB(1, 0), cB + kstep, voffB); PG8_STAGE(PG8_SA(1, 0), cA + kstep, voffA); PG8_STAGE(PG8_SB(1, 1), cB + hstepB + kstep, voffB);
    PG8_WAIT_V(6); PG8_BAR;
    for (;;) {
        const bool has_next = S.next(ui + 1, nxt);
        const char* nA = has_next ? nxt.a : cA; const char* nB = has_next ? nxt.b : cB;
        for (int t = 0; t < nt; t += 2) {
            const bool last = (t == nt - 2);
            const char* a1 = cA + (size_t)(t + 1) * kstep;
            const char* a2 = last ? nA : cA + (size_t)(t + 2) * kstep; const char* b2 = last ? nB : cB + (size_t)(t + 2) * kstep;
            const char* a3 = a2 + kstep; const char* b3 = b2 + kstep;
            PG8_LDB(B0, 0, 0); PG8_LDB(B1, 0, 1); PG8_SCHED; PG8_LDA(At, 0, 0); PG8_STAGE(PG8_SA(1, 1), a1 + hstepA, voffA);
            PG8_WAIT_V(8); PG8_WAIT_L(0); PG8_BAR; PG8_MMA(0, 0, At, B0); PG8_MMA(0, 1, At, B1); PG8_BAR; PG8_SCHED;
            PG8_LDA(At, 0, 1); PG8_STAGE(PG8_SB(0, 0), b2, voffB); PG8_STAGE(PG8_SB(0, 1), b2 + hstepB, voffB); PG8_STAGE(PG8_SA(0, 0), a2, voffA);
            PG8_WAIT_V(8); PG8_WAIT_L(0); PG8_BAR; PG8_MMA(1, 0, At, B0); PG8_MMA(1, 1, At, B1); PG8_BAR; PG8_SCHED;
            PG8_LDB(B0, 1, 0); PG8_LDB(B1, 1, 1); PG8_SCHED; PG8_LDA(At, 1, 0); PG8_STAGE(PG8_SA(0, 1), a2 + hstepA, voffA);
            PG8_WAIT_V(8); PG8_WAIT_L(0); PG8_BAR; PG8_MMA(0, 0, At, B0); PG8_MMA(0, 1, At, B1); PG8_BAR; PG8_SCHED;
            PG8_LDA(At, 1, 1); PG8_STAGE(PG8_SB(1, 0), b3, voffB); PG8_STAGE(PG8_SB(1, 1), b3 + hstepB, voffB); PG8_STAGE(PG8_SA(1, 0), a3, voffA);
            PG8_WAIT_V(8); PG8_WAIT_L(0); PG8_BAR; PG8_MMA(1, 0, At, B0); PG8_MMA(1, 1, At, B1); PG8_BAR; PG8_SCHED;
        }
        if (wr == 0) PG8_BAR;
        E(acc, cur, wr, wc, fr, fq);
        if (!has_next) break;
        if (!CHAIN || cur.aux == 3) {
#pragma unroll
        for (int a = 0; a < 2; ++a)
#pragma unroll
            for (int b = 0; b < 2; ++b)
#pragma unroll
                for (int m = 0; m < 4; ++m)
#pragma unroll
                    for (int n = 0; n < 2; ++n) acc[a][b][m][n] = (f32x4){0.f, 0.f, 0.f, 0.f};
        }
        cur = nxt; cA = nA; cB = nB; ++ui;
        if (wr == 1) PG8_BAR;
    }
    PG8_WAIT_V(0);
    PG8_BAR;
#undef PG8_SA
#undef PG8_SB
#undef PG8_STAGE
#undef PG8_LDA
#undef PG8_LDB
#undef PG8_MMA
#undef PG8_WAIT_V
#undef PG8_WAIT_L
#undef PG8_BAR
#undef PG8_SCHED
}
}

template <class Epi, class Sched>
__device__ __noinline__ void gemm_call(LAS unsigned char* lds, int K, int lda, int ldb, Sched S, Epi E) { pg8::gemm_phase(lds, K, lda, ldb, S, E); }

__device__ __forceinline__ u32x4 pack8(f32x4 a, f32x4 b) { u32x4 w; w.x = cvt_pk_bf16(a[0], a[1]); w.y = cvt_pk_bf16(a[2], a[3]); w.z = cvt_pk_bf16(b[0], b[1]); w.w = cvt_pk_bf16(b[2], b[3]); return w; }
__device__ __forceinline__ u32x2 pack4(f32x4 a) { u32x2 w; w.x = cvt_pk_bf16(a[0], a[1]); w.y = cvt_pk_bf16(a[2], a[3]); return w; }
__device__ __forceinline__ u32x2 pack8_fp8(f32x4 a, f32x4 b) { unsigned w0 = 0u, w1 = 0u;
    w0 = __builtin_amdgcn_cvt_pk_fp8_f32(a[0], a[1], w0, false); w0 = __builtin_amdgcn_cvt_pk_fp8_f32(a[2], a[3], w0, true);
    w1 = __builtin_amdgcn_cvt_pk_fp8_f32(b[0], b[1], w1, false); w1 = __builtin_amdgcn_cvt_pk_fp8_f32(b[2], b[3], w1, true); u32x2 r; r.x = w0; r.y = w1; return r; }
__device__ __forceinline__ void unpack8_fp8(u32x2 w, f32x4& a, f32x4& b) { typedef float f2 __attribute__((ext_vector_type(2)));
    const f2 a0 = __builtin_amdgcn_cvt_pk_f32_fp8(w.x, false), a1 = __builtin_amdgcn_cvt_pk_f32_fp8(w.x, true), b0 = __builtin_amdgcn_cvt_pk_f32_fp8(w.y, false), b1 = __builtin_amdgcn_cvt_pk_f32_fp8(w.y, true);
    a[0] = a0[0]; a[1] = a0[1]; a[2] = a1[0]; a[3] = a1[1]; b[0] = b0[0]; b[1] = b0[1]; b[2] = b1[0]; b[3] = b1[1]; }
__device__ __forceinline__ f32x4 sig4(f32x4 v) { f32x4 r; r[0] = sigmoidf_(v[0]); r[1] = sigmoidf_(v[1]); r[2] = sigmoidf_(v[2]); r[3] = sigmoidf_(v[3]); return r; }
__device__ __forceinline__ f32x4 ld_sc1_f32x4(const float* p) { typedef unsigned long long u64; const u64 a = __hip_atomic_load((const u64*)p, __ATOMIC_RELAXED, __HIP_MEMORY_SCOPE_AGENT), b = __hip_atomic_load((const u64*)p + 1, __ATOMIC_RELAXED, __HIP_MEMORY_SCOPE_AGENT);
    f32x4 r; r[0] = __uint_as_float((unsigned)a); r[1] = __uint_as_float((unsigned)(a >> 32)); r[2] = __uint_as_float((unsigned)b); r[3] = __uint_as_float((unsigned)(b >> 32)); return r; }
__device__ __forceinline__ u32x4 ld_sc1_u32x4(const void* p) { typedef unsigned long long u64; const u64 a = __hip_atomic_load((const u64*)p, __ATOMIC_RELAXED, __HIP_MEMORY_SCOPE_AGENT), b = __hip_atomic_load((const u64*)p + 1, __ATOMIC_RELAXED, __HIP_MEMORY_SCOPE_AGENT);
    u32x4 r; r.x = (unsigned)a; r.y = (unsigned)(a >> 32); r.z = (unsigned)b; r.w = (unsigned)(b >> 32); return r; }
__device__ __forceinline__ void unpack8(u32x4 w, f32x4& a, f32x4& b) { a[0] = bflo(w.x); a[1] = bfhi(w.x); a[2] = bflo(w.y); a[3] = bfhi(w.y); b[0] = bflo(w.z); b[1] = bfhi(w.z); b[2] = bflo(w.w); b[3] = bfhi(w.w); }

#define ACC_T const f32x4 (&acc)[2][2][4][2]
#define FOR_AI_M _Pragma("unroll") for (int ai = 0; ai < 2; ++ai) _Pragma("unroll") for (int m = 0; m < 4; ++m)

struct EpiA {
    unsigned char* R; const float* rope64; const float* rope32; float inv;
    __device__ __forceinline__ void vt_store(bf16_t* T, int nheads, int b, int head, int dv0, int tseq, f32x4 v0, f32x4 v1) const {
        bf16_t* p = T + ((size_t)(b * nheads + head) * 64 + dv0) * SEQ + perm23(tseq);
#pragma unroll
        for (int k = 0; k < 4; ++k) { p[(size_t)k * SEQ] = f2bf(v0[k]); p[(size_t)(4 + k) * SEQ] = f2bf(v1[k]); }
    }
    __device__ __forceinline__ void operator()(ACC_T, const pg8::Unit& u, int wr, int wc, int fr, int fq) const {
        asm volatile("" : "+v"(fr), "+v"(fq));
        const int t = u.pn; const int row0 = u.pm * 256 + wr * 64 + fr;
        if (t >= 20) {
            bf16_t* G = (bf16_t*)(R + R_GATES);
            FOR_AI_M { const int row = row0 + ai * 128 + m * 16;
#pragma unroll
                for (int bj = 0; bj < 2; ++bj) *(u32x4*)(G + (size_t)row * 8192 + (t - 20) * 256 + bj * 128 + wc * 32 + fq * 8) = pack8(acc[ai][bj][m][0], acc[ai][bj][m][1]); }
        } else if (t < 6) {
            bf16_t* dst; int ld, col; float sc;
            if (t < 2) { dst = (bf16_t*)(R + R_AQ); ld = 512; col = (t & 1) * 256 + 64 * wc; sc = QS64 * inv; }
            else if (t < 4) { dst = (bf16_t*)(R + R_BQ); ld = 512; col = (t & 1) * 256 + 64 * wc; sc = QS64 * inv; }
            else if (t == 4) { dst = (bf16_t*)(R + (wc < 2 ? R_AKC : R_AKS)); ld = 128; col = 64 * (wc & 1); sc = inv; }
            else { dst = (bf16_t*)(R + (wc < 2 ? R_AKW : R_BK)); ld = 128; col = 64 * (wc & 1); sc = inv; }
            FOR_AI_M { const int row = row0 + ai * 128 + m * 16; const float* rp = rope64 + (size_t)row * 64 + 8 * fq;
                const f32x4 c0 = *(const f32x4*)rp, c1 = *(const f32x4*)(rp + 4), s0 = *(const f32x4*)(rp + 32), s1 = *(const f32x4*)(rp + 36);
                const f32x4 l0 = acc[ai][0][m][0], l1 = acc[ai][0][m][1], h0 = acc[ai][1][m][0], h1 = acc[ai][1][m][1];
                const f32x4 ol0 = (l0 * c0 - h0 * s0) * sc, ol1 = (l1 * c1 - h1 * s1) * sc, oh0 = (h0 * c0 + l0 * s0) * sc, oh1 = (h1 * c1 + l1 * s1) * sc;
                bf16_t* p = dst + (size_t)row * ld + col + 8 * fq;
                *(u32x4*)p = pack8(ol0, ol1); *(u32x4*)(p + 32) = pack8(oh0, oh1); }
        } else if (t < 10) {
            bf16_t* dst = (bf16_t*)(R + (t < 8 ? R_CQ : R_CK)); const float sc = (t < 8 ? QS64 : 1.f) * inv;
            FOR_AI_M { const int row = row0 + ai * 128 + m * 16;
#pragma unroll
                for (int bj = 0; bj < 2; ++bj) *(u32x4*)(dst + (size_t)row * 512 + (t & 1) * 256 + bj * 128 + wc * 32 + fq * 8) = pack8(acc[ai][bj][m][0] * sc, acc[ai][bj][m][1] * sc); }
        } else if (t < 14) {
            bf16_t* dst = (bf16_t*)(R + (t < 12 ? R_DQ : R_DK)); const float sc = (t < 12 ? QS32 : 1.f) * inv;
            FOR_AI_M { const int row = row0 + ai * 128 + m * 16; const float* rp = rope32 + (size_t)row * 32 + 4 * fq;
                const f32x4 c = *(const f32x4*)rp, s = *(const f32x4*)(rp + 16);
#pragma unroll
                for (int n = 0; n < 2; ++n) { const f32x4 lo = acc[ai][0][m][n], hi = acc[ai][1][m][n];
                    bf16_t* p = dst + (size_t)row * 512 + (t & 1) * 256 + 64 * wc + 32 * n + 4 * fq;
                    *(u32x2*)p = pack4((lo * c - hi * s) * sc); *(u32x2*)(p + 16) = pack4((hi * c + lo * s) * sc); } }
        } else {
            const int b = u.pm >> 4;
            FOR_AI_M { const int row = row0 + ai * 128 + m * 16; const int tseq = row & (SEQ - 1);
#pragma unroll
                for (int bj = 0; bj < 2; ++bj) { const f32x4 v0 = acc[ai][bj][m][0] * inv, v1 = acc[ai][bj][m][1] * inv; const int dv0 = 32 * (wc & 1) + 8 * fq, hh = wc >> 1;
                    if (t == 14) { if (bj == 0) *(u32x4*)((bf16_t*)(R + R_AVC) + (size_t)row * 128 + wc * 32 + fq * 8) = pack8(v0, v1);
                                   else vt_store((bf16_t*)(R + R_AVST), 2, b, hh, dv0, tseq, v0, v1); }
                    else if (t == 15) vt_store((bf16_t*)(R + (bj == 0 ? R_AVWT : R_BVT)), 2, b, hh, dv0, tseq, v0, v1);
                    else vt_store((bf16_t*)(R + (t < 18 ? R_CVT : R_DVT)), 8, b, (t & 1) * 4 + 2 * bj + hh, dv0, tseq, v0, v1); }
                asm volatile("s_waitcnt vmcnt(16)" ::: "memory"); }
        }
    }
};
struct EpiGate8 {
    unsigned char* G; float inv_scale;
    __device__ __forceinline__ void operator()(ACC_T, const pg8::Unit& u, int wr, int wc, int fr, int fq) const {
        asm volatile("" : "+v"(fr), "+v"(fq));
        const unsigned row0 = (unsigned)(u.pm * 256 + wr * 64 + fr), colb = (unsigned)(u.pn * 256 + wc * 32 + fq * 8);
        FOR_AI_M { const unsigned row = row0 + ai * 128 + m * 16;
#pragma unroll
            for (int bj = 0; bj < 2; ++bj) { f32x4 l0, l1;
#pragma unroll
                for (int i = 0; i < 4; ++i) { l0[i] = -__builtin_amdgcn_logf(1.f + fast_exp2(fminf(-acc[ai][bj][m][0][i] * (inv_scale * LOG2E), 100.f))); l1[i] = -__builtin_amdgcn_logf(1.f + fast_exp2(fminf(-acc[ai][bj][m][1][i] * (inv_scale * LOG2E), 100.f))); }
                *(u32x2*)(G + (row * 8192u + colb + bj * 128)) = pack8_fp8(l0, l1); } }
    }
};
struct EpiMerge {
    const unsigned char* gates; bf16_t* merged; unsigned char* merged8;
    __device__ __forceinline__ void operator()(ACC_T, const pg8::Unit& u, int wr, int wc, int fr, int fq) const {
        asm volatile("" : "+v"(fr), "+v"(fq));
        const int n = u.aux; const unsigned row0 = (unsigned)(u.pm * 256 + wr * 64 + fr), colb = (unsigned)(u.pn * 256 + wc * 32 + fq * 8);
        const unsigned char* gb = gates + n * 2048;
#pragma unroll
        for (int ai = 0; ai < 2; ++ai)
#pragma unroll
            for (int mp = 0; mp < 2; ++mp) {
                u32x2 g[2][2]; u32x4 p[2][2];
#pragma unroll
                for (int mm = 0; mm < 2; ++mm)
#pragma unroll
                    for (int bj = 0; bj < 2; ++bj) { const unsigned row = row0 + ai * 128 + (2 * mp + mm) * 16, col = colb + bj * 128;
                        g[mm][bj] = *(const u32x2*)(gb + (row * 8192u + col));
                        if (n > 0) p[mm][bj] = *(const u32x4*)(merged + (row * 2048u + col)); else p[mm][bj] = (u32x4){0u, 0u, 0u, 0u}; }
#pragma unroll
                for (int mm = 0; mm < 2; ++mm)
#pragma unroll
                    for (int bj = 0; bj < 2; ++bj) { const int m = 2 * mp + mm; const unsigned row = row0 + ai * 128 + m * 16, col = colb + bj * 128;
                        f32x4 g0, g1, p0, p1; unpack8_fp8(g[mm][bj], g0, g1); unpack8(p[mm][bj], p0, p1); g0 = sig4(g0); g1 = sig4(g1);
                        const f32x4 v0 = g0 * acc[ai][bj][m][0] + p0, v1 = g1 * acc[ai][bj][m][1] + p1;
                        if (n < 3) *(u32x4*)(merged + (row * 2048u + col)) = pack8(v0, v1); else *(u32x2*)(merged8 + (row * 2048u + col)) = pack8_fp8(v0 * MERGED8_SCALE, v1 * MERGED8_SCALE); }
                asm volatile("" ::: "memory");
            }
    }
};
#ifndef MERGE_CHAIN
#define MERGE_CHAIN 1
#endif
struct EpiMergeChain {
    const unsigned char* gates; unsigned char* merged8; float inv;
    __device__ __forceinline__ void operator()(f32x4 (&acc)[2][2][4][2], const pg8::Unit& u, int wr, int wc, int fr, int fq) const {
        asm volatile("" : "+v"(fr), "+v"(fq));
        const int n = u.aux; const unsigned row0 = (unsigned)(u.pm * 256 + wr * 64 + fr), colb = (unsigned)(u.pn * 256 + wc * 32 + fq * 8);
        const unsigned char* gb = gates + n * 2048;
#pragma unroll
        for (int ai = 0; ai < 2; ++ai)
#pragma unroll
            for (int mp = 0; mp < 2; ++mp) {
                u32x2 g[2][2], h[2][2];
#pragma unroll
                for (int mm = 0; mm < 2; ++mm)
#pragma unroll
                    for (int bj = 0; bj < 2; ++bj) { const unsigned row = row0 + ai * 128 + (2 * mp + mm) * 16, col = colb + bj * 128;
                        g[mm][bj] = *(const u32x2*)(gb + (row * 8192u + col));
                        if (n < 3) h[mm][bj] = *(const u32x2*)(gb + 2048 + (row * 8192u + col)); else h[mm][bj] = (u32x2){0u, 0u}; }
#pragma unroll
                for (int mm = 0; mm < 2; ++mm)
#pragma unroll
                    for (int bj = 0; bj < 2; ++bj) { const int m = 2 * mp + mm; const unsigned row = row0 + ai * 128 + m * 16, col = colb + bj * 128;
                        f32x4 x0, x1; unpack8_fp8(g[mm][bj], x0, x1);
                        if (n < 3) { f32x4 y0, y1; unpack8_fp8(h[mm][bj], y0, y1);
#pragma unroll
                            for (int i = 0; i < 4; ++i) { acc[ai][bj][m][0][i] *= fast_exp2(x0[i] - y0[i]); acc[ai][bj][m][1][i] *= fast_exp2(x1[i] - y1[i]); } }
                        else { f32x4 d0, d1;
#pragma unroll
                            for (int i = 0; i < 4; ++i) { d0[i] = fast_exp2(x0[i]); d1[i] = fast_exp2(x1[i]); }
                            *(u32x2*)(merged8 + (row * 2048u + col)) = pack8_fp8(acc[ai][bj][m][0] * d0 * (MERGED8_SCALE * inv), acc[ai][bj][m][1] * d1 * (MERGED8_SCALE * inv)); } }
                asm volatile("" ::: "memory");
            }
    }
};
struct EpiF32 {
    float* out; float scale;
    __device__ __forceinline__ void operator()(ACC_T, const pg8::Unit& u, int wr, int wc, int fr, int fq) const {
        asm volatile("" : "+v"(fr), "+v"(fq));
        const unsigned row0 = (unsigned)(u.pm * 256 + wr * 64 + fr), colb = (unsigned)(u.pn * 256 + wc * 32 + fq * 8);
        FOR_AI_M { const unsigned row = row0 + ai * 128 + m * 16;
#pragma unroll
            for (int bj = 0; bj < 2; ++bj) { const unsigned o = row * 2048u + colb + bj * 128; *(f32x4*)(out + o) = acc[ai][bj][m][0] * scale; *(f32x4*)(out + o + 4) = acc[ai][bj][m][1] * scale; } }
    }
};
struct EpiBf16S {
    bf16_t* out; float scale;
    __device__ __forceinline__ void operator()(ACC_T, const pg8::Unit& u, int wr, int wc, int fr, int fq) const {
        asm volatile("" : "+v"(fr), "+v"(fq));
        const unsigned row0 = (unsigned)(u.pm * 256 + wr * 64 + fr), colb = (unsigned)(u.pn * 256 + wc * 32 + fq * 8);
        FOR_AI_M { const unsigned row = row0 + ai * 128 + m * 16;
#pragma unroll
            for (int bj = 0; bj < 2; ++bj) *(u32x4*)(out + (row * 2048u + colb + bj * 128)) = pack8(acc[ai][bj][m][0] * scale, acc[ai][bj][m][1] * scale); }
    }
};
struct EpiSwiglu {
    bf16_t* act; int ld;
    __device__ __forceinline__ void operator()(ACC_T, const pg8::Unit& u, int wr, int wc, int fr, int fq) const {
        asm volatile("" : "+v"(fr), "+v"(fq));
        const int row0 = u.pm * 256 + wr * 64 + fr;
        FOR_AI_M { const int row = row0 + ai * 128 + m * 16; f32x4 o[2];
#pragma unroll
            for (int n = 0; n < 2; ++n) { const f32x4 g = acc[ai][0][m][n], up = acc[ai][1][m][n];
#pragma unroll
                for (int i = 0; i < 4; ++i) o[n][i] = g[i] * sigmoidf_(g[i]) * up[i]; }
            *(u32x4*)(act + (size_t)row * ld + u.pn * 128 + wc * 32 + fq * 8) = pack8(o[0], o[1]); }
    }
};
struct EpiSwigluF8 {
    unsigned char* act; int ld; float inv_scale;
    __device__ __forceinline__ void operator()(ACC_T, const pg8::Unit& u, int wr, int wc, int fr, int fq) const {
        asm volatile("" : "+v"(fr), "+v"(fq));
        const int row0 = u.pm * 256 + wr * 64 + fr;
        FOR_AI_M { const int row = row0 + ai * 128 + m * 16; f32x4 o[2];
#pragma unroll
            for (int n = 0; n < 2; ++n) { const f32x4 g = acc[ai][0][m][n] * inv_scale, up = acc[ai][1][m][n] * inv_scale;
#pragma unroll
                for (int i = 0; i < 4; ++i) o[n][i] = g[i] * sigmoidf_(g[i]) * up[i]; }
            *(u32x2*)(act + (size_t)row * ld + u.pn * 128 + wc * 32 + fq * 8) = pack8_fp8(o[0], o[1]); }
    }
};
struct EpiBf16 {
    bf16_t* out;
    __device__ __forceinline__ void operator()(ACC_T, const pg8::Unit& u, int wr, int wc, int fr, int fq) const {
        asm volatile("" : "+v"(fr), "+v"(fq));
        const int row0 = u.pm * 256 + wr * 64 + fr;
        FOR_AI_M { const int row = row0 + ai * 128 + m * 16;
#pragma unroll
            for (int bj = 0; bj < 2; ++bj) *(u32x4*)(out + (size_t)row * DM + u.pn * 256 + bj * 128 + wc * 32 + fq * 8) = pack8(acc[ai][bj][m][0], acc[ai][bj][m][1]); }
    }
};
struct EpiPleGate {
    const bf16_t* ptmp; bf16_t* ple; float scale;
    __device__ __forceinline__ void operator()(ACC_T, const pg8::Unit& u, int wr, int wc, int fr, int fq) const {
        asm volatile("" : "+v"(fr), "+v"(fq));
        const int row0 = u.pm * 256 + wr * 64 + fr;
        FOR_AI_M { const int row = row0 + ai * 128 + m * 16;
#pragma unroll
            for (int bj = 0; bj < 2; ++bj) { const size_t o = (size_t)row * DM + u.pn * 256 + bj * 128 + wc * 32 + fq * 8;
                f32x4 p0, p1; unpack8(ld_sc1_u32x4(ptmp + o), p0, p1);
                *(u32x4*)(ple + o) = pack8(sig4(acc[ai][bj][m][0] * scale) * p0, sig4(acc[ai][bj][m][1] * scale) * p1); }
            asm volatile("" ::: "memory"); }
    }
};
struct EpiMoeDown {
    const float* sroww; bf16_t* ys; float inv_scale;
    __device__ __forceinline__ void operator()(ACC_T, const pg8::Unit& u, int wr, int wc, int fr, int fq) const {
        asm volatile("" : "+v"(fr), "+v"(fq));
        const int row0 = u.pm * 256 + wr * 64 + fr;
        FOR_AI_M { const int row = row0 + ai * 128 + m * 16; const float w = sroww[row] * inv_scale;
#pragma unroll
            for (int bj = 0; bj < 2; ++bj) *(u32x4*)(ys + (size_t)row * DM + u.pn * 256 + bj * 128 + wc * 32 + fq * 8) = pack8(acc[ai][bj][m][0] * w, acc[ai][bj][m][1] * w); }
    }
};

struct Args { const void* in[28]; float* out; unsigned char* ws; int ph_lo, ph_hi; };
enum { IN_X = 0, IN_P, IN_POS, IN_WIN, IN_PE, IN_CW1, IN_CB1, IN_CW2, IN_SINK, IN_FOXB, IN_DLAM, IN_DGAIN, IN_WBR, IN_WOUT, IN_LN1G, IN_LN1B,
       IN_FWG, IN_FWU, IN_FWD, IN_ROUTER, IN_ROUTERB, IN_MWG, IN_MWU, IN_MWD, IN_PPROJ, IN_PGATE, IN_LN2G, IN_LN2B };
struct Frame { LAS unsigned char* lds; int tid, lane, wave, vcu, G; };

enum { MAP_PLAIN = 0, MAP_R64 = 1, MAP_R32 = 2, MAP_GU = 3 };
struct TrSeg { const float* W; bf16_t* WT; int ldw, K, ncols, ldt, kind, vbase, aoff, item0; float f8scale; int pad; };
__device__ __forceinline__ int map_row(int kind, int a) {
    if (kind == MAP_R64) { const int l = a & 255; return (a & ~255) + 128 * ((l >> 5) & 1) + 32 * (l >> 6) + (l & 31); }
    if (kind == MAP_R32) { const int l = a & 255; return (a & ~255) + 128 * ((l >> 4) & 1) + 32 * (l >> 6) + 8 * ((l >> 2) & 3) + 4 * ((l >> 5) & 1) + (l & 3); }
    if (kind == MAP_GU) return (a >> 7) * 256 + (a & 127);
    return a;
}
__device__ __forceinline__ void tr_item(const TrSeg& s, int item, LAS unsigned char* scr, int lane) {
    const int nblk = s.ncols >> 6, kb = item / nblk, nb = item - kb * nblk, k0 = kb * 64, n0 = nb * 64;
    const int q4 = lane >> 4, n4 = (lane & 15) * 4;
    f32x4 v[16];
    const float* src = s.W + (size_t)(k0 + q4 * 16) * s.ldw + n0 + n4;
#pragma unroll
    for (int kk = 0; kk < 16; ++kk) v[kk] = *(const f32x4*)(src + (size_t)kk * s.ldw);
    if (s.f8scale != 0.f) {
        const float sc = s.f8scale;
#pragma unroll
        for (int i = 0; i < 4; ++i) { u32x4 w;
#pragma unroll
            for (int j = 0; j < 4; ++j) { unsigned d = 0u; d = __builtin_amdgcn_cvt_pk_fp8_f32(v[4 * j][i] * sc, v[4 * j + 1][i] * sc, d, false); d = __builtin_amdgcn_cvt_pk_fp8_f32(v[4 * j + 2][i] * sc, v[4 * j + 3][i] * sc, d, true); w[j] = d; }
            *(LAS u32x4*)(scr + (n4 + i) * 144 + q4 * 16) = w; }
        LDS_WAIT(); asm volatile("" ::: "memory");
#pragma unroll
        for (int it = 0; it < 4; ++it) { const int n = (lane >> 2) + 16 * it, ch = lane & 3;
            const u32x4 val = *(const LAS u32x4*)(scr + n * 144 + ch * 16);
            const int vr = s.vbase + map_row(s.kind, s.aoff + n0 + n);
            *(u32x4*)((unsigned char*)s.WT + (size_t)vr * s.ldt + k0 + ch * 16) = val; }
        LDS_WAIT(); asm volatile("" ::: "memory");
        return;
    }
#pragma unroll
    for (int i = 0; i < 4; ++i) {
        u32x4 w0, w1;
        w0.x = cvt_pk_bf16(v[0][i], v[1][i]); w0.y = cvt_pk_bf16(v[2][i], v[3][i]); w0.z = cvt_pk_bf16(v[4][i], v[5][i]); w0.w = cvt_pk_bf16(v[6][i], v[7][i]);
        w1.x = cvt_pk_bf16(v[8][i], v[9][i]); w1.y = cvt_pk_bf16(v[10][i], v[11][i]); w1.z = cvt_pk_bf16(v[12][i], v[13][i]); w1.w = cvt_pk_bf16(v[14][i], v[15][i]);
        LAS unsigned char* p = scr + (n4 + i) * 144 + q4 * 32;
        *(LAS u32x4*)p = w0; *(LAS u32x4*)(p + 16) = w1;
    }
    LDS_WAIT(); asm volatile("" ::: "memory");
#pragma unroll
    for (int it = 0; it < 8; ++it) { const int n = (lane >> 3) + 8 * it, ch = lane & 7;
        const u32x4 val = *(const LAS u32x4*)(scr + n * 144 + ch * 16);
        const int vr = s.vbase + map_row(s.kind, s.aoff + n0 + n);
        *(u32x4*)(s.WT + (size_t)vr * s.ldt + k0 + ch * 8) = val; }
    LDS_WAIT(); asm volatile("" ::: "memory");
}
__device__ __forceinline__ void tr_item_f8(const TrSeg& s, int item, LAS unsigned char* scr, int lane) {
    const int nblk = s.ncols >> 6, kb = item / nblk, nb = item - kb * nblk, k0 = kb * 128, n0 = nb * 64;
    const int q4 = lane >> 4, n4 = (lane & 15) * 4;
    f32x4 v[32];
    const float* src = s.W + (size_t)(k0 + q4 * 32) * s.ldw + n0 + n4;
#pragma unroll
    for (int kk = 0; kk < 32; ++kk) v[kk] = *(const f32x4*)(src + (size_t)kk * s.ldw);
    const float sc = s.f8scale;
#pragma unroll
    for (int i = 0; i < 4; ++i) { u32x4 w0, w1;
#pragma unroll
        for (int j = 0; j < 4; ++j) { unsigned d = 0u; d = __builtin_amdgcn_cvt_pk_fp8_f32(v[4 * j][i] * sc, v[4 * j + 1][i] * sc, d, false); d = __builtin_amdgcn_cvt_pk_fp8_f32(v[4 * j + 2][i] * sc, v[4 * j + 3][i] * sc, d, true); w0[j] = d;
            unsigned e = 0u; e = __builtin_amdgcn_cvt_pk_fp8_f32(v[16 + 4 * j][i] * sc, v[17 + 4 * j][i] * sc, e, false); e = __builtin_amdgcn_cvt_pk_fp8_f32(v[18 + 4 * j][i] * sc, v[19 + 4 * j][i] * sc, e, true); w1[j] = e; }
        LAS unsigned char* p = scr + (n4 + i) * 144 + q4 * 32; *(LAS u32x4*)p = w0; *(LAS u32x4*)(p + 16) = w1; }
    LDS_WAIT(); asm volatile("" ::: "memory");
#pragma unroll
    for (int it = 0; it < 8; ++it) { const int n = (lane >> 3) + 8 * it, ch = lane & 7;
        const u32x4 val = *(const LAS u32x4*)(scr + n * 144 + ch * 16);
        const int vr = s.vbase + map_row(s.kind, s.aoff + n0 + n);
        *(u32x4*)((unsigned char*)s.WT + (size_t)vr * s.ldt + k0 + ch * 16) = val; }
    LDS_WAIT(); asm volatile("" ::: "memory");
}
__device__ __forceinline__ void p0_prologue(const Frame& F, const Args& A) {
    unsigned char* ws = A.ws;
    LAS unsigned char* scr = F.lds + F.wave * 9216;
    LAS TrSeg* tab = (LAS TrSeg*)(F.lds + 81920);
    LAS int* tabn = (LAS int*)(F.lds + 81920 + 96 * 56);
    if (F.tid == 0) {
        int n = 0, item = 0;
#define add8(W_, ldw_, K_, ncols_, WT_, ldt_, kind_, vbase_, aoff_, f8_) do { LAS TrSeg* s_ = tab + n; s_->f8scale = (f8_); s_->pad = 0; s_->W = (W_); s_->WT = (WT_); s_->ldw = (ldw_); s_->K = (K_); s_->ncols = (ncols_); s_->ldt = (ldt_); \
            s_->kind = (kind_); s_->vbase = (vbase_); s_->aoff = (aoff_); s_->item0 = item; ++n; item += ((K_) >> 6) * ((ncols_) >> 6); } while (0)
#define add(W_, ldw_, K_, ncols_, WT_, ldt_, kind_, vbase_, aoff_) add8(W_, ldw_, K_, ncols_, WT_, ldt_, kind_, vbase_, aoff_, 0.f)
        int n_now = 0, item_now = 0;
        for (int pass = 0; pass < 2; ++pass) {
#define addp(def_, ...) do { if ((def_) == pass) add(__VA_ARGS__); } while (0)
#define addp8(def_, ...) do { if ((def_) == pass) add8(__VA_ARGS__); } while (0)
            addp(1, (const float*)A.in[IN_FWG], DFF, DM, DFF, (bf16_t*)(ws + WS_WFGU), DM, MAP_GU, 0, 0);
            addp(1, (const float*)A.in[IN_FWU], DFF, DM, DFF, (bf16_t*)(ws + WS_WFGU), DM, MAP_GU, 128, 0);
#if DENSE_DOWN_FP8
            addp8(1, (const float*)A.in[IN_FWD], DM, DFF, DM, (bf16_t*)(ws + WS_WFD), DFF8, MAP_PLAIN, 0, 0, WFD_SCALE);
#else
            addp(1, (const float*)A.in[IN_FWD], DM, DFF, DM, (bf16_t*)(ws + WS_WFD), DFF, MAP_PLAIN, 0, 0);
#endif
            for (int L = 0; L < NLAYER; ++L) {
                const float* win = (const float*)A.in[IN_WIN] + (size_t)L * DM * INC; bf16_t* wa = (bf16_t*)(ws + WS_WA + L * SZ_WA);
#if QKV_FP8
#define ADDWA(W_, nc_, kind_, vb_, ao_) addp8(L, W_, INC, DM, nc_, wa, DM, kind_, vb_, ao_, WA_SCALE)
#else
#define ADDWA(W_, nc_, kind_, vb_, ao_) addp(L, W_, INC, DM, nc_, wa, DM, kind_, vb_, ao_)
#endif
                ADDWA(win + SRC_AQ, 512, MAP_R64, 0 * 256, 0);
                ADDWA(win + SRC_BQ, 512, MAP_R64, 2 * 256, 0);
                ADDWA(win + SRC_AKC, 128, MAP_R64, 4 * 256, 0);
                ADDWA(win + SRC_AKS, 128, MAP_R64, 4 * 256, 128);
                ADDWA(win + SRC_AKW, 128, MAP_R64, 5 * 256, 0);
                ADDWA(win + SRC_BK, 128, MAP_R64, 5 * 256, 128);
                ADDWA(win + SRC_CQ, 512, MAP_PLAIN, 6 * 256, 0);
                ADDWA(win + SRC_CK, 512, MAP_PLAIN, 8 * 256, 0);
                ADDWA(win + SRC_DQ, 512, MAP_R32, 10 * 256, 0);
                ADDWA(win + SRC_DK, 512, MAP_R32, 12 * 256, 0);
                ADDWA(win + SRC_AVC, 128, MAP_PLAIN, 14 * 256, 0);
                ADDWA(win + SRC_AVS, 128, MAP_PLAIN, 14 * 256, 128);
                ADDWA(win + SRC_AVW, 128, MAP_PLAIN, 15 * 256, 0);
                ADDWA(win + SRC_BV, 128, MAP_PLAIN, 15 * 256, 128);
                ADDWA(win + SRC_CV, 512, MAP_PLAIN, 16 * 256, 0);
                ADDWA(win + SRC_DV, 512, MAP_PLAIN, 18 * 256, 0);
                addp8(L, win + SRC_MG, INC, DM, 8192, (bf16_t*)(ws + WS_WAG8 + L * SZ_WAG8), DM, MAP_PLAIN, 0, 0, GATE_W_SCALE);
                for (int kv = 0; kv < 2; ++kv) addp(L, (const float*)A.in[IN_CW1] + (size_t)(L * 2 + kv) * 2048 * 256, 256, 2048, 256, (bf16_t*)(ws + WS_WC1 + (L * 2 + kv) * SZ_WC1), 2048, MAP_PLAIN, 0, 0);
#if PD_FP8
                for (int nb = 0; nb < 4; ++nb) addp8(1, (const float*)A.in[IN_WBR] + (size_t)(L * 4 + nb) * 512 * DM, DM, 512, DM, (bf16_t*)(ws + WS_WB + L * SZ_WB + (size_t)nb * DM * 512), 512, MAP_PLAIN, 0, 0, WB_SCALE);
#else
                for (int nb = 0; nb < 4; ++nb) addp(1, (const float*)A.in[IN_WBR] + (size_t)(L * 4 + nb) * 512 * DM, DM, 512, DM, (bf16_t*)(ws + WS_WB + L * SZ_WB) + (size_t)nb * DM * 512, 512, MAP_PLAIN, 0, 0);
#endif
                addp8(1, (const float*)A.in[IN_WOUT] + (size_t)L * DM * DM, DM, DM, DM, (bf16_t*)(ws + WS_WO + L * SZ_WO), DM, MAP_PLAIN, 0, 0, WO_SCALE);
                addp(1, (const float*)A.in[IN_PPROJ] + (size_t)L * PLE * DM, DM, PLE, DM, (bf16_t*)(ws + WS_WPP + L * SZ_WPP), PLE, MAP_PLAIN, 0, 0);
                if (L == 0 && !PLE0_FP8) addp(1, (const float*)A.in[IN_PGATE] + (size_t)L * DM * DM, DM, DM, DM, (bf16_t*)(ws + WS_WPG + L * SZ_WPG), DM, MAP_PLAIN, 0, 0);
                else addp8(1, (const float*)A.in[IN_PGATE] + (size_t)L * DM * DM, DM, DM, DM, (bf16_t*)(ws + WS_WPG + L * SZ_WPG), DM, MAP_PLAIN, 0, 0, PG_SCALE);
            }
            if (pass == 0) { n_now = n; item_now = item; }
#undef addp
#undef addp8
        }
        if (F.vcu == 0) {
            int* gh = (int*)(ws + WS_CTL + DEFTAB_OFF); gh[0] = n - n_now; gh[1] = item - item_now;
            for (int i = n_now; i < n; ++i) { const LAS unsigned* src = (const LAS unsigned*)(tab + i); unsigned* dst = (unsigned*)(gh + 4) + (i - n_now) * 14;
                for (int w = 0; w < 14; ++w) dst[w] = src[w];
                ((TrSeg*)dst)->item0 = tab[i].item0 - item_now; }
        }
        n = n_now; item = item_now;
        tabn[0] = n; tabn[1] = item;
#undef add
#undef add8
    }
    __syncthreads();
    const int nseg = tabn[0], nitems = tabn[1];
    const int gw = F.vcu * NWAVES + F.wave, NGW = F.G * NWAVES;
    {
        int si = 0; TrSeg s; int send;
#define LDSEG(i_) do { LAS TrSeg* t_ = tab + (i_); s.W = (const float*)(const GAS float*)(unsigned long long)t_->W; s.WT = (bf16_t*)(GAS bf16_t*)(unsigned long long)t_->WT; s.ldw = t_->ldw; s.K = t_->K; s.ncols = t_->ncols; s.ldt = t_->ldt; s.kind = t_->kind; s.vbase = t_->vbase; s.aoff = t_->aoff; s.item0 = t_->item0; s.f8scale = t_->f8scale; \
            send = ((i_) + 1 < nseg) ? tab[(i_) + 1].item0 : nitems; } while (0)
        LDSEG(0);
        for (int it = gw; it < nitems; it += NGW) {
            while (it >= send) { ++si; LDSEG(si); }
            tr_item(s, it - s.item0, scr, F.lane);
        }
    }
    const int gt = (F.vcu * NWAVES + F.wave) * 64 + F.lane, NGT = NGW * 64;
    { const float* x = (const float*)A.in[IN_X]; bf16_t* hb = (bf16_t*)(ws + WS_HB);
      unsigned char* hb8 = ws + WS_HB8;
      for (int i = gt; i < MTOK * DM / 8; i += NGT) { const f32x4 a = *(const f32x4*)(x + (size_t)i * 8), b = *(const f32x4*)(x + (size_t)i * 8 + 4); *(u32x4*)(hb + (size_t)i * 8) = pack8(a, b); *(u32x2*)(hb8 + (size_t)i * 8) = pack8_fp8(a, b); }
      const float* p = (const float*)A.in[IN_P]; bf16_t* pb = (bf16_t*)(ws + WS_PB16);
      for (int i = gt; i < 2 * MTOK * PLE / 8; i += NGT) { const f32x4 a = *(const f32x4*)(p + (size_t)i * 8), b = *(const f32x4*)(p + (size_t)i * 8 + 4); *(u32x4*)(pb + (size_t)i * 8) = pack8(a, b); } }
#if DENSE_DOWN_FP8
    for (int i = gt; i < DM * 8; i += NGT) *(u32x4*)(ws + WS_WFD + (size_t)(i >> 3) * DFF8 + DFF + (i & 7) * 16) = (u32x4){0u, 0u, 0u, 0u};
#endif
    { const int* pos = (const int*)A.in[IN_POS]; float* r64 = (float*)(ws + WS_ROPE64); float* r32 = (float*)(ws + WS_ROPE32);
      for (int i = gt; i < MTOK * 32; i += NGT) { const int tok = i >> 5, j = i & 31; const float inv = 1.0f / powf(10000.0f, (float)(2 * j) / 64.0f); const float ang = (float)pos[tok] * inv;
          float sn, cs; sincosf(ang, &sn, &cs); r64[(size_t)tok * 64 + j] = cs; r64[(size_t)tok * 64 + 32 + j] = sn; }
      for (int i = gt; i < MTOK * 16; i += NGT) { const int tok = i >> 4, j = i & 15; const float inv = 1.0f / powf(10000.0f, (float)(2 * j) / 32.0f); const float ang = (float)pos[tok] * inv;
          float sn, cs; sincosf(ang, &sn, &cs); r32[(size_t)tok * 32 + j] = cs; r32[(size_t)tok * 32 + 16 + j] = sn; } }
    for (int i = gt; i < NLAYER * 32 * DM; i += NGT) { const int L = i / (32 * DM), r = (i / DM) & 31, k = i % DM; const int sc = r < 24 ? SRC_AG + r : SRC_CF + (r - 24);
        ((bf16_t*)(ws + WS_WS))[i] = f2bf(((const float*)A.in[IN_WIN])[((size_t)L * DM + k) * INC + sc]); }
    for (int i = gw; i < NLAYER * 2 * 256; i += NGW) { const int lk = i >> 8, n = i & 255; const float* pe = (const float*)A.in[IN_PE] + (size_t)lk * 2048 + F.lane * 32; const float* w1 = (const float*)A.in[IN_CW1] + (size_t)lk * 2048 * 256 + (size_t)(F.lane * 32) * 256 + n;
        float wv[32];
#pragma unroll
        for (int j = 0; j < 32; ++j) wv[j] = w1[(size_t)j * 256];
        float sacc = 0.f;
#pragma unroll
        for (int j = 0; j < 32; ++j) sacc += pe[j] * wv[j];
        sacc = wave_sum(sacc);
        if (F.lane == 0) ((float*)(ws + WS_CVEC))[i] = sacc + ((const float*)A.in[IN_CB1])[i]; }
}

__device__ __forceinline__ void small_gates(const Frame& F, const bf16_t* hb, const bf16_t* wsm, const float* foxb, float* ga) {
    const int fr = F.lane & 15, fq = F.lane >> 4; const int half = F.wave >> 2, wq = F.wave & 3;
    LAS f32x4* part = (LAS f32x4*)F.lds + wq * 128 + F.lane * 2;
    for (int task0 = F.vcu * 4; task0 < MTOK / 16; task0 += F.G * 4) {
        const int task = task0 + wq;
        const bf16_t* ap = hb + (size_t)(task * 16 + fr) * DM + fq * 8 + half * 1024; const bf16_t* bp = wsm + (size_t)fr * DM + fq * 8 + half * 1024;
        f32x4 acc0 = {0.f, 0.f, 0.f, 0.f}, acc1 = {0.f, 0.f, 0.f, 0.f};
#pragma unroll 1
        for (int ks = 0; ks < 32; ks += 8) {
            bf16x8 a[8], b0[8], b1[8];
#pragma unroll
            for (int j = 0; j < 8; ++j) { a[j] = *(const bf16x8*)(ap + (ks + j) * 32); b0[j] = *(const bf16x8*)(bp + (ks + j) * 32); b1[j] = *(const bf16x8*)(bp + (size_t)16 * DM + (ks + j) * 32); }
#pragma unroll
            for (int j = 0; j < 8; ++j) { acc0 = __builtin_amdgcn_mfma_f32_16x16x32_bf16(b0[j], a[j], acc0, 0, 0, 0); acc1 = __builtin_amdgcn_mfma_f32_16x16x32_bf16(b1[j], a[j], acc1, 0, 0, 0); }
        }
        if (half == 1) { part[0] = acc0; part[1] = acc1; }
        __syncthreads();
        if (half == 0) {
            acc0 = acc0 + part[0]; acc1 = acc1 + part[1];
            float* o = ga + (size_t)(task * 16 + fr) * 32 + 4 * fq;
            *(f32x4*)o = sig4(acc0);
            f32x4 r;
            if (fq < 2) r = sig4(acc1);
            else {
#pragma unroll
                for (int i = 0; i < 4; ++i) { const float x = acc1[i] + foxb[4 * (fq - 2) + i]; r[i] = fminf(x, 0.f) - log1pf(expf(-fabsf(x))); }
            }
            *(f32x4*)(o + 16) = r;
        }
        __syncthreads();
    }
}

__device__ __forceinline__ float gelu_tanh(float x) { const float u = 0.7978845608028654f * (x + 0.044715f * x * x * x); const float e = __expf(2.f * u); const float th = 1.f - 2.f / (e + 1.f); return 0.5f * x * (1.f + th); }
__device__ __forceinline__ void pb_item(const Frame& F, const Args& A, int L, int item) {
    unsigned char* ws = A.ws; unsigned char* R = ws + WS_R;
    if (item < NB * 8) { const int task = item;
        const int b = task >> 3, hh = task & 7; const float* src = (const float*)(ws + WS_GA) + ((size_t)b * SEQ + 8 * F.tid) * 32 + 24 + hh;
        LAS float* wtot = (LAS float*)(F.lds + 32768);
        float v[8];
#pragma unroll
        for (int j = 0; j < 8; ++j) v[j] = src[j * 32];
#pragma unroll
        for (int j = 1; j < 8; ++j) v[j] += v[j - 1];
        float inc = v[7];
#pragma unroll
        for (int o = 1; o < 64; o <<= 1) { const float y = __shfl_up(inc, o); if (F.lane >= o) inc += y; }
        if (F.lane == 63) wtot[F.wave] = inc;
        __syncthreads();
        float base = inc - v[7];
        for (int w = 0; w < F.wave; ++w) base += wtot[w];
        f32x4 o0, o1;
#pragma unroll
        for (int j = 0; j < 4; ++j) { o0[j] = (base + v[j]) * LOG2E; o1[j] = (base + v[4 + j]) * LOG2E; }
        float* dst = (float*)(ws + WS_CUM) + (size_t)task * SEQ + 8 * F.tid;
        *(f32x4*)dst = o0; *(f32x4*)(dst + 4) = o1;
        __syncthreads();
        return;
    }
    LAS float* hid = (LAS float*)(F.lds);
    LAS float* w2s = (LAS float*)(F.lds + 32768 + 1024);
    const int fr = F.lane & 15, fq = F.lane >> 4;
    { const int u = item - NB * 8;
        const int kv = u >> 7, b = (u >> 5) & 3, h = (u >> 4) & 1, ig = u & 15;
        const bf16_t* src = (const bf16_t*)(R + (kv == 0 ? R_AKC : R_AVC)); const bf16_t* w1t = (const bf16_t*)(ws + WS_WC1 + (L * 2 + kv) * SZ_WC1);
        const float* cvec = (const float*)(ws + WS_CVEC) + (L * 2 + kv) * 256; const float* w2 = (const float*)A.in[IN_CW2] + (size_t)(L * 2 + kv) * 256 * 64;
        { f32x4 t[8];
#pragma unroll
          for (int q = 0; q < 8; ++q) t[q] = *(const f32x4*)(w2 + (size_t)(F.tid + 512 * q) * 4);
#pragma unroll
          for (int q = 0; q < 8; ++q) *(LAS f32x4*)(w2s + (F.tid + 512 * q) * 4) = t[q]; }
        int ic = 16 * ig + fr; if (ic > 254) ic = 254;
        const bf16_t* xp = src + ((size_t)b * SEQ + 16 * ic) * 128 + h * 64 + fq * 8;
        const bf16_t* wp = w1t + (size_t)(32 * F.wave + fr) * 2048 + fq * 8;
        f32x4 acc0 = {0.f, 0.f, 0.f, 0.f}, acc1 = {0.f, 0.f, 0.f, 0.f};
#pragma unroll 1
        for (int ks = 0; ks < 64; ks += 16) {
            bf16x8 a[16], b0[16], b1[16];
#pragma unroll
            for (int j = 0; j < 16; ++j) { const int k = ks + j; a[j] = *(const bf16x8*)(xp + (size_t)(k >> 1) * 128 + (k & 1) * 32); b0[j] = *(const bf16x8*)(wp + k * 32); b1[j] = *(const bf16x8*)(wp + (size_t)16 * 2048 + k * 32); }
            asm volatile("s_waitcnt vmcnt(0)" ::: "memory");
#pragma unroll
            for (int j = 0; j < 16; ++j) { acc0 = __builtin_amdgcn_mfma_f32_16x16x32_bf16(b0[j], a[j], acc0, 0, 0, 0); acc1 = __builtin_amdgcn_mfma_f32_16x16x32_bf16(b1[j], a[j], acc1, 0, 0, 0); }
        }
#pragma unroll
        for (int i = 0; i < 4; ++i) { const int c0 = 32 * F.wave + 4 * fq + i; hid[fr * 260 + c0] = gelu_tanh(acc0[i] + cvec[c0]); hid[fr * 260 + c0 + 16] = gelu_tanh(acc1[i] + cvec[c0 + 16]); }
        __syncthreads();
        { const int r = F.tid >> 5, c0 = 2 * (F.tid & 31); float o0 = 0.f, o1 = 0.f;
#pragma unroll 16
          for (int k = 0; k < 256; ++k) { const float hv = hid[r * 260 + k]; const f32x2 w = *(const LAS f32x2*)(w2s + k * 64 + c0); o0 += hv * w.x; o1 += hv * w.y; }
          const int i = 16 * ig + r; if (i == 255) { o0 = 0.f; o1 = 0.f; }
          if (kv == 0) { *(unsigned*)((bf16_t*)(ws + WS_KC) + ((size_t)(b * 2 + h) * 256 + i) * 64 + c0) = cvt_pk_bf16(o0, o1); }
          else { bf16_t* vt = (bf16_t*)(ws + WS_VCT) + ((size_t)(b * 2 + h) * 64 + c0) * 256 + perm23(i); vt[0] = f2bf(o0); vt[256] = f2bf(o1); } }
        __syncthreads();
    }
}

__device__ __forceinline__ void ln_finish(f32x4 (&v)[8], const float* g, const float* bt, float* outf, bf16_t* outb, int lane, unsigned char* out8 = nullptr) {
    float s = 0.f;
#pragma unroll
    for (int j = 0; j < 8; ++j) s += (v[j][0] + v[j][1]) + (v[j][2] + v[j][3]);
    const float mean = wave_sum(s) * (1.f / DM); float s2 = 0.f;
#pragma unroll
    for (int j = 0; j < 8; ++j) { v[j] = v[j] - mean; s2 += (v[j][0] * v[j][0] + v[j][1] * v[j][1]) + (v[j][2] * v[j][2] + v[j][3] * v[j][3]); }
    const float rstd = 1.f / sqrtf(wave_sum(s2) * (1.f / DM) + LN_EPS);
#pragma unroll
    for (int j = 0; j < 8; ++j) { const int c = 4 * lane + 256 * j; v[j] = v[j] * rstd * *(const f32x4*)(g + c) + *(const f32x4*)(bt + c);
        if (outf) *(f32x4*)(outf + c) = v[j];
        if (outb) *(u32x2*)(outb + c) = pack4(v[j]);
        if (out8) { unsigned w = 0u; w = __builtin_amdgcn_cvt_pk_fp8_f32(v[j][0], v[j][1], w, false); w = __builtin_amdgcn_cvt_pk_fp8_f32(v[j][2], v[j][3], w, true); *(unsigned*)(out8 + c) = w; } }
}

#if PRE_BF16
typedef u32x2 PRE_T;
#define LDPRE(base_, off_) (*(const u32x2*)((const bf16_t*)(base_) + (off_)))
__device__ __forceinline__ f32x4 CVPRE(u32x2 w) { f32x4 r; r[0] = bflo(w.x); r[1] = bfhi(w.x); r[2] = bflo(w.y); r[3] = bfhi(w.y); return r; }
#else
typedef f32x4 PRE_T;
#define LDPRE(base_, off_) (*(const f32x4*)((const float*)(base_) + (off_)))
__device__ __forceinline__ f32x4 CVPRE(f32x4 w) { return w; }
#endif
__device__ __forceinline__ void pf_phase(const Frame& F, const Args& A, int L, bool moe, const float* hin) {
    unsigned char* ws = A.ws; const float* pre = (const float*)(ws + WS_R + R_PRE);
    const float* g = (const float*)A.in[IN_LN1G] + L * DM; const float* bt = (const float*)A.in[IN_LN1B] + L * DM;
    float* hf = (float*)(ws + WS_HF); bf16_t* hb = (bf16_t*)(ws + WS_HB) + (size_t)MTOK * DM;
    LAS float* wr = (LAS float*)F.lds;
    LAS int* cnt = (LAS int*)(F.lds + 65536);
    if (moe) { const float* rw = (const float*)A.in[IN_ROUTER];
        for (int i = F.tid; i < DM * NEXP; i += NTHREADS) { const int d = i >> 3, e = i & 7; wr[e * DM + d] = rw[i]; }
    }
    for (int c = F.vcu; c < MTOK / 64; c += F.G) {
        if (moe) { if (F.tid < 8) cnt[F.tid] = 0; }
        __syncthreads();
        f32x4 na[8]; PRE_T nb[8];
        { const size_t o0 = (size_t)(64 * c + 8 * F.wave) * DM + 4 * F.lane;
#pragma unroll
          for (int q = 0; q < 8; ++q) { na[q] = *(const f32x4*)(hin + o0 + 256 * q); nb[q] = LDPRE(pre, o0 + 256 * q); } }
#pragma unroll 1
        for (int j = 0; j < 8; ++j) {
            const int row = 64 * c + 8 * F.wave + j;
            f32x4 v[8];
#pragma unroll
            for (int q = 0; q < 8; ++q) v[q] = na[q] * ALPHA + CVPRE(nb[q]);
            if (j + 1 < 8) { const size_t o1 = (size_t)(row + 1) * DM + 4 * F.lane;
#pragma unroll
                for (int q = 0; q < 8; ++q) { na[q] = *(const f32x4*)(hin + o1 + 256 * q); nb[q] = LDPRE(pre, o1 + 256 * q); } }
            ln_finish(v, g, bt, RES_BF16 ? nullptr : hf + (size_t)row * DM, (moe && !RES_BF16) ? nullptr : hb + (size_t)row * DM, F.lane, (moe || PLE0_FP8) ? ws + WS_HB8 + (size_t)row * DM : nullptr);
            if (moe) {
                float lg[8];
#pragma unroll
                for (int e = 0; e < 8; ++e) { float s = 0.f;
#pragma unroll
                    for (int q = 0; q < 8; ++q) { const f32x4 w = *(const LAS f32x4*)(wr + e * DM + 4 * F.lane + 256 * q); s += (v[q][0] * w[0] + v[q][1] * w[1]) + (v[q][2] * w[2] + v[q][3] * w[3]); }
                    lg[e] = wave_sum(s) + ((const float*)A.in[IN_ROUTERB])[e]; }
                int i0 = 0; float v0 = lg[0];
#pragma unroll
                for (int e = 1; e < 8; ++e) if (lg[e] > v0) { v0 = lg[e]; i0 = e; }
                int i1 = -1; float v1 = -3.0e38f;
#pragma unroll
                for (int e = 0; e < 8; ++e) if (e != i0 && lg[e] > v1) { v1 = lg[e]; i1 = e; }
                const float e1 = __expf(v1 - v0), w0 = 1.f / (1.f + e1), w1 = e1 * w0;
                if (F.lane == 0) { int* re = (int*)(ws + WS_ROUTE + RT_E); float* rwt = (float*)(ws + WS_ROUTE + RT_W);
                    re[2 * row] = i0; re[2 * row + 1] = i1; rwt[2 * row] = w0; rwt[2 * row + 1] = w1;
                    __hip_atomic_fetch_add(cnt + i0, 1, __ATOMIC_RELAXED, __HIP_MEMORY_SCOPE_WORKGROUP); __hip_atomic_fetch_add(cnt + i1, 1, __ATOMIC_RELAXED, __HIP_MEMORY_SCOPE_WORKGROUP); }
            }
        }
        __syncthreads();
        if (moe && F.tid < 8) ((int*)(ws + WS_ROUTE + RT_CNT))[c * 8 + F.tid] = cnt[F.tid];
    }
}

__device__ __forceinline__ void moe_scatter(const Frame& F, const Args& A) {
    unsigned char* ws = A.ws;
    const int* cntg = (const int*)(ws + WS_ROUTE + RT_CNT); const int* re = (const int*)(ws + WS_ROUTE + RT_E); const float* rwt = (const float*)(ws + WS_ROUTE + RT_W);
    int* toksrow = (int*)(ws + WS_ROUTE + RT_TOKSROW); float* sroww = (float*)(ws + WS_ROUTE + RT_SROWW); int* panel = (int*)(ws + WS_ROUTE + RT_PANEL);
    const bf16_t* hb = (const bf16_t*)(ws + WS_HB) + (size_t)MTOK * DM; unsigned char* hs = ws + WS_R + R_HS;
    LAS int* tot = (LAS int*)F.lds; LAS int* part = tot + 8; LAS int* off = tot + 16; LAS int* ee = tot + 32; LAS int* srow = tot + 160; LAS int* cnt0 = tot + 24;
    for (int c = F.vcu; c < MTOK / 64; c += F.G) {
        { const int e = F.wave; int t = 0, p = 0;
#pragma unroll
          for (int q = 0; q < 4; ++q) { const int cc = 4 * F.lane + q; const int v = cntg[cc * 8 + e]; t += v; p += (cc < c) ? v : 0; }
#pragma unroll
          for (int o = 1; o < 64; o <<= 1) { t += __shfl_xor(t, o); p += __shfl_xor(p, o); }
          if (F.lane == 0) { tot[e] = t; part[e] = p; } }
        if (F.tid < 128) ee[F.tid] = re[128 * c + F.tid];
        __syncthreads();
        if (F.tid == 0) { int o = 0, np = 0;
            for (int e = 0; e < 8; ++e) { off[e] = o; const int npan = (tot[e] + 255) >> 8;
                if (c == 0) for (int q = 0; q < npan; ++q) panel[1 + np + q] = e;
                np += npan; o += npan * 256; }
            if (c == 0) panel[0] = np; }
        __syncthreads();
        int rank_ = 0, e_ = 0;
        if (F.tid < 128) { e_ = ee[F.tid];
#pragma unroll
            for (int k = 0; k < 8; ++k) { const unsigned long long m_ = __ballot(e_ == k); if (e_ == k) rank_ = __popcll(m_ & ((1ull << F.lane) - 1ull)); if (F.tid == 0) cnt0[k] = __popcll(m_); } }
        __syncthreads();
        if (F.tid < 128) { const int e = e_; const int rank = rank_ + (F.tid >= 64 ? cnt0[e] : 0);
            const int sr = off[e] + part[e] + rank; srow[F.tid] = sr; toksrow[128 * c + F.tid] = sr; sroww[sr] = rwt[128 * c + F.tid]; }
        __syncthreads();
        for (int q = 0; q < 16; ++q) { const int ent = F.wave * 16 + q; const int tok = 64 * c + (ent >> 1); const int sr = srow[ent];
            const u32x4* s = (const u32x4*)(ws + WS_HB8 + (size_t)tok * DM); u32x4* d = (u32x4*)(hs + (size_t)sr * DM);
#pragma unroll
            for (int k = 0; k < 2; ++k) d[F.lane + 64 * k] = s[F.lane + 64 * k]; }
        __syncthreads();
    }
}

__device__ __forceinline__ void pi_phase(const Frame& F, const Args& A, int L, bool moe) {
    unsigned char* ws = A.ws;
    const float* g = (const float*)A.in[IN_LN2G] + L * DM; const float* bt = (const float*)A.in[IN_LN2B] + L * DM;
    const bool last = (L == NLAYER - 1);
    float* outf = last ? A.out : (float*)(ws + WS_HF) + (size_t)MTOK * DM; bf16_t* outb = last ? nullptr : (bf16_t*)(ws + WS_HB);
    const int gw = F.vcu * NWAVES + F.wave, NGW = F.G * NWAVES;
    const bf16_t* hb1 = (const bf16_t*)(ws + WS_HB) + (size_t)MTOK * DM; const float* hf1 = (const float*)(ws + WS_HF);
    const float* pre2 = (const float*)(ws + WS_R + R_PRE2); const bf16_t* ple = moe ? (const bf16_t*)(ws + WS_HF + (size_t)MTOK * DM * 4) : (const bf16_t*)(ws + WS_R + R_PLE);
    const int* ts = (const int*)(ws + WS_ROUTE + RT_TOKSROW); const bf16_t* ys = (const bf16_t*)(ws + WS_R + R_YS);
    u32x2 nh[8], np[8], ny0[8], ny1[8]; PRE_T nf[8]; f32x4 nhf[8]; int t0n = 0, t1n = 0;
#define PI_LOAD(row_, i0_, i1_) do { const size_t o_ = (size_t)(row_) * DM + 4 * F.lane; _Pragma("unroll") for (int q = 0; q < 8; ++q) { \
        if (RES_BF16) nh[q] = *(const u32x2*)(hb1 + o_ + 256 * q); else nhf[q] = *(const f32x4*)(hf1 + o_ + 256 * q); \
        np[q] = *(const u32x2*)(ple + o_ + 256 * q); \
        if (!moe) nf[q] = LDPRE(pre2, o_ + 256 * q); \
        else { ny0[q] = *(const u32x2*)(ys + (size_t)(i0_) * DM + 4 * F.lane + 256 * q); ny1[q] = *(const u32x2*)(ys + (size_t)(i1_) * DM + 4 * F.lane + 256 * q); } } } while (0)
    if (gw < MTOK) { if (moe) { t0n = ts[2 * gw]; t1n = ts[2 * gw + 1]; } PI_LOAD(gw, t0n, t1n); if (moe && gw + NGW < MTOK) { t0n = ts[2 * (gw + NGW)]; t1n = ts[2 * (gw + NGW) + 1]; } }
#pragma unroll 1
    for (int row = gw; row < MTOK; row += NGW) {
        f32x4 v[8];
#pragma unroll
        for (int q = 0; q < 8; ++q) { f32x4 h; if (RES_BF16) { h[0] = bflo(nh[q].x); h[1] = bfhi(nh[q].x); h[2] = bflo(nh[q].y); h[3] = bfhi(nh[q].y); } else h = nhf[q];
            f32x4 r; const u32x2 p = np[q];
            if (!moe) { r[0] = bflo(p.x); r[1] = bfhi(p.x); r[2] = bflo(p.y); r[3] = bfhi(p.y); r = CVPRE(nf[q]) + r; }
            else { const u32x2 a = ny0[q], b = ny1[q]; r[0] = (bflo(a.x) + bflo(b.x)) + bflo(p.x); r[1] = (bfhi(a.x) + bfhi(b.x)) + bfhi(p.x); r[2] = (bflo(a.y) + bflo(b.y)) + bflo(p.y); r[3] = (bfhi(a.y) + bfhi(b.y)) + bfhi(p.y); }
            v[q] = h * ALPHA + r; }
        const int nrow = row + NGW;
        if (nrow < MTOK) { PI_LOAD(nrow, t0n, t1n); if (moe && nrow + NGW < MTOK) { t0n = ts[2 * (nrow + NGW)]; t1n = ts[2 * (nrow + NGW) + 1]; } }
        ln_finish(v, g, bt, outf + (size_t)row * DM, outb ? outb + (size_t)row * DM : nullptr, F.lane, last ? nullptr : ws + WS_HB8 + (size_t)row * DM);
    }
#undef PI_LOAD
}

namespace att {
constexpr int TP = 144, TILE_B = 64 * TP, STAGE_B = 2 * TILE_B + 256;
constexpr int L_WS = 2 * STAGE_B;
constexpr int IMP_P = 68;
constexpr int L_IMP = L_WS + 8 * 256;
constexpr int L_SEL = L_IMP + 4 * 64 * IMP_P * 4;
constexpr int L_UID = L_SEL + 512;
static_assert(L_UID + 64 <= RING_BYTES, "attention LDS map");
constexpr int NEGBIG_I = -(1 << 29);
constexpr float NEG_INF = -__builtin_inff();

struct Stream { const bf16_t* K; const bf16_t* VT; const float* bias; int ldk, ldv; };
struct State { float m, l; f32x16 o0, o1; };
__device__ __forceinline__ void state_init(State& S) { S.m = 0.f; S.l = -1.f;
#pragma unroll
    for (int r = 0; r < 16; ++r) { S.o0[r] = 0.f; S.o1[r] = 0.f; } }
__device__ __forceinline__ float swap_max(float v) { auto rr = __builtin_amdgcn_permlane32_swap(__float_as_uint(v), __float_as_uint(v), false, false); return fmaxf(__uint_as_float(rr[0]), __uint_as_float(rr[1])); }
__device__ __forceinline__ float swap_sum(float v) { auto rr = __builtin_amdgcn_permlane32_swap(__float_as_uint(v), __float_as_uint(v), false, false); return __uint_as_float(rr[0]) + __uint_as_float(rr[1]); }

template <bool BIAS>
__device__ __forceinline__ void stage_issue(const Stream& s, int tile, int tid, u32x4& kr, u32x4& vr, f32x4& br) {
    const int row = tid >> 3, ch = tid & 7;
    kr = *(const u32x4*)(s.K + (size_t)(tile * 64 + row) * s.ldk + ch * 8);
    vr = *(const u32x4*)(s.VT + (size_t)row * s.ldv + tile * 64 + ch * 8);
    if (BIAS) { if (tid < 16) br = *(const f32x4*)(s.bias + tile * 64 + tid * 4); }
}
template <bool BIAS>
__device__ __forceinline__ void stage_write(LAS unsigned char* st, int tid, const u32x4& kr, const u32x4& vr, const f32x4& br) {
    const int row = tid >> 3, ch = tid & 7;
    *(LAS u32x4*)(st + row * TP + ch * 16) = kr; *(LAS u32x4*)(st + TILE_B + row * TP + ch * 16) = vr;
    if (BIAS) { if (tid < 16) *(LAS f32x4*)(st + 2 * TILE_B + tid * 16) = br; }
}
template <bool BIAS, int D0A, int D0B>
__device__ __forceinline__ void tile_scores(const LAS unsigned char* st, const bf16x8 (&qf)[4], int kb, int kv_lo, int kv_hi, bool need_lo, bool need_hi, float cinit, f32x16& p0, f32x16& p1, int r32, int hi) {
#pragma unroll
    for (int r = 0; r < 16; ++r) { p0[r] = cinit; p1[r] = cinit; }
    const LAS unsigned char* kp = st + r32 * TP + hi * 16;
    bf16x8 kf0[D0B - D0A], kf1[D0B - D0A];
#pragma unroll
    for (int d0 = D0A; d0 < D0B; ++d0) { kf0[d0 - D0A] = *(const LAS bf16x8*)(kp + d0 * 32); kf1[d0 - D0A] = *(const LAS bf16x8*)(kp + 32 * TP + d0 * 32); }
    LDS_WAIT(); __builtin_amdgcn_sched_barrier(0);
#pragma unroll
    for (int d0 = D0A; d0 < D0B; ++d0) { p0 = __builtin_amdgcn_mfma_f32_32x32x16_bf16(kf0[d0 - D0A], qf[d0], p0, 0, 0, 0); p1 = __builtin_amdgcn_mfma_f32_32x32x16_bf16(kf1[d0 - D0A], qf[d0], p1, 0, 0, 0); }
    if (BIAS) { const LAS float* bp = (const LAS float*)(st + 2 * TILE_B) + 4 * hi;
#pragma unroll
        for (int g = 0; g < 4; ++g) { const f32x4 b0 = *(const LAS f32x4*)(bp + 8 * g), b1 = *(const LAS f32x4*)(bp + 32 + 8 * g);
#pragma unroll
            for (int i = 0; i < 4; ++i) { p0[4 * g + i] -= b0[i]; p1[4 * g + i] -= b1[i]; } } }
    if (need_hi) { asm volatile("; mask hi" ::: "memory"); const int thr = kv_hi - kb - 4 * hi;
#pragma unroll
        for (int r = 0; r < 16; ++r) { const int c = (r & 3) + 8 * (r >> 2); if (c > thr) p0[r] = NEG_INF; if (c + 32 > thr) p1[r] = NEG_INF; } }
    if (need_lo) { asm volatile("; mask lo" ::: "memory"); const int thr = kv_lo - kb - 4 * hi;
#pragma unroll
        for (int r = 0; r < 16; ++r) { const int c = (r & 3) + 8 * (r >> 2); if (c < thr) p0[r] = NEG_INF; if (c + 32 < thr) p1[r] = NEG_INF; } }
}
constexpr float RESC_THR = 8.0f;
#define MAX3F(a, b, c) __builtin_fmaxf(__builtin_fmaxf((a), (b)), (c))
template <bool BIAS, int D0A, int D0B, bool NOPV = false>
__device__ __forceinline__ void tile_compute(const LAS unsigned char* st, const bf16x8 (&qf)[4], int kb, int kv_lo, int kv_hi, bool need_lo, bool need_hi, float cinit, State& S, LAS float* wsf, int r32, int hi) {
    f32x16 p0, p1;
    tile_scores<BIAS, D0A, D0B>(st, qf, kb, kv_lo, kv_hi, need_lo, need_hi, cinit - S.m, p0, p1, r32, hi);
    __builtin_amdgcn_sched_barrier(0);
    bf16x8 vf0[4], vf1[4];
    if (!NOPV) { const LAS unsigned char* vp_ = st + TILE_B + r32 * TP + hi * 16;
#pragma unroll
        for (int s = 0; s < 4; ++s) { vf0[s] = *(const LAS bf16x8*)(vp_ + s * 32); vf1[s] = *(const LAS bf16x8*)(vp_ + 32 * TP + s * 32); }
        __builtin_amdgcn_sched_barrier(0); }
    float ma = MAX3F(p0[0], p0[1], p1[0]), mb = MAX3F(p0[2], p0[3], p1[1]); ma = MAX3F(ma, p1[2], p1[3]);
#pragma unroll
    for (int r = 4; r < 16; r += 4) { ma = MAX3F(ma, p0[r], p0[r + 1]); mb = MAX3F(mb, p0[r + 2], p0[r + 3]); ma = MAX3F(ma, p1[r], p1[r + 1]); mb = MAX3F(mb, p1[r + 2], p1[r + 3]); }
    const float mx = swap_max(fmaxf(ma, mb));
    const bool fresh = (S.l < 0.f);
    float dl = fresh ? (mx > -1.0e30f ? mx : 0.f) : fmaxf(mx, 0.f);
    const bool move = fresh ? (mx > -1.0e30f) : (dl > RESC_THR);
    if (__any(move)) {
        if (!move) dl = 0.f;
        S.m += dl;
#pragma unroll
        for (int r = 0; r < 16; ++r) { p0[r] -= dl; p1[r] -= dl; }
        const float alpha = fast_exp2(-dl);
        if (fresh) { if (mx > -1.0e30f) S.l = 0.f; } else S.l *= alpha;
        if (!NOPV) {
            if (hi == 0) wsf[r32] = fresh ? 1.f : alpha;
            LDS_WAIT();
#pragma unroll
            for (int g = 0; g < 4; ++g) { const f32x4 a = *(const LAS f32x4*)(wsf + 8 * g + 4 * hi);
#pragma unroll
                for (int i = 0; i < 4; ++i) { S.o0[4 * g + i] *= a[i]; S.o1[4 * g + i] *= a[i]; } }
            LDS_WAIT();
        }
    }
    float sum = 0.f;
#pragma unroll
    for (int r = 0; r < 16; ++r) { p0[r] = fast_exp2(p0[r]); p1[r] = fast_exp2(p1[r]); sum += p0[r] + p1[r]; }
    if (S.l >= 0.f) S.l += sum;
    if (NOPV) return;
    u32x4 pw[4];
#pragma unroll
    for (int k = 0; k < 4; ++k) { pw[0][k] = cvt_pk_bf16(p0[2 * k], p0[2 * k + 1]); pw[1][k] = cvt_pk_bf16(p0[8 + 2 * k], p0[9 + 2 * k]); pw[2][k] = cvt_pk_bf16(p1[2 * k], p1[2 * k + 1]); pw[3][k] = cvt_pk_bf16(p1[8 + 2 * k], p1[9 + 2 * k]); }
    LDS_WAIT(); __builtin_amdgcn_sched_barrier(0);
#pragma unroll
    for (int s = 0; s < 4; ++s) {
        const bf16x8 pa = __builtin_bit_cast(bf16x8, pw[s]);
        S.o0 = __builtin_amdgcn_mfma_f32_32x32x16_bf16(pa, vf0[s], S.o0, 0, 0, 0); S.o1 = __builtin_amdgcn_mfma_f32_32x32x16_bf16(pa, vf1[s], S.o1, 0, 0, 0);
    }
}
__device__ __forceinline__ void seg_finish(const State& S, float gate, float extra_l, f32x16& a0, f32x16& a1, LAS float* wsf, int r32, int hi) {
    const float lt = swap_sum(fmaxf(S.l, 0.f)) + extra_l; const float f = lt > 0.f ? gate / lt : 0.f;
    if (hi == 0) wsf[r32] = f;
    LDS_WAIT();
#pragma unroll
    for (int g = 0; g < 4; ++g) { const f32x4 a = *(const LAS f32x4*)(wsf + 8 * g + 4 * hi);
#pragma unroll
        for (int i = 0; i < 4; ++i) { a0[4 * g + i] += S.o0[4 * g + i] * a[i]; a1[4 * g + i] += S.o1[4 * g + i] * a[i]; } }
    LDS_WAIT();
}
__device__ __forceinline__ void seg_finish_lds(const State& S, float gate, LAS float* accl, bool first, LAS float* wsf, int r32, int hi) {
    const float lt = swap_sum(fmaxf(S.l, 0.f)); const float f = lt > 0.f ? gate / lt : 0.f;
    if (hi == 0) wsf[r32] = f;
    LDS_WAIT();
#pragma unroll
    for (int g = 0; g < 4; ++g) { const f32x4 a = *(const LAS f32x4*)(wsf + 8 * g + 4 * hi);
#pragma unroll
        for (int i = 0; i < 4; ++i) { LAS float* p = accl + (8 * g + 4 * hi + i) * 64 + r32; const float x0 = S.o0[4 * g + i] * a[i], x1 = S.o1[4 * g + i] * a[i];
            if (first) { p[0] = x0; p[32] = x1; } else { p[0] += x0; p[32] += x1; } } }
    LDS_WAIT();
}
template <bool BIAS, bool SEL, bool DUAL, bool NOPV = false>
__device__ __forceinline__ void run_seg(LAS unsigned char* lds, const Stream& s, int t_lo, int t_hi, const bf16x8 (&qf)[4], int kv_lo, int kv_hi, unsigned sel_lo, unsigned sel_hi,
                                        State& S, State& S2, LAS float* wsf, int tid, int r32, int hi) {
    asm volatile("" : "+v"(tid));
    u32x4 kr, vr; f32x4 br = {0.f, 0.f, 0.f, 0.f};
    const int hi_min = __builtin_amdgcn_readlane(kv_hi, 0), hi_max = __builtin_amdgcn_readlane(kv_hi, 31), lo_min = __builtin_amdgcn_readlane(kv_lo, 0), lo_max = __builtin_amdgcn_readlane(kv_lo, 31);
    stage_issue<BIAS>(s, t_lo, tid, kr, vr, br); stage_write<BIAS>(lds, tid, kr, vr, br);
    __syncthreads();
    for (int t = t_lo; t < t_hi; ++t) {
        const int cur = (t - t_lo) & 1; const bool more = (t + 1 < t_hi);
        if (more) stage_issue<BIAS>(s, t + 1, tid, kr, vr, br);
        const int kb = 64 * t;
        bool active = !(kb > hi_max || kb + 63 < lo_min);
        float cinit = 0.f;
        if (SEL) { const unsigned bit = (t < 32) ? ((sel_lo >> t) & 1u) : ((sel_hi >> (t - 32)) & 1u); cinit = bit ? 0.f : NEG_INF; active = active && __any(bit != 0u); }
        if (active) {
            const LAS unsigned char* st = lds + cur * STAGE_B; const bool nlo = kb < lo_max, nhi = kb + 63 > hi_min;
            if (DUAL) { tile_compute<false, 0, 2>(st, qf, kb, kv_lo, kv_hi, nlo, nhi, cinit, S, wsf, r32, hi); tile_compute<false, 2, 4>(st, qf, kb, kv_lo, kv_hi, nlo, nhi, cinit, S2, wsf, r32, hi); }
            else tile_compute<BIAS, 0, 4, NOPV>(st, qf, kb, kv_lo, kv_hi, nlo, nhi, cinit, S, wsf, r32, hi);
        }
        if (more) stage_write<BIAS>(lds + (cur ^ 1) * STAGE_B, tid, kr, vr, br);
        __syncthreads();
    }
}
__device__ __forceinline__ void load_q(bf16x8 (&qf)[4], const bf16_t* qrow, int hi) {
#pragma unroll
    for (int d0 = 0; d0 < 4; ++d0) qf[d0] = *(const bf16x8*)(qrow + d0 * 16 + hi * 8);
}
#if PD_FP8
typedef unsigned char br_t;
__device__ __forceinline__ void store_o(const f32x16& a0, const f32x16& a1, br_t* base, int hi, int r32) {
#pragma unroll
    for (int r = 0; r < 16; ++r) { const int q = (r & 3) + 8 * (r >> 2) + 4 * hi; br_t* p = base + (size_t)q * DM + r32; const unsigned w = __builtin_amdgcn_cvt_pk_fp8_f32(a0[r] * BR8_SCALE, a1[r] * BR8_SCALE, 0u, false); p[0] = (br_t)(w & 0xffu); p[32] = (br_t)((w >> 8) & 0xffu); }
}
#else
typedef bf16_t br_t;
#endif
#if !PD_FP8
__device__ __forceinline__ void store_o(const f32x16& a0, const f32x16& a1, bf16_t* base, int hi, int r32) {
#pragma unroll
    for (int r = 0; r < 16; ++r) { const int q = (r & 3) + 8 * (r >> 2) + 4 * hi; bf16_t* p = base + (size_t)q * DM + r32; p[0] = f2bf(a0[r]); p[32] = f2bf(a1[r]); }
}
#endif

struct Ctx { LAS unsigned char* lds; unsigned char* ws; unsigned char* R; const float* dlam; const float* dgain; const float* sink; int L, tid, lane, wave, r32, hi; LAS float* wsf; };

__device__ __forceinline__ void fox_unit(const Ctx& C, int b, int h, int qb) {
    const int tq = 256 * qb + 32 * C.wave + C.r32;
    bf16x8 qf[4]; load_q(qf, (const bf16_t*)(C.R + R_CQ) + ((size_t)b * SEQ + tq) * 512 + h * 64, C.hi);
    Stream s; s.K = (const bf16_t*)(C.R + R_CK) + (size_t)b * SEQ * 512 + h * 64; s.ldk = 512; s.VT = (const bf16_t*)(C.R + R_CVT) + (size_t)(b * 8 + h) * 64 * SEQ; s.ldv = SEQ;
    s.bias = (const float*)(C.ws + WS_CUM) + (size_t)(b * 8 + h) * SEQ;
    State S; state_init(S);
    run_seg<true, false, false>(C.lds, s, 0, 4 * (qb + 1), qf, NEGBIG_I, tq, 0u, 0u, S, S, C.wsf, C.tid, C.r32, C.hi);
    f32x16 a0, a1;
#pragma unroll
    for (int r = 0; r < 16; ++r) { a0[r] = 0.f; a1[r] = 0.f; }
    seg_finish(S, 1.f, 0.f, a0, a1, C.wsf, C.r32, C.hi);
    store_o(a0, a1, (br_t*)(C.R + R_BR) + ((size_t)b * SEQ + 256 * qb + 32 * C.wave) * DM + 2 * 512 + h * 64, C.hi, C.r32);
}
__device__ __forceinline__ void diff_unit(const Ctx& C, int b, int h, int qb) {
    const int tq = 256 * qb + 32 * C.wave + C.r32;
    bf16x8 qf[4]; load_q(qf, (const bf16_t*)(C.R + R_DQ) + ((size_t)b * SEQ + tq) * 512 + h * 64, C.hi);
    Stream s; s.K = (const bf16_t*)(C.R + R_DK) + (size_t)b * SEQ * 512 + h * 64; s.ldk = 512; s.VT = (const bf16_t*)(C.R + R_DVT) + (size_t)(b * 8 + h) * 64 * SEQ; s.ldv = SEQ; s.bias = nullptr;
    const float* lf = C.dlam + C.L * 128; const int j = C.lane & 31;
    const float sa = wave_sum(C.lane < 32 ? lf[j] * lf[32 + j] : 0.f), sb = wave_sum(C.lane < 32 ? lf[64 + j] * lf[96 + j] : 0.f);
    const float lam_init = C.L == 0 ? 0.2f : 0.35550906759096314f;
    const float lam = __expf(sa) - __expf(sb) + lam_init;
    State S0, S1; state_init(S0); state_init(S1);
    run_seg<false, false, true>(C.lds, s, 0, 4 * (qb + 1), qf, NEGBIG_I, tq, 0u, 0u, S0, S1, C.wsf, C.tid, C.r32, C.hi);
    f32x16 a0, a1;
#pragma unroll
    for (int r = 0; r < 16; ++r) { a0[r] = 0.f; a1[r] = 0.f; }
    seg_finish(S0, 1.f, 0.f, a0, a1, C.wsf, C.r32, C.hi);
    seg_finish(S1, -lam, 0.f, a0, a1, C.wsf, C.r32, C.hi);
    const float* gain = C.dgain + C.L * 64; const float g0 = gain[C.r32] * (1.f - lam_init), g1 = gain[32 + C.r32] * (1.f - lam_init);
#pragma unroll
    for (int r = 0; r < 16; ++r) { float ss = a0[r] * a0[r] + a1[r] * a1[r];
#pragma unroll
        for (int o = 1; o < 32; o <<= 1) ss += __shfl_xor(ss, o);
        const float rs = 1.f / sqrtf(ss * (1.f / 64.f) + LN_EPS); a0[r] = a0[r] * rs * g0; a1[r] = a1[r] * rs * g1; }
    store_o(a0, a1, (br_t*)(C.R + R_BR) + ((size_t)b * SEQ + 256 * qb + 32 * C.wave) * DM + 3 * 512 + h * 64, C.hi, C.r32);
}
__device__ __forceinline__ void swa_unit(const Ctx& C, int b, int kvh, int tt) {
    const int g = C.wave & 3, sub = C.wave >> 2, hq = kvh * 4 + g; const int tq = 64 * tt + 32 * sub + C.r32;
    bf16x8 qf[4]; load_q(qf, (const bf16_t*)(C.R + R_BQ) + ((size_t)b * SEQ + tq) * 512 + hq * 64, C.hi);
    Stream s; s.K = (const bf16_t*)(C.R + R_BK) + (size_t)b * SEQ * 128 + kvh * 64; s.ldk = 128; s.VT = (const bf16_t*)(C.R + R_BVT) + (size_t)(b * 2 + kvh) * 64 * SEQ; s.ldv = SEQ; s.bias = nullptr;
    State S; state_init(S);
    run_seg<false, false, false>(C.lds, s, tt >= 2 ? tt - 2 : 0, tt + 1, qf, tq - 127, tq, 0u, 0u, S, S, C.wsf, C.tid, C.r32, C.hi);
    const float sink2 = C.sink[C.L * 8 + hq] * LOG2E;
    f32x16 a0, a1;
#pragma unroll
    for (int r = 0; r < 16; ++r) { a0[r] = 0.f; a1[r] = 0.f; }
    seg_finish(S, 1.f, fast_exp2(sink2 - S.m), a0, a1, C.wsf, C.r32, C.hi);
    store_o(a0, a1, (br_t*)(C.R + R_BR) + ((size_t)b * SEQ + 64 * tt + 32 * sub) * DM + 1 * 512 + hq * 64, C.hi, C.r32);
}
__device__ __forceinline__ void nsa_unit(const Ctx& C, int b, int kvh, int tt) {
    const int g = C.wave & 3, sub = C.wave >> 2, hq = kvh * 4 + g; const int tq = 64 * tt + 32 * sub + C.r32;
    const int tid = C.tid, r32 = C.r32, hi = C.hi;
    bf16x8 qf[4]; load_q(qf, (const bf16_t*)(C.R + R_AQ) + ((size_t)b * SEQ + tq) * 512 + hq * 64, hi);
    LAS float* tbl = (LAS float*)(C.lds + L_IMP); LAS unsigned* selw = (LAS unsigned*)(C.lds + L_SEL);
    LAS float* accl = tbl + C.wave * 2048;
    unsigned char* wsb; { unsigned long long x_ = (unsigned long long)C.ws; asm volatile("" : "+s"(x_)); wsb = (unsigned char*)(GAS unsigned char*)x_; }
    Stream sc; sc.K = (const bf16_t*)(wsb + WS_KC) + (size_t)(b * 2 + kvh) * 256 * 64; sc.ldk = 64; sc.VT = (const bf16_t*)(wsb + WS_VCT) + (size_t)(b * 2 + kvh) * 64 * 256; sc.ldv = 256; sc.bias = nullptr;
    const int kvhi_c = (tq - 31) >> 4; const int ntc = ((4 * tt + 2) >> 6) + 1;
    State S; state_init(S);
    run_seg<false, false, false>(C.lds, sc, 0, ntc, qf, NEGBIG_I, kvhi_c, 0u, 0u, S, S, C.wsf, tid, r32, hi);
    const float m1 = S.m; const float l1 = swap_sum(fmaxf(S.l, 0.f)); const float rl1 = l1 > 0.f ? 1.f / l1 : 0.f;
    for (int i = tid; i < 4 * 64 * IMP_P; i += NTHREADS) tbl[i] = 0.f;
    {
        int tid2 = C.tid; asm volatile("" : "+v"(tid2));
        u32x4 kr, vr; f32x4 br = {0.f, 0.f, 0.f, 0.f};
        const int hi_min = __builtin_amdgcn_readlane(kvhi_c, 0), hi_max = __builtin_amdgcn_readlane(kvhi_c, 31);
        stage_issue<false>(sc, 0, tid2, kr, vr, br); stage_write<false>(C.lds, tid2, kr, vr, br);
        __syncthreads();
        LAS float* trow = tbl + (g * 64 + 32 * sub + r32) * IMP_P;
        for (int t = 0; t < ntc; ++t) {
            const int cur = t & 1; const bool more = (t + 1 < ntc);
            if (more) stage_issue<false>(sc, t + 1, tid2, kr, vr, br);
            const int kb = 64 * t;
            if (kb <= hi_max) {
                f32x16 p0, p1;
                tile_scores<false, 0, 4>(C.lds + cur * STAGE_B, qf, kb, NEGBIG_I, kvhi_c, false, kb + 63 > hi_min, 0.f, p0, p1, r32, hi);
#pragma unroll
                for (int r = 0; r < 16; ++r) { p0[r] = fast_exp2(p0[r] - m1) * rl1; p1[r] = fast_exp2(p1[r] - m1) * rl1; }
#pragma unroll
                for (int g4 = 0; g4 < 4; ++g4) {
                    const float x0 = 2.f * ((p0[4 * g4] + p0[4 * g4 + 1]) + p0[4 * g4 + 2]) + p0[4 * g4 + 3], x1 = 2.f * ((p1[4 * g4] + p1[4 * g4 + 1]) + p1[4 * g4 + 2]) + p1[4 * g4 + 3];
                    const int j = 16 * t + 2 * g4 + hi;
                    __hip_atomic_fetch_add(trow + j, x0, __ATOMIC_RELAXED, __HIP_MEMORY_SCOPE_WORKGROUP); __hip_atomic_fetch_add(trow + j + 8, x1, __ATOMIC_RELAXED, __HIP_MEMORY_SCOPE_WORKGROUP);
                    asm volatile("" ::: "memory");
                    __hip_atomic_fetch_add(trow + j + 1, p0[4 * g4 + 3], __ATOMIC_RELAXED, __HIP_MEMORY_SCOPE_WORKGROUP); __hip_atomic_fetch_add(trow + j + 9, p1[4 * g4 + 3], __ATOMIC_RELAXED, __HIP_MEMORY_SCOPE_WORKGROUP);
                    asm volatile("" ::: "memory");
                }
            }
            if (more) stage_write<false>(C.lds + (cur ^ 1) * STAGE_B, tid2, kr, vr, br);
            __syncthreads();
        }
    }
    {
        const int tok = tid >> 3, part = tid & 7; LAS float* t0 = tbl + tok * IMP_P;
        float my[8];
#pragma unroll
        for (int jj = 0; jj < 8; ++jj) { const int j = 8 * part + jj; float v = ((t0[j] + t0[64 * IMP_P + j]) + t0[2 * 64 * IMP_P + j]) + t0[3 * 64 * IMP_P + j];
            if (j == 0 || j == tt || j == tt - 1) v = 1.0e9f; else if (j > tt) v = -1.0e9f; my[jj] = v; }
        __syncthreads();
#pragma unroll
        for (int jj = 0; jj < 8; ++jj) t0[8 * part + jj] = my[jj];
        __syncthreads();
        int cnt[8];
#pragma unroll
        for (int jj = 0; jj < 8; ++jj) cnt[jj] = 0;
        for (int k4 = 0; k4 < 16; ++k4) { const f32x4 x = *(const LAS f32x4*)(t0 + 4 * k4);
#pragma unroll
            for (int i = 0; i < 4; ++i) { const int k = 4 * k4 + i;
#pragma unroll
                for (int jj = 0; jj < 8; ++jj) { const int j = 8 * part + jj; cnt[jj] += (x[i] > my[jj] || (x[i] == my[jj] && k < j)) ? 1 : 0; } } }
        unsigned bits = 0u;
#pragma unroll
        for (int jj = 0; jj < 8; ++jj) bits |= (cnt[jj] < 16 ? 1u : 0u) << jj;
        unsigned wlo = part < 4 ? bits << (8 * part) : 0u, whi = part >= 4 ? bits << (8 * (part - 4)) : 0u;
#pragma unroll
        for (int o = 1; o < 8; o <<= 1) { wlo |= __shfl_xor(wlo, o); whi |= __shfl_xor(whi, o); }
        if (part == 0) { selw[2 * tok] = wlo; selw[2 * tok + 1] = whi; }
        __syncthreads();
    }
    const float* gp = (const float*)(C.ws + WS_GA) + ((size_t)b * SEQ + tq) * 32 + hq * 3;
    seg_finish_lds(S, gp[0], accl, true, C.wsf, r32, hi);
    {
        const unsigned sel_lo = selw[2 * (32 * sub + r32)], sel_hi = selw[2 * (32 * sub + r32) + 1];
        unsigned char* Rb; { unsigned long long x_ = (unsigned long long)C.R; asm volatile("" : "+s"(x_)); Rb = (unsigned char*)(GAS unsigned char*)x_; }
        Stream ss; ss.K = (const bf16_t*)(Rb + R_AKS) + (size_t)b * SEQ * 128 + kvh * 64; ss.ldk = 128; ss.VT = (const bf16_t*)(Rb + R_AVST) + (size_t)(b * 2 + kvh) * 64 * SEQ; ss.ldv = SEQ; ss.bias = nullptr;
        state_init(S);
        run_seg<false, true, false>(C.lds, ss, 0, tt + 1, qf, NEGBIG_I, tq, sel_lo, sel_hi, S, S, C.wsf, tid, r32, hi);
        seg_finish_lds(S, gp[1], accl, false, C.wsf, r32, hi);
    }
    {
        unsigned char* Rb; { unsigned long long x_ = (unsigned long long)C.R; asm volatile("" : "+s"(x_)); Rb = (unsigned char*)(GAS unsigned char*)x_; }
        Stream sw; sw.K = (const bf16_t*)(Rb + R_AKW) + (size_t)b * SEQ * 128 + kvh * 64; sw.ldk = 128; sw.VT = (const bf16_t*)(Rb + R_AVWT) + (size_t)(b * 2 + kvh) * 64 * SEQ; sw.ldv = SEQ; sw.bias = nullptr;
        state_init(S);
        run_seg<false, false, false>(C.lds, sw, tt >= 8 ? tt - 8 : 0, tt + 1, qf, tq - 511, tq, 0u, 0u, S, S, C.wsf, tid, r32, hi);
        seg_finish_lds(S, gp[2], accl, false, C.wsf, r32, hi);
    }
    { unsigned char* Rb; { unsigned long long x_ = (unsigned long long)C.R; asm volatile("" : "+s"(x_)); Rb = (unsigned char*)(GAS unsigned char*)x_; }
      br_t* ob = (br_t*)(Rb + R_BR) + ((size_t)b * SEQ + 64 * tt + 32 * sub) * DM + 0 * 512 + hq * 64;
#pragma unroll
      for (int i = 0; i < 4; ++i) { const int row = 8 * i + (C.lane >> 3), ch = C.lane & 7; const f32x4 x0 = *(const LAS f32x4*)(accl + row * 64 + ch * 8), x1 = *(const LAS f32x4*)(accl + row * 64 + ch * 8 + 4);
#if PD_FP8
          *(u32x2*)(ob + (size_t)row * DM + ch * 8) = pack8_fp8(x0 * BR8_SCALE, x1 * BR8_SCALE); } }
#else
          *(u32x4*)(ob + (size_t)row * DM + ch * 8) = pack8(x0, x1); } }
#endif
    __syncthreads();
}
constexpr int CONV_ITEMS_PER_MAT = (DM / 128) * (DFE / 64), CONV_BATCHES = 12 * CONV_ITEMS_PER_MAT / 32;
__device__ __forceinline__ void conv_batch(LAS unsigned char* lds0, const Args& A, int L, int batch, int wave, int lane) {
    LAS unsigned char* scr = lds0 + wave * 9216;
#pragma unroll 1
    for (int j = 0; j < 4; ++j) {
        const int item = batch * 32 + wave * 4 + j; const int mat = item / CONV_ITEMS_PER_MAT, local = item - mat * CONV_ITEMS_PER_MAT; const int e = 4 * L + mat / 3, which = mat - (mat / 3) * 3;
        TrSeg s; s.item0 = 0; s.pad = 0; s.aoff = 0;
        if (which < 2) { s.W = (const float*)A.in[which == 0 ? IN_MWG : IN_MWU] + (size_t)e * DM * DFE; s.ldw = DFE; s.K = DM; s.ncols = DFE; s.WT = (bf16_t*)(A.ws + WS_WMGU + (size_t)e * 2 * DFE * DM); s.ldt = DM; s.kind = MAP_GU; s.vbase = which * 128; s.f8scale = MOE_WGU_SCALE; }
        else { s.W = (const float*)A.in[IN_MWD] + (size_t)e * DFE * DM; s.ldw = DM; s.K = DFE; s.ncols = DM; s.WT = (bf16_t*)(A.ws + WS_WMD + (size_t)e * DM * DFE); s.ldt = DFE; s.kind = MAP_PLAIN; s.vbase = 0; s.f8scale = MOE_WD_SCALE; }
        tr_item_f8(s, local, scr, lane);
    }
}
constexpr int DEF_ITEMS = 3 * (DM / 64) * (DFF / 64) + (4 * 8 * 32 + 32 * 32 + 4 * 32 + 32 * 32) + (80 * 32 + 128 * 32 + 2 * 128 + 4 * 8 * 32 + 32 * 32 + 4 * 32 + 32 * 32), SMALL_BATCHES = (DEF_ITEMS + 31) / 32;
__device__ __forceinline__ void conv_small(LAS unsigned char* lds0, const Args& A, int batch, int wave, int lane) {
    LAS unsigned char* scr = lds0 + wave * 9216;
    const int* gh = (const int*)(A.ws + WS_CTL + DEFTAB_OFF); const TrSeg* gtab = (const TrSeg*)(gh + 4);
    const int nseg = gh[0], nitems = gh[1];
    int si = 0;
#pragma unroll 1
    for (int j = 0; j < 4; ++j) {
        const int item = batch * 32 + wave * 4 + j; if (item >= nitems) break;
        while (si + 1 < nseg && item >= gtab[si + 1].item0) ++si;
        const TrSeg* t = gtab + si; TrSeg s; s.W = t->W; s.WT = t->WT; s.ldw = t->ldw; s.K = t->K; s.ncols = t->ncols; s.ldt = t->ldt; s.kind = t->kind; s.vbase = t->vbase; s.aoff = t->aoff; s.item0 = t->item0; s.f8scale = t->f8scale; s.pad = 0;
        tr_item(s, item - s.item0, scr, lane);
    }
}
constexpr int NUNITS = 2048, NPB = NB * 8 + 256, QLEN = NPB + NUNITS + CONV_BATCHES;
#ifndef ATT_MASK
#define ATT_MASK 15
#endif
#define ATT_CTX() Ctx C; { int t_ = wave0 * 64 + lane_id(); asm volatile("" : "+v"(t_)); C.tid = t_; C.lane = t_ & 63; C.wave = __builtin_amdgcn_readfirstlane(t_ >> 6); C.r32 = C.lane & 31; C.hi = C.lane >> 5; \
      unsigned l_ = 0u; asm volatile("" : "+s"(l_)); C.lds = lds0 + l_; unsigned long long w_ = (unsigned long long)A.ws; asm volatile("" : "+s"(w_)); C.ws = (unsigned char*)(GAS unsigned char*)w_; C.R = C.ws + WS_R; \
      C.dlam = (const float*)A.in[IN_DLAM]; C.dgain = (const float*)A.in[IN_DGAIN]; C.sink = (const float*)A.in[IN_SINK]; C.L = L; C.wsf = (LAS float*)(C.lds + L_WS) + C.wave * 64; }
#define ATT_FETCH() do { if (wave0 == 0 && lane_id() == 0) uidp[0] = (int)__hip_atomic_fetch_add(qhead, 1u, __ATOMIC_RELAXED, __HIP_MEMORY_SCOPE_AGENT); __syncthreads(); pos = uidp[0]; __syncthreads(); } while (0)
#define ATT_NEXT_FROM(have) do { bool have_ = (have); const int cb_ = (L == 0) ? CONV_BATCHES + SMALL_BATCHES : CONV_BATCHES, per_ = (L == 0) ? 2 : 4; for (;;) { if (!have_) ATT_FETCH(); have_ = false; const int p_ = pos - NPB; \
      if (p_ >= NUNITS + cb_) { id = NUNITS; break; } \
      if (p_ < per_ * cb_) { const int q_ = p_ / per_, r_ = p_ - q_ * per_; \
          if (r_ == per_ - 1) { if (L == 0 && q_ < SMALL_BATCHES) conv_small(lds0, A, q_, wave0, lane_id()); else conv_batch(lds0, A, L, L == 0 ? q_ - SMALL_BATCHES : q_, wave0, lane_id()); __syncthreads(); continue; } \
          id = (per_ - 1) * q_ + r_; break; } \
      id = p_ - cb_; break; } } while (0)
#define ATT_NEXT() ATT_NEXT_FROM(false)
__device__ __forceinline__ void attn_phase(const Frame& F, const Args& A, int L, int rep) {
    LAS unsigned char* lds0 = F.lds; const int wave0 = F.wave;
    LAS int* uidp = (LAS int*)(lds0 + L_UID);
    unsigned* qhead = (unsigned*)(A.ws + WS_CTL) + CW_ATTQ + 64 * L + 128 * rep;
    unsigned* pbdone = (unsigned*)(A.ws + WS_CTL) + CW_PBDONE + 64 * L + 128 * rep;
    int pos, id; ATT_FETCH();
    while (pos < NPB) {
        pb_item(F, A, L, pos);
        asm volatile("s_waitcnt vmcnt(0)" ::: "memory"); __syncthreads();
        if (wave0 == 0 && lane_id() == 0) { __builtin_amdgcn_fence(__ATOMIC_RELEASE, "agent"); asm volatile("s_waitcnt vmcnt(0)" ::: "memory"); (void)__hip_atomic_fetch_add(pbdone, 1u, __ATOMIC_RELAXED, __HIP_MEMORY_SCOPE_AGENT); }
        ATT_FETCH();
    }
    ATT_NEXT_FROM(true);
    { ATT_CTX(); while (id < 512) { if (ATT_MASK & 1) diff_unit(C, (id & 31) >> 3, id & 7, 15 - (id >> 5)); ATT_NEXT(); } }
    { if (wave0 == 0 && lane_id() == 0) { unsigned sp = 0u; while (__hip_atomic_load(pbdone, __ATOMIC_RELAXED, __HIP_MEMORY_SCOPE_AGENT) < (unsigned)NPB) { __builtin_amdgcn_s_sleep(2); if (++sp > (1u << 22)) break; }
          __builtin_amdgcn_fence(__ATOMIC_ACQUIRE, "agent"); asm volatile("s_waitcnt vmcnt(0)" ::: "memory"); }
      __syncthreads(); }
    { ATT_CTX(); while (id < 1024) { const int q = id - 512; if (ATT_MASK & 2) fox_unit(C, (q & 31) >> 3, q & 7, 15 - (q >> 5)); ATT_NEXT(); } }
    { ATT_CTX(); while (id < 1536) { const int q = id - 1024; if (ATT_MASK & 4) nsa_unit(C, (q & 7) >> 1, q & 1, 63 - (q >> 3)); ATT_NEXT(); } }
    { ATT_CTX(); while (id < 2048) { const int q = id - 1536; if (ATT_MASK & 8) swa_unit(C, (q & 7) >> 1, q & 1, q >> 3); ATT_NEXT(); } }
}
}

constexpr int NPHASE = 20;
__device__ __forceinline__ Args load_args() {
    Args a;
#if defined(__HIP_DEVICE_COMPILE__)
    const unsigned long long __attribute__((address_space(4)))* kp = (const unsigned long long __attribute__((address_space(4)))*)__builtin_amdgcn_kernarg_segment_ptr(); asm volatile("" : "+s"(kp));
#pragma unroll
    for (int i = 0; i < 28; ++i) a.in[i] = (const void*)(const GAS void*)kp[i];
    a.out = (float*)(GAS float*)kp[28]; a.ws = (unsigned char*)(GAS unsigned char*)kp[29]; const unsigned long long w = kp[30]; a.ph_lo = (int)(unsigned)w; a.ph_hi = (int)(unsigned)(w >> 32);
#else
    for (int i = 0; i < 28; ++i) a.in[i] = nullptr; a.out = nullptr; a.ws = nullptr; a.ph_lo = 0; a.ph_hi = 0;
#endif
    return a;
}
static_assert(sizeof(Args) == 31 * 8, "Args layout");
#ifndef KMASK
#define KMASK 0xffff
#endif
#define KEN(kind) (KIND < 0 ? (((KMASK) >> (kind)) & 1) != 0 : KIND == (kind))
#define PHASE_ENV() \
    Frame F; { int t_ = wave_s * 64 + lane_id(); asm volatile("" : "+v"(t_)); F.tid = t_; F.lane = t_ & 63; F.wave = __builtin_amdgcn_readfirstlane(t_ >> 6); \
      unsigned l_ = 0u; asm volatile("" : "+s"(l_)); F.lds = (LAS unsigned char*)lds_raw + l_; F.G = gridDim.x; const int bx_ = blockIdx.x; F.vcu = (F.G % 8 == 0) ? (bx_ % 8) * (F.G / 8) + bx_ / 8 : bx_; } \
    const Args args = load_args(); \
    unsigned char* ws = args.ws; unsigned char* R = ws + WS_R; const int c = (int)blockIdx.x; (void)R; (void)c; \
    const float* hin = (L == 0) ? (const float*)args.in[IN_X] : (const float*)(ws + WS_HF) + (size_t)MTOK * DM; (void)hin; \
    const bf16_t* hbin = (const bf16_t*)(ws + WS_HB); (void)hbin; const bf16_t* hb1 = (const bf16_t*)(ws + WS_HB) + (size_t)MTOK * DM; (void)hb1;

#if MK_PER_PHASE
#define GRID_BAR() do { } while (0)
#else
#define GRID_BAR() do { XcdBarrier b_ = bar; { unsigned long long p_ = (unsigned long long)b_.bar; asm volatile("" : "+s"(p_)); b_.bar = (unsigned*)(GAS unsigned*)p_; } xcd_barrier_impl(b_.bar, b_.x, b_.st); } while (0)
#endif
#if MK_PER_PHASE
#define IN(k) (lo <= (k) && (k) < hi)
#else
#define IN(k) true
#endif
#define SEAM(k) do { if (IN(k) && IN((k) + 1)) GRID_BAR(); } while (0)
#ifndef REPEAT_KIND
#define REPEAT_KIND -1
#endif
#define REP(kind) for (int rep_ = 0; rep_ < ((REPEAT_KIND == (kind)) ? 2 : 1); ++rep_)


template <int KIND, int L> __device__ __forceinline__ void layer_phases(const int lo, const int hi, const XcdBarrier bar, const int wave_s) {
    extern __shared__ __attribute__((aligned(16))) unsigned char lds_raw[];
    (void)lo; (void)hi; (void)bar;
        const int base = 1 + 9 * L;
        if (KEN(1) && IN(base + 0)) REP(1) { if (rep_) GRID_BAR();
            { PHASE_ENV(); small_gates(F, hbin, (const bf16_t*)(ws + WS_WS + L * SZ_WS), (const float*)args.in[IN_FOXB] + L * 8, (float*)(ws + WS_GA)); }
            { PHASE_ENV();
#if QKV_FP8
              pg8::StaticOrder8 S{ws + WS_HB8, ws + WS_WA + L * SZ_WA, DM, DM, MTOK / 256, 20, F.G, c};
              EpiA E{R, (const float*)(ws + WS_ROPE64), (const float*)(ws + WS_ROPE32), 1.f / WA_SCALE};
              pg8::gemm_phase<EpiA, pg8::StaticOrder8, true>(F.lds, F.tid, DM, DM, DM, S, E); }
#else
              pg8::StaticOrder S{hbin, (const bf16_t*)(ws + WS_WA + L * SZ_WA), DM, DM, MTOK / 256, 20, F.G, c};
              EpiA E{R, (const float*)(ws + WS_ROPE64), (const float*)(ws + WS_ROPE32), 1.f};
              pg8::gemm_phase(F.lds, F.tid, DM, DM, DM, S, E); }
#endif
            { PHASE_ENV();
              pg8::StaticOrder8 S{ws + WS_HB8, ws + WS_WAG8 + L * SZ_WAG8, DM, DM, MTOK / 256, 8192 / 256, F.G, c};
              EpiGate8 E{R + R_GATES, 1.f / GATE_W_SCALE};
              pg8::gemm_phase<EpiGate8, pg8::StaticOrder8, true>(F.lds, F.tid, DM, DM, DM, S, E); }
        }
        SEAM(base + 0);
        if (KEN(3) && IN(base + 2)) REP(3) { if (rep_) GRID_BAR(); PHASE_ENV(); att::attn_phase(F, args, L, rep_); }
        SEAM(base + 2);
        if (KEN(4) && IN(base + 3)) REP(4) { if (rep_) GRID_BAR(); PHASE_ENV();
            pg8::MergeOrder S{(const bf16_t*)(R + R_BR), (const bf16_t*)(ws + WS_WB + L * SZ_WB), F.G, c};
#if MERGE_CHAIN
#if PD_FP8
            pg8::MergeOrder8 S8{R + R_BR, ws + WS_WB + L * SZ_WB, F.G, c};
            EpiMergeChain E{R + R_GATES, R + R_MERGED8, 1.f / (BR8_SCALE * WB_SCALE)};
            pg8::gemm_phase<EpiMergeChain, pg8::MergeOrder8, true, true>(F.lds, F.tid, 512, DM, 512, S8, E);
#else
            EpiMergeChain E{R + R_GATES, R + R_MERGED8, 1.f};
            pg8::gemm_phase<EpiMergeChain, pg8::MergeOrder, false, true>(F.lds, F.tid, 512, DM, 512, S, E);
#endif
#else
            EpiMerge E{R + R_GATES, (bf16_t*)(R + R_MERGED), R + R_MERGED8};
            pg8::gemm_phase(F.lds, F.tid, 512, DM, 512, S, E);
#endif
        }
        SEAM(base + 3);
        if (KEN(5) && IN(base + 4)) { PHASE_ENV();
            pg8::StaticOrder8 S{R + R_MERGED8, ws + WS_WO + L * SZ_WO, DM, DM, MTOK / 256, DM / 256, F.G, c};
#if PRE_BF16
            EpiBf16S E{(bf16_t*)(R + R_PRE), 1.f / (WO_SCALE * MERGED8_SCALE)};
            pg8::gemm_phase<EpiBf16S, pg8::StaticOrder8, true>(F.lds, F.tid, DM, DM, DM, S, E);
#else
            EpiF32 E{(float*)(R + R_PRE), 1.f / (WO_SCALE * MERGED8_SCALE)};
            pg8::gemm_phase<EpiF32, pg8::StaticOrder8, true>(F.lds, F.tid, DM, DM, DM, S, E);
#endif
        }
        SEAM(base + 4);
        if (KEN(6) && IN(base + 5)) REP(6) { if (rep_) GRID_BAR(); PHASE_ENV(); pf_phase(F, args, L, L == 1, hin); }
        SEAM(base + 5);
        if (L == 0) {
            if (KEN(7) && IN(base + 6)) {
#if DENSE_DOWN_FP8
                { PHASE_ENV(); for (int i = F.vcu * NTHREADS + F.tid; i < MTOK * 8; i += F.G * NTHREADS) *(u32x4*)(R + R_ACT + (size_t)(i >> 3) * DFF8 + DFF + (i & 7) * 16) = (u32x4){0u, 0u, 0u, 0u}; }
#endif
                { PHASE_ENV(); pg8::StaticOrder S{hb1, (const bf16_t*)(ws + WS_WFGU), DM, DM, MTOK / 256, 2 * DFF / 256, F.G, c};
#if DENSE_DOWN_FP8
                  EpiSwigluF8 E{R + R_ACT, DFF8, 1.f};
#else
                  EpiSwiglu E{(bf16_t*)(R + R_ACT), DFF};
#endif
                  pg8::gemm_phase(F.lds, F.tid, DM, DM, DM, S, E); }
                { PHASE_ENV(); pg8::StaticOrder S{(const bf16_t*)(ws + WS_PB16) + (size_t)L * MTOK * PLE, (const bf16_t*)(ws + WS_WPP + L * SZ_WPP), PLE, PLE, MTOK / 256, DM / 256, F.G, c}; EpiBf16 E{(bf16_t*)(R + R_PTMP)}; int kp = PLE; asm volatile("" : "+s"(kp)); pg8::gemm_phase(F.lds, F.tid, kp, PLE, PLE, S, E); }
#if PLE0_FP8
                { PHASE_ENV(); pg8::StaticOrder8 S{ws + WS_HB8, ws + WS_WPG + L * SZ_WPG, DM, DM, MTOK / 256, DM / 256, F.G, c}; EpiPleGate E{(const bf16_t*)(R + R_PTMP), (bf16_t*)(R + R_PLE), 1.f / PG_SCALE}; pg8::gemm_phase<EpiPleGate, pg8::StaticOrder8, true>(F.lds, F.tid, DM, DM, DM, S, E); }
#else
                { PHASE_ENV(); pg8::StaticOrder S{hb1, (const bf16_t*)(ws + WS_WPG + L * SZ_WPG), DM, DM, MTOK / 256, DM / 256, F.G, c}; EpiPleGate E{(const bf16_t*)(R + R_PTMP), (bf16_t*)(R + R_PLE), 1.f}; pg8::gemm_phase(F.lds, F.tid, DM, DM, DM, S, E); }
#endif
            }
            SEAM(base + 6);
            if (KEN(8) && IN(base + 7)) { PHASE_ENV();
#if DENSE_DOWN_FP8
                pg8::StaticOrder8 S{R + R_ACT, ws + WS_WFD, DFF8, DFF8, MTOK / 256, DM / 256, F.G, c};
                EpiF32 E{(float*)(R + R_PRE2), 1.f / WFD_SCALE};
                pg8::gemm_phase<EpiF32, pg8::StaticOrder8, true>(F.lds, F.tid, DFF8, DFF8, DFF8, S, E);
#else
                pg8::StaticOrder S{(const bf16_t*)(R + R_ACT), (const bf16_t*)(ws + WS_WFD), DFF, DFF, MTOK / 256, DM / 256, F.G, c};
#if PRE_BF16
                EpiBf16S E{(bf16_t*)(R + R_PRE2), 1.f};
#else
                EpiF32 E{(float*)(R + R_PRE2), 1.f};
#endif
                pg8::gemm_phase(F.lds, F.tid, DFF, DFF, DFF, S, E);
#endif
            }
            SEAM(base + 7);
            if (KEN(9) && IN(base + 8)) { PHASE_ENV(); pi_phase(F, args, L, false); }
            SEAM(base + 8);
        } else {
            if (KEN(10) && IN(base + 6)) {
                { PHASE_ENV(); moe_scatter(F, args); }
                { PHASE_ENV(); bf16_t* ptmp = (bf16_t*)(ws + WS_HF + (size_t)MTOK * DM * 4) + (size_t)MTOK * DM;
                  pg8::StaticOrder S{(const bf16_t*)(ws + WS_PB16) + (size_t)L * MTOK * PLE, (const bf16_t*)(ws + WS_WPP + L * SZ_WPP), PLE, PLE, MTOK / 256, DM / 256, F.G, c}; EpiBf16 E{ptmp}; int kp = PLE; asm volatile("" : "+s"(kp)); pg8::gemm_phase(F.lds, F.tid, kp, PLE, PLE, S, E); }
                { PHASE_ENV(); bf16_t* ple = (bf16_t*)(ws + WS_HF + (size_t)MTOK * DM * 4); bf16_t* ptmp = ple + (size_t)MTOK * DM;
                  pg8::StaticOrder8 S{ws + WS_HB8, ws + WS_WPG + L * SZ_WPG, DM, DM, MTOK / 256, DM / 256, F.G, c}; EpiPleGate E{ptmp, ple, 1.f / PG_SCALE}; pg8::gemm_phase<EpiPleGate, pg8::StaticOrder8, true>(F.lds, F.tid, DM, DM, DM, S, E); }
            }
            SEAM(base + 6);
            if (KEN(11) && IN(base + 7)) REP(11) { if (rep_) GRID_BAR(); PHASE_ENV(); const int* panel = (const int*)(ws + WS_ROUTE + RT_PANEL);
                pg8::MoeOrder S{R + R_HS, ws + WS_WMGU, panel, DM, DM, 2 * DFE / 256, F.G, c}; EpiSwigluF8 E{R + R_ACTS, DFE, 1.f / MOE_WGU_SCALE};
                pg8::gemm_phase<EpiSwigluF8, pg8::MoeOrder, true>(F.lds, F.tid, DM, DM, DM, S, E);
            }
            SEAM(base + 7);
            if (KEN(12) && IN(base + 8)) REP(12) { if (rep_) GRID_BAR(); PHASE_ENV(); const int* panel = (const int*)(ws + WS_ROUTE + RT_PANEL);
                pg8::MoeOrder S{R + R_ACTS, ws + WS_WMD, panel, DFE, DFE, DM / 256, F.G, c}; EpiMoeDown E{(const float*)(ws + WS_ROUTE + RT_SROWW), (bf16_t*)(R + R_YS), 1.f / MOE_WD_SCALE};
                pg8::gemm_phase<EpiMoeDown, pg8::MoeOrder, true>(F.lds, F.tid, DFE, DFE, DFE, S, E);
            }
            SEAM(base + 8);
            if (KEN(13) && IN(base + 9)) { PHASE_ENV(); pi_phase(F, args, L, true); }
        }
}

template <int KIND> __global__ void __launch_bounds__(NTHREADS, 2) mk_fwd(Args args0) {
    extern __shared__ __attribute__((aligned(16))) unsigned char lds_raw[];
    const int wave_s = __builtin_amdgcn_readfirstlane((int)threadIdx.x >> 6);
    for (int u = threadIdx.x; u < 64; u += NTHREADS) ((LAS unsigned*)((LAS unsigned char*)lds_raw + RING_BYTES))[u + 64] = 0u;
    __syncthreads();
    const int lo = args0.ph_lo, hi = args0.ph_hi; (void)lo; (void)hi;
#if !MK_PER_PHASE
    XcdBarrier bar = xcd_barrier_post((unsigned*)(args0.ws + WS_CTL) + CW_BAR, (volatile LAS unsigned*)((LAS unsigned char*)lds_raw + MISC_OFF) + 8);
#else
    XcdBarrier bar; bar.bar = nullptr; bar.x = 0u; bar.st = nullptr;
#endif
    if (KEN(0) && IN(0)) REP(0) { if (rep_) GRID_BAR(); const int L = 0; PHASE_ENV(); p0_prologue(F, args); } SEAM(0);

    layer_phases<KIND, 0>(lo, hi, bar, wave_s);
    layer_phases<KIND, 1>(lo, hi, bar, wave_s);
}

__global__ void dbg_bf16_out(const bf16_t* src, float* out, size_t n) { for (size_t i = (size_t)blockIdx.x * blockDim.x + threadIdx.x; i < n; i += (size_t)gridDim.x * blockDim.x) out[i] = bf2f(src[i]); }
__global__ void fill_const(float* out, int n, float v) { for (int i = blockIdx.x * blockDim.x + threadIdx.x; i < n; i += gridDim.x * blockDim.x) out[i] = v; }

typedef void (*kern_t)(Args);
static kern_t kernel_of_kind(int k) {
    switch (k) { case 0: return mk_fwd<0>; case 1: return mk_fwd<1>; case 2: return mk_fwd<2>; case 3: return mk_fwd<3>; case 4: return mk_fwd<4>; case 5: return mk_fwd<5>; case 6: return mk_fwd<6>;
                 case 7: return mk_fwd<7>; case 8: return mk_fwd<8>; case 9: return mk_fwd<9>; case 10: return mk_fwd<10>; case 11: return mk_fwd<11>; case 12: return mk_fwd<12>; default: return mk_fwd<13>; }
}
static const int kind_of_phase[NPHASE] = {0, 1, 2, 3, 4, 5, 6, 7, 8, 9, 1, 2, 3, 4, 5, 6, 10, 11, 12, 13};
extern "C" void kernel_launch(void* const* d_in, const int* in_sizes, int n_in, void* d_out, int out_size, void* d_ws, size_t ws_size, hipStream_t stream) {
    static int grid = 0;
    if (grid == 0) {
        int dev = 0, cus = 0; bool ok = true;
        if (hipGetDevice(&dev) != hipSuccess || hipDeviceGetAttribute(&cus, hipDeviceAttributeMultiprocessorCount, dev) != hipSuccess) { fprintf(stderr, "kernel_launch: device query failed\n"); ok = false; }
#if MK_PER_PHASE
        for (int k = 0; k < 14 && ok; ++k) if (hipFuncSetAttribute((const void*)kernel_of_kind(k), hipFuncAttributeMaxDynamicSharedMemorySize, LDS_BYTES) != hipSuccess) { fprintf(stderr, "kernel_launch: hipFuncSetAttribute failed\n"); ok = false; }
#else
        if (ok && hipFuncSetAttribute((const void*)mk_fwd<-1>, hipFuncAttributeMaxDynamicSharedMemorySize, LDS_BYTES) != hipSuccess) { fprintf(stderr, "kernel_launch: hipFuncSetAttribute failed\n"); ok = false; }
        if (ok) { int per_cu = 0; (void)hipOccupancyMaxActiveBlocksPerMultiprocessor(&per_cu, (const void*)mk_fwd<-1>, NTHREADS, LDS_BYTES); (void)hipGetLastError(); }
#endif
        grid = ok ? cus : -1;
    }
    if (grid < 0 || n_in != 28 || out_size != MTOK * DM || ws_size < WS_END) {
        fprintf(stderr, "kernel_launch: bad configuration (grid %d, n_in %d, out %d, ws %zu, need %zu)\n", grid, n_in, out_size, ws_size, (size_t)WS_END);
        hipLaunchKernelGGL(fill_const, dim3(1024), dim3(256), 0, stream, (float*)d_out, out_size, ws_size < WS_END ? 1000.0f : 100.0f);
        return;
    }
    (void)hipMemsetAsync((char*)d_ws + WS_CTL, 0, CTL_BYTES, stream);
    Args a{};
    for (int i = 0; i < 28; ++i) a.in[i] = d_in[i];
    a.out = (float*)d_out; a.ws = (unsigned char*)d_ws;
#if MK_PER_PHASE
#ifndef DBG_STOP_AFTER
#define DBG_STOP_AFTER (NPHASE - 1)
#endif
#ifndef DBG_REPEAT_PHASE
#define DBG_REPEAT_PHASE -1
#endif
    for (int p = 0; p <= DBG_STOP_AFTER; ++p) { a.ph_lo = p; a.ph_hi = p + 1; hipLaunchKernelGGL(kernel_of_kind(kind_of_phase[p]), dim3(grid), dim3(NTHREADS), LDS_BYTES, stream, a);
        if (p == DBG_REPEAT_PHASE) { (void)hipMemsetAsync((char*)d_ws + WS_CTL, 0, CTL_BYTES, stream); hipLaunchKernelGGL(kernel_of_kind(kind_of_phase[p]), dim3(grid), dim3(NTHREADS), LDS_BYTES, stream, a); } }
#ifdef DBG_BF16_OFF
    hipLaunchKernelGGL(dbg_bf16_out, dim3(2048), dim3(256), 0, stream, (const bf16_t*)((char*)d_ws + (DBG_BF16_OFF)), (float*)d_out, (size_t)MTOK * DM);
#endif
#ifdef DBG_COPY_OFF
    (void)hipMemcpyAsync(d_out, (char*)d_ws + (DBG_COPY_OFF), (size_t)MTOK * DM * 4, hipMemcpyDeviceToDevice, stream);
#endif
#else
    a.ph_lo = 0; a.ph_hi = NPHASE;
    hipLaunchKernelGGL(mk_fwd<-1>, dim3(grid), dim3(NTHREADS), LDS_BYTES, stream, a);
#endif
}
```

```cpp
#include <hip/hip_runtime.h>
#include <cstdio>
#include <cstdint>

#ifndef MK_PER_PHASE
#define MK_PER_PHASE 0
#endif

#define LAS __attribute__((address_space(3)))
#define GAS __attribute__((address_space(1)))
typedef unsigned short bf16_t;
typedef short bf16x8 __attribute__((ext_vector_type(8)));
typedef float f32x2 __attribute__((ext_vector_type(2)));
typedef float f32x4 __attribute__((ext_vector_type(4)));
typedef float f32x16 __attribute__((ext_vector_type(16)));
typedef unsigned u32x2 __attribute__((ext_vector_type(2)));
typedef unsigned u32x4 __attribute__((ext_vector_type(4)));
typedef GAS unsigned gu32;

constexpr int NB = 4, SEQ = 4096, DM = 2048, MTOK = NB * SEQ, NLAYER = 2;
constexpr int INC = 13344;
constexpr int DFF = 5504, NEXP = 8, DFE = 7168, PLE = 256;
constexpr int NA = 13312;
constexpr float ALPHA = 1.41421356237309515f;
constexpr float LN_EPS = 1e-5f;
constexpr float LOG2E = 1.4426950408889634f;
constexpr float QS64 = 0.125f * LOG2E;
constexpr float QS32 = 0.17677669529663687f * LOG2E;
constexpr int MOE_ROWS = 2 * MTOK + NEXP * 256;
constexpr int MOE_PANELS = MOE_ROWS / 256;

constexpr int SRC_AQ = 0, SRC_AKC = 512, SRC_AVC = 640, SRC_AKS = 768, SRC_AVS = 896, SRC_AKW = 1024, SRC_AVW = 1152, SRC_AG = 1280,
              SRC_BQ = 1304, SRC_BK = 1816, SRC_BV = 1944, SRC_CQ = 2072, SRC_CK = 2584, SRC_CV = 3096, SRC_CF = 3608,
              SRC_DQ = 3616, SRC_DK = 4128, SRC_DV = 4640, SRC_MG = 5152;

constexpr size_t al256(size_t x) { return (x + 255) & ~(size_t)255; }
constexpr size_t WS_CTL = 0, CTL_BYTES = 1u << 20;
constexpr size_t SZ_WA = (size_t)NA * DM * 2, SZ_WS = 32 * DM * 2, SZ_WC1 = 256 * 2048 * 2, SZ_WB = (size_t)4 * DM * 512 * 2, SZ_WO = (size_t)DM * DM * 2,
                 SZ_WFGU = (size_t)2 * DFF * DM * 2, SZ_WFD = (size_t)DM * DFF * 2, SZ_WMGU = (size_t)NEXP * 2 * DFE * DM  , SZ_WMD = (size_t)NEXP * DM * DFE  ,
                 SZ_WPG = (size_t)DM * DM * 2, SZ_WPP = (size_t)DM * PLE * 2;
constexpr size_t WS_WA = WS_CTL + CTL_BYTES;
constexpr size_t WS_WS = WS_WA + 2 * SZ_WA;
constexpr size_t WS_WC1 = WS_WS + 2 * SZ_WS;
constexpr size_t WS_CVEC = WS_WC1 + 4 * SZ_WC1;
constexpr size_t WS_WB = WS_CVEC + 4096;
constexpr size_t WS_WO = WS_WB + 2 * SZ_WB;
constexpr size_t WS_WFGU = WS_WO + 2 * SZ_WO;
constexpr size_t WS_WFD = WS_WFGU + SZ_WFGU;
constexpr size_t WS_WMGU = WS_WFD + SZ_WFD;
constexpr size_t WS_WMD = WS_WMGU + SZ_WMGU;
constexpr size_t WS_WPG = WS_WMD + SZ_WMD;
constexpr size_t WS_WPP = WS_WPG + 2 * SZ_WPG;
constexpr size_t WS_WAG8 = WS_WPP + 2 * SZ_WPP;
constexpr size_t SZ_WAG8 = (size_t)8192 * DM;
constexpr size_t WS_HB8 = WS_WAG8 + 2 * SZ_WAG8;
constexpr size_t WS_ROPE64 = WS_HB8 + (size_t)MTOK * DM;
constexpr size_t WS_ROPE32 = WS_ROPE64 + (size_t)MTOK * 64 * 4;
constexpr size_t WS_PB16 = WS_ROPE32 + (size_t)MTOK * 32 * 4;
constexpr size_t WS_GA = WS_PB16 + (size_t)2 * MTOK * PLE * 2;
constexpr size_t WS_CUM = WS_GA + (size_t)MTOK * 32 * 4;
constexpr size_t WS_KC = WS_CUM + (size_t)NB * 8 * SEQ * 4;
constexpr size_t WS_VCT = WS_KC + (size_t)NB * 2 * 256 * 64 * 2;
constexpr size_t WS_ROUTE = WS_VCT + (size_t)NB * 2 * 256 * 64 * 2;
constexpr size_t RT_E = 0, RT_W = (size_t)MTOK * 2 * 4, RT_CNT = RT_W + (size_t)MTOK * 2 * 4, RT_TOKSROW = RT_CNT + 256 * 8 * 4,
                 RT_SROWW = RT_TOKSROW + (size_t)MTOK * 2 * 4, RT_PANEL = RT_SROWW + (size_t)MOE_ROWS * 4, RT_END = RT_PANEL + 1024;
constexpr size_t WS_HF = al256(WS_ROUTE + RT_END);
constexpr size_t WS_HB = WS_HF + (size_t)2 * MTOK * DM * 4;
constexpr size_t WS_R = WS_HB + (size_t)2 * MTOK * DM * 2;
constexpr size_t R_AQ = 0, SZ_Q = (size_t)MTOK * 512 * 2, SZ_K2 = (size_t)MTOK * 128 * 2;
constexpr size_t R_BQ = R_AQ + SZ_Q, R_CQ = R_BQ + SZ_Q, R_DQ = R_CQ + SZ_Q, R_CK = R_DQ + SZ_Q, R_DK = R_CK + SZ_Q;
constexpr size_t R_AKC = R_DK + SZ_Q, R_AKS = R_AKC + SZ_K2, R_AKW = R_AKS + SZ_K2, R_BK = R_AKW + SZ_K2, R_AVC = R_BK + SZ_K2;
constexpr size_t R_AVST = R_AVC + SZ_K2, R_AVWT = R_AVST + SZ_K2, R_BVT = R_AVWT + SZ_K2, R_CVT = R_BVT + SZ_K2, R_DVT = R_CVT + SZ_Q;
constexpr size_t R_QKV_END = R_DVT + SZ_Q;
constexpr size_t R_PART = 0;
static_assert((size_t)MTOK * DM * 4 <= R_QKV_END, "merge partial fits over the qkv set");
constexpr size_t R_GATES = R_QKV_END;
constexpr size_t R_PRE = R_GATES;
constexpr size_t R_BR = R_GATES + (size_t)MTOK * 8192 * 2;
constexpr size_t R_MERGED = R_BR + (size_t)MTOK * DM * 2;
constexpr size_t R_MERGED8 = R_MERGED + (size_t)MTOK * DM * 2;
constexpr size_t R_MIX_END = R_MERGED8 + (size_t)MTOK * DM;
constexpr size_t R_ACT = 0;
constexpr size_t R_PLE = R_ACT + (size_t)MTOK * DFF * 2;
constexpr size_t R_PTMP = R_PLE + (size_t)MTOK * DM * 2;
constexpr size_t R_PRE2 = R_PTMP + (size_t)MTOK * DM * 2;
constexpr size_t R_FFN_END = R_PRE2 + (size_t)MTOK * DM * 4;
constexpr size_t R_HS = 0;
constexpr size_t R_ACTS = R_HS + (size_t)MOE_ROWS * DM;
constexpr size_t R_YS = R_ACTS + (size_t)MOE_ROWS * DFE;
constexpr size_t R_MOE_END = R_YS + (size_t)MOE_ROWS * DM * 2;
#ifndef QKV_FP8
#define QKV_FP8 1
#endif
#ifndef PD_FP8
#define PD_FP8 1
#endif
constexpr float BR8_SCALE = 16.f, WB_SCALE = 32.f;
#ifndef PRE_BF16
#define PRE_BF16 1
#endif
#ifndef RES_BF16
#define RES_BF16 1
#endif
#ifndef PLE0_FP8
#define PLE0_FP8 1
#endif
#ifndef DENSE_DOWN_FP8
#define DENSE_DOWN_FP8 0
#endif
constexpr float WA_SCALE = 32.f;
constexpr int DFF8 = 5632;
constexpr float WFD_SCALE = 128.f;
constexpr float MOE_WGU_SCALE = 32.f, MOE_WD_SCALE = 128.f, GATE_W_SCALE = 32.f, WO_SCALE = 64.f, MERGED8_SCALE = 4.f, PG_SCALE = 32.f;
constexpr size_t R_SIZE = R_MOE_END > R_MIX_END ? (R_MOE_END > R_FFN_END ? R_MOE_END : R_FFN_END) : (R_MIX_END > R_FFN_END ? R_MIX_END : R_FFN_END);
constexpr size_t WS_END = WS_R + R_SIZE;

constexpr int CW_TMO = 0;
constexpr int CW_ATTQ = 64;
constexpr int CW_PBDONE = 1024;
constexpr int CW_BAR = 4096;
constexpr int DEFTAB_OFF = 65536;

constexpr int LDS_BYTES = 147456;
constexpr int RING_BYTES = 131072;
constexpr int MISC_OFF = RING_BYTES + 320;
constexpr int NWAVES = 8, NTHREADS = 512;

typedef __bf16 bf16x2_t __attribute__((ext_vector_type(2)));
__device__ __forceinline__ unsigned cvt_pk_bf16(float lo, float hi) { const f32x2 v = {lo, hi}; const bf16x2_t b = __builtin_convertvector(v, bf16x2_t); return __builtin_bit_cast(unsigned, b); }
__device__ __forceinline__ float bf2f(unsigned short b) { return __uint_as_float((unsigned)b << 16); }
__device__ __forceinline__ float bflo(unsigned w) { return __uint_as_float(w << 16); }
__device__ __forceinline__ float bfhi(unsigned w) { return __uint_as_float(w & 0xffff0000u); }
__device__ __forceinline__ bf16_t f2bf(float f) { return (bf16_t)(cvt_pk_bf16(f, 0.f) & 0xffffu); }
__device__ __forceinline__ float fast_exp2(float x) { return __builtin_amdgcn_exp2f(x); }
__device__ __forceinline__ float fast_rcp(float x) { return __builtin_amdgcn_rcpf(x); }
__device__ __forceinline__ float sigmoidf_(float x) { return fast_rcp(1.f + fast_exp2(-x * LOG2E)); }
__device__ __forceinline__ float wave_sum(float v) {
#pragma unroll
    for (int o = 1; o < 64; o <<= 1) v += __shfl_xor(v, o);
    return v;
}
__device__ __forceinline__ int lane_id() { int l; asm volatile("v_mbcnt_lo_u32_b32 %0, -1, 0\n\tv_mbcnt_hi_u32_b32 %0, -1, %0" : "=v"(l)); return l; }
__device__ __forceinline__ int perm23(int t) { return (t & ~12) | ((t & 4) << 1) | ((t & 8) >> 1); }
#define LDS_WAIT() asm volatile("s_waitcnt lgkmcnt(0)" ::: "memory")
#define VM_WAIT() asm volatile("s_waitcnt vmcnt(0)" ::: "memory")

#define XB_TMO      128
#define XB_XCNT(j)  (256  + 64 * (j))
#define XB_XSUB(j)  (1280 + 64 * (j))
#define XB_XGEN(j)  (2304 + 64 * (j))
#define XB_TOP      3328
#define XB_TOPGEN   3392
#define XCD_BAR_WORDS 3456
#define XB_SPIN_CAP (1u << 18)
__device__ __forceinline__ unsigned xb_ld(unsigned* p)              { return __hip_atomic_load(p, __ATOMIC_RELAXED, __HIP_MEMORY_SCOPE_AGENT); }
__device__ __forceinline__ unsigned xb_add(unsigned* p, unsigned v) { return __hip_atomic_fetch_add(p, v, __ATOMIC_RELAXED, __HIP_MEMORY_SCOPE_AGENT); }
__device__ __forceinline__ unsigned xb_xcc_id() { return (unsigned)__builtin_amdgcn_s_getreg((3 << 11) | 20) & 0xFu; }
#define XB_SPIN(cond, bar) do { unsigned _sp = 0; while (cond) { __builtin_amdgcn_s_sleep(1); \
    if ((++_sp & 255u) == 0u) { if (xb_ld(&(bar)[XB_TMO])) break; if (_sp > XB_SPIN_CAP) { atomicAdd(&(bar)[XB_TMO], 1u); break; } } } } while (0)
struct XcdBarrier { unsigned* bar; unsigned x; volatile LAS unsigned* st; };
__device__ __forceinline__ XcdBarrier xcd_barrier_post(unsigned* bar, volatile LAS unsigned* st) {
    XcdBarrier b; b.bar = bar; b.x = xb_xcc_id(); b.st = st;
    if (threadIdx.x == 0) (void)xb_add(&bar[XB_XCNT(b.x)], 1u);
    return b;
}
__device__ __forceinline__ void xcd_barrier_complete(unsigned* bar, unsigned x, unsigned& nloc, unsigned& nx) {
    const unsigned G = gridDim.x * gridDim.y * gridDim.z;
    unsigned sum, cnt, mine, sp = 0u;
    for (;;) {
        sum = 0u; cnt = 0u; mine = 0u;
#pragma unroll
        for (unsigned j = 0; j < 16; ++j) { const unsigned c = xb_ld(&bar[XB_XCNT(j)]); sum += c; cnt += (c > 0u) ? 1u : 0u; mine = (j == x) ? c : mine; }
        if (sum == G) break;
        __builtin_amdgcn_s_sleep(1);
        if ((++sp & 255u) == 0u) { if (xb_ld(&bar[XB_TMO])) break; if (sp > XB_SPIN_CAP) { atomicAdd(&bar[XB_TMO], 1u); break; } }
    }
    nloc = mine > 0u ? mine : 1u; nx = cnt > 0u ? cnt : 1u;
}
__device__ __noinline__ void xcd_barrier_impl(unsigned* bar_, unsigned x_, volatile LAS unsigned* st_) {
    XcdBarrier b; b.bar = bar_; b.x = x_; b.st = st_;
    asm volatile("s_waitcnt vmcnt(0)" ::: "memory");
    __syncthreads();
    if (threadIdx.x == 0) {
        unsigned* bar = b.bar;
        __builtin_amdgcn_s_waitcnt(0);
        unsigned nloc = b.st[0], nx = b.st[1];
        if (nloc == 0u) { xcd_barrier_complete(bar, b.x, nloc, nx); b.st[0] = nloc; b.st[1] = nx; }
        const unsigned old = xb_add(&bar[XB_XSUB(b.x)], 1u);
        const unsigned gen = old / nloc;
        if (old + 1u == (gen + 1u) * nloc) {
            __builtin_amdgcn_fence(__ATOMIC_RELEASE, "agent");
            asm volatile("s_waitcnt vmcnt(0)" ::: "memory");
            const unsigned og = xb_add(&bar[XB_TOP], 1u);
            const unsigned tg = og / nx;
            if (og + 1u == (tg + 1u) * nx) xb_add(&bar[XB_TOPGEN], 1u);
            else XB_SPIN(xb_ld(&bar[XB_TOPGEN]) == tg, bar);
            __builtin_amdgcn_fence(__ATOMIC_ACQUIRE, "agent");
            xb_add(&bar[XB_XGEN(b.x)], 1u);
            asm volatile("s_waitcnt vmcnt(0)" ::: "memory");
        } else {
            XB_SPIN(xb_ld(&bar[XB_XGEN(b.x)]) == gen, bar);
            __builtin_amdgcn_fence(__ATOMIC_ACQUIRE, "agent");
            asm volatile("s_waitcnt vmcnt(0)" ::: "memory");
        }
    }
    __syncthreads();
}

namespace pg8 {
typedef int v4i_t __attribute__((ext_vector_type(4))); typedef int v8i_t __attribute__((ext_vector_type(8)));
constexpr int BM = 256, BK = 64, HALF = 128, HTB = HALF * BK * 2, STAGE_BYTES = 8 * HTB, NXCD = 8, WGM = 8;
__host__ __device__ __forceinline__ int lds_byte(int r, int c) { const int st = (r >> 4) * 2 + (c >> 5), rr = r & 15, cc = c & 31, ob = rr * 64 + cc * 2; return st * 1024 + (ob ^ (((ob >> 9) & 1) << 5)); }
__host__ __device__ __forceinline__ void stage_rc(int b, int& R, int& C) { const int st = b / 1024, sb = b % 1024, swz = sb ^ (((sb >> 9) & 1) << 5); R = (st >> 1) * 16 + swz / 64; C = (st & 1) * 32 + (swz % 64) / 2; }
__host__ __device__ __forceinline__ int perm32(int rho) { const int n = rho >> 4, i = rho & 15; return 8 * (i >> 2) + 4 * n + (i & 3); }

struct Unit { int pm, pn, aux; const char* a; const char* b; };

__device__ __forceinline__ bool tile_of(int i, int G, int c, int nM, int nN, int& pm, int& pn) {
    const int nwg = nM * nN; const long L = (long)i * G + c; if (L >= nwg) return false;
    int wgid = (int)L; { const int q = nwg / NXCD, r = nwg % NXCD, xcd = wgid % NXCD, off = wgid / NXCD; wgid = (xcd < r ? xcd * (q + 1) : r * (q + 1) + (xcd - r) * q) + off; }
    const int nig = WGM * nN, gid = wgid / nig, fm = gid * WGM, gsz = (nM - fm) < WGM ? (nM - fm) : WGM;
    pm = fm + ((wgid % nig) % gsz); pn = (wgid % nig) / gsz; return true;
}
struct StaticOrder {
    const bf16_t* A; const bf16_t* Bt; int lda, ldb, nM, nN, G, c;
    __device__ __forceinline__ bool next(int i, Unit& u) const {
        if (!tile_of(i, G, c, nM, nN, u.pm, u.pn)) return false;
        u.aux = 0; u.a = (const char*)(A + (size_t)u.pm * BM * lda); u.b = (const char*)(Bt + (size_t)u.pn * BM * ldb); return true;
    }
};
struct StaticOrder8 {
    const unsigned char* A; const unsigned char* Bt; int lda, ldb, nM, nN, G, c;
    __device__ __forceinline__ bool next(int i, Unit& u) const {
        if (!tile_of(i, G, c, nM, nN, u.pm, u.pn)) return false;
        u.aux = 0; u.a = (const char*)(A + (size_t)u.pm * BM * lda); u.b = (const char*)(Bt + (size_t)u.pn * BM * ldb); return true;
    }
};
struct MergeOrder {
    const bf16_t* BR; const bf16_t* WbT; int G, c;
    __device__ __forceinline__ bool next(int i, Unit& u) const {
        if (!tile_of(i >> 2, G, c, MTOK / BM, DM / BM, u.pm, u.pn)) return false;
        const int n = i & 3; u.aux = n; u.a = (const char*)(BR + (size_t)u.pm * BM * DM + n * 512); u.b = (const char*)(WbT + (size_t)n * DM * 512 + (size_t)u.pn * BM * 512); return true;
    }
};
struct MergeOrder8 {
    const unsigned char* BR; const unsigned char* WbT; int G, c;
    __device__ __forceinline__ bool next(int i, Unit& u) const {
        if (!tile_of(i >> 2, G, c, MTOK / BM, DM / BM, u.pm, u.pn)) return false;
        const int n = i & 3; u.aux = n; u.a = (const char*)(BR + (size_t)u.pm * BM * DM + n * 512); u.b = (const char*)(WbT + (size_t)n * DM * 512 + (size_t)u.pn * BM * 512); return true;
    }
};
struct MoeOrder {
    const unsigned char* A; const unsigned char* W; const int* panel; int lda, ldb, nN, G, c;
    __device__ __forceinline__ bool next(int i, Unit& u) const {
        const int nP = panel[0]; const long L = (long)i * G + c; if (L >= (long)nP * nN) return false;
        const int nig = WGM * nN, gid = (int)(L / nig), within = (int)(L % nig), fm = gid * WGM, gsz = (nP - fm) < WGM ? (nP - fm) : WGM;
        u.pm = fm + within % gsz; u.pn = within / gsz; const int e = panel[1 + u.pm]; u.aux = e;
        u.a = (const char*)(A + (size_t)u.pm * BM * lda); u.b = (const char*)(W + ((size_t)e * nN + u.pn) * BM * ldb); return true;
    }
};

template <class Epi, class Sched, bool FP8 = false, bool CHAIN = false>
__device__ __forceinline__ void gemm_phase(LAS unsigned char* lds, const int tid, const int K, const int lda, const int ldb, const Sched& S, const Epi& E) {
    constexpr int ES = FP8 ? 1 : 2;
    const int wid = __builtin_amdgcn_readfirstlane(tid >> 6), lane = tid & 63, wr = wid >> 2, wc = wid & 3, fr = lane & 15, fq = lane >> 4;
    const int nt = K * ES / 128;
    unsigned voffA[2], voffB[2];
#pragma unroll
    for (int i = 0; i < 2; ++i) { int R, C; stage_rc(tid * 16 + i * 8192, R, C); const int Rb = (R & ~31) + perm32(R & 31);
        voffA[i] = (unsigned)(R * lda * ES + C * 2); voffB[i] = (unsigned)(Rb * ldb * ES + C * 2); }
    const size_t kstep = (size_t)(BK * 2);
    const size_t hstepA = (size_t)HALF * lda * ES, hstepB = (size_t)HALF * ldb * ES;
    const unsigned ldsw = (unsigned)wid * 1024u;
    const int aoff = lds_byte(wr * 64 + fr, fq * 8), boff = lds_byte(wc * 32 + fr, fq * 8);
#define PG8_SA(b, h) (((b) * 2 + (h)) * HTB)
#define PG8_SB(b, h) ((4 + (b) * 2 + (h)) * HTB)
#define PG8_STAGE(bufoff, gbase, voff) do { _Pragma("unroll") for (int _i = 0; _i < 2; ++_i) \
        __builtin_amdgcn_global_load_lds((const unsigned*)((const char*)(gbase) + (voff)[_i]), (LAS unsigned*)(lds + (bufoff) + ldsw + _i * 8192), 16, 0, 0); } while (0)
#define PG8_LDA(dst, b, h) do { _Pragma("unroll") for (int m = 0; m < 4; ++m) { const v4i_t lo_ = *(const LAS v4i_t*)(lds + PG8_SA(b, h) + aoff + m * 2048), hi_ = *(const LAS v4i_t*)(lds + PG8_SA(b, h) + aoff + m * 2048 + 1024); \
        dst[m] = __builtin_shufflevector(lo_, hi_, 0, 1, 2, 3, 4, 5, 6, 7); } } while (0)
#define PG8_LDB(dst, b, h) do { _Pragma("unroll") for (int n = 0; n < 2; ++n) { const v4i_t lo_ = *(const LAS v4i_t*)(lds + PG8_SB(b, h) + boff + n * 2048), hi_ = *(const LAS v4i_t*)(lds + PG8_SB(b, h) + boff + n * 2048 + 1024); \
        dst[n] = __builtin_shufflevector(lo_, hi_, 0, 1, 2, 3, 4, 5, 6, 7); } } while (0)
#define PG8_MMA(ai, bj, At, Bt) do { __builtin_amdgcn_s_setprio(1); _Pragma("unroll") for (int m = 0; m < 4; ++m) _Pragma("unroll") for (int n = 0; n < 2; ++n) { \
        if constexpr (FP8) asm volatile("v_mfma_scale_f32_16x16x128_f8f6f4 %0, %1, %2, %0, %3, %3 op_sel_hi:[0,0,0]" : "+v"(acc[ai][bj][m][n]) : "v"(Bt[n]), "v"(At[m]), "v"(0x7f7f7f7f));   \
        else { acc[ai][bj][m][n] = __builtin_amdgcn_mfma_f32_16x16x32_bf16(__builtin_bit_cast(bf16x8, __builtin_shufflevector(Bt[n], Bt[n], 0, 1, 2, 3)), __builtin_bit_cast(bf16x8, __builtin_shufflevector(At[m], At[m], 0, 1, 2, 3)), acc[ai][bj][m][n], 0, 0, 0); \
               acc[ai][bj][m][n] = __builtin_amdgcn_mfma_f32_16x16x32_bf16(__builtin_bit_cast(bf16x8, __builtin_shufflevector(Bt[n], Bt[n], 4, 5, 6, 7)), __builtin_bit_cast(bf16x8, __builtin_shufflevector(At[m], At[m], 4, 5, 6, 7)), acc[ai][bj][m][n], 0, 0, 0); } } __builtin_amdgcn_s_setprio(0); } while (0)
#define PG8_WAIT_V(n) asm volatile("s_waitcnt vmcnt(" #n ")" ::: "memory")
#define PG8_WAIT_L(n) asm volatile("s_waitcnt lgkmcnt(" #n ")" ::: "memory")
#define PG8_BAR __builtin_amdgcn_s_barrier()
#define PG8_SCHED __builtin_amdgcn_sched_barrier(0)
    Unit cur, nxt; int ui = 0;
    if (!S.next(0, cur)) return;
    f32x4 acc[2][2][4][2];
#pragma unroll
    for (int a = 0; a < 2; ++a)
#pragma unroll
        for (int b = 0; b < 2; ++b)
#pragma unroll
            for (int m = 0; m < 4; ++m)
#pragma unroll
                for (int n = 0; n < 2; ++n) acc[a][b][m][n] = (f32x4){0.f, 0.f, 0.f, 0.f};
    v8i_t At[4], B0[2], B1[2];
    const char* cA = cur.a; const char* cB = cur.b;
    PG8_STAGE(PG8_SB(0, 0), cB, voffB); PG8_STAGE(PG8_SB(0, 1), cB + hstepB, voffB); PG8_STAGE(PG8_SA(0, 0), cA, voffA); PG8_STAGE(PG8_SA(0, 1), cA + hstepA, voffA);
    if (wr == 1) PG8_BAR;
    PG8_WAIT_V(2); PG8_BAR;
    PG8_STAGE(PG8_SB(1, 0), cB + kstep, voffB); PG8_STAGE(PG8_SA(1, 0), cA + kstep, voffA); PG8_STAGE(PG8_SB(1, 1), cB + hstepB + kstep, voffB);
    PG8_WAIT_V(6); PG8_BAR;
    for (;;) {
        const bool has_next = S.next(ui + 1, nxt);
        const char* nA = has_next ? nxt.a : cA; const char* nB = has_next ? nxt.b : cB;
        for (int t = 0; t < nt; t += 2) {
            const bool last = (t == nt - 2);
            const char* a1 = cA + (size_t)(t + 1) * kstep;
            const char* a2 = last ? nA : cA + (size_t)(t + 2) * kstep; const char* b2 = last ? nB : cB + (size_t)(t + 2) * kstep;
            const char* a3 = a2 + kstep; const char* b3 = b2 + kstep;
            PG8_LDB(B0, 0, 0); PG8_LDB(B1, 0, 1); PG8_SCHED; PG8_LDA(At, 0, 0); PG8_STAGE(PG8_SA(1, 1), a1 + hstepA, voffA);
            PG8_WAIT_V(8); PG8_WAIT_L(0); PG8_BAR; PG8_MMA(0, 0, At, B0); PG8_MMA(0, 1, At, B1); PG8_BAR; PG8_SCHED;
            PG8_LDA(At, 0, 1); PG8_STAGE(PG8_SB(0, 0), b2, voffB); PG8_STAGE(PG8_SB(0, 1), b2 + hstepB, voffB); PG8_STAGE(PG8_SA(0, 0), a2, voffA);
            PG8_WAIT_V(8); PG8_WAIT_L(0); PG8_BAR; PG8_MMA(1, 0, At, B0); PG8_MMA(1, 1, At, B1); PG8_BAR; PG8_SCHED;
            PG8_LDB(B0, 1, 0); PG8_LDB(B1, 1, 1); PG8_SCHED; PG8_LDA(At, 1, 0); PG8_STAGE(PG8_SA(0, 1), a2 + hstepA, voffA);
            PG8_WAIT_V(8); PG8_WAIT_L(0); PG8_BAR; PG8_MMA(0, 0, At, B0); PG8_MMA(0, 1, At, B1); PG8_BAR; PG8_SCHED;
            PG8_LDA(At, 1, 1); PG8_STAGE(PG8_SB(1, 0), b3, voffB); PG8_STAGE(PG8_SB(1, 1), b3 + hstepB, voffB); PG8_STAGE(PG8_SA(1, 0), a3, voffA);
            PG8_WAIT_V(8); PG8_WAIT_L(0); PG8_BAR; PG8_MMA(1, 0, At, B0); PG8_MMA(1, 1, At, B1); PG8_BAR; PG8_SCHED;
        }
        if (wr == 0) PG8_BAR;
        E(acc, cur, wr, wc, fr, fq);
        if (!has_next) break;
        if (!CHAIN || cur.aux == 3) {
#pragma unroll
        for (int a = 0; a < 2; ++a)
#pragma unroll
            for (int b = 0; b < 2; ++b)
#pragma unroll
                for (int m = 0; m < 4; ++m)
#pragma unroll
                    for (int n = 0; n < 2; ++n) acc[a][b][m][n] = (f32x4){0.f, 0.f, 0.f, 0.f};
        }
        cur = nxt; cA = nA; cB = nB; ++ui;
        if (wr == 1) PG8_BAR;
    }
    PG8_WAIT_V(0);
    PG8_BAR;
#undef PG8_SA
#undef PG8_SB
#undef PG8_STAGE
#undef PG8_LDA
#undef PG8_LDB
#undef PG8_MMA
#undef PG8_WAIT_V
#undef PG8_WAIT_L
#undef PG8_BAR
#undef PG8_SCHED
}
}

template <class Epi, class Sched>
__device__ __noinline__ void gemm_call(LAS unsigned char* lds, int K, int lda, int ldb, Sched S, Epi E) { pg8::gemm_phase(lds, K, lda, ldb, S, E); }

__device__ __forceinline__ u32x4 pack8(f32x4 a, f32x4 b) { u32x4 w; w.x = cvt_pk_bf16(a[0], a[1]); w.y = cvt_pk_bf16(a[2], a[3]); w.z = cvt_pk_bf16(b[0], b[1]); w.w = cvt_pk_bf16(b[2], b[3]); return w; }
__device__ __forceinline__ u32x2 pack4(f32x4 a) { u32x2 w; w.x = cvt_pk_bf16(a[0], a[1]); w.y = cvt_pk_bf16(a[2], a[3]); return w; }
__device__ __forceinline__ u32x2 pack8_fp8(f32x4 a, f32x4 b) { unsigned w0 = 0u, w1 = 0u;
    w0 = __builtin_amdgcn_cvt_pk_fp8_f32(a[0], a[1], w0, false); w0 = __builtin_amdgcn_cvt_pk_fp8_f32(a[2], a[3], w0, true);
    w1 = __builtin_amdgcn_cvt_pk_fp8_f32(b[0], b[1], w1, false); w1 = __builtin_amdgcn_cvt_pk_fp8_f32(b[2], b[3], w1, true); u32x2 r; r.x = w0; r.y = w1; return r; }
__device__ __forceinline__ void unpack8_fp8(u32x2 w, f32x4& a, f32x4& b) { typedef float f2 __attribute__((ext_vector_type(2)));
    const f2 a0 = __builtin_amdgcn_cvt_pk_f32_fp8(w.x, false), a1 = __builtin_amdgcn_cvt_pk_f32_fp8(w.x, true), b0 = __builtin_amdgcn_cvt_pk_f32_fp8(w.y, false), b1 = __builtin_amdgcn_cvt_pk_f32_fp8(w.y, true);
    a[0] = a0[0]; a[1] = a0[1]; a[2] = a1[0]; a[3] = a1[1]; b[0] = b0[0]; b[1] = b0[1]; b[2] = b1[0]; b[3] = b1[1]; }
__device__ __forceinline__ f32x4 sig4(f32x4 v) { f32x4 r; r[0] = sigmoidf_(v[0]); r[1] = sigmoidf_(v[1]); r[2] = sigmoidf_(v[2]); r[3] = sigmoidf_(v[3]); return r; }
__device__ __forceinline__ f32x4 ld_sc1_f32x4(const float* p) { typedef unsigned long long u64; const u64 a = __hip_atomic_load((const u64*)p, __ATOMIC_RELAXED, __HIP_MEMORY_SCOPE_AGENT), b = __hip_atomic_load((const u64*)p + 1, __ATOMIC_RELAXED, __HIP_MEMORY_SCOPE_AGENT);
    f32x4 r; r[0] = __uint_as_float((unsigned)a); r[1] = __uint_as_float((unsigned)(a >> 32)); r[2] = __uint_as_float((unsigned)b); r[3] = __uint_as_float((unsigned)(b >> 32)); return r; }
__device__ __forceinline__ u32x4 ld_sc1_u32x4(const void* p) { typedef unsigned long long u64; const u64 a = __hip_atomic_load((const u64*)p, __ATOMIC_RELAXED, __HIP_MEMORY_SCOPE_AGENT), b = __hip_atomic_load((const u64*)p + 1, __ATOMIC_RELAXED, __HIP_MEMORY_SCOPE_AGENT);
    u32x4 r; r.x = (unsigned)a; r.y = (unsigned)(a >> 32); r.z = (unsigned)b; r.w = (unsigned)(b >> 32); return r; }
__device__ __forceinline__ void unpack8(u32x4 w, f32x4& a, f32x4& b) { a[0] = bflo(w.x); a[1] = bfhi(w.x); a[2] = bflo(w.y); a[3] = bfhi(w.y); b[0] = bflo(w.z); b[1] = bfhi(w.z); b[2] = bflo(w.w); b[3] = bfhi(w.w); }

#define ACC_T const f32x4 (&acc)[2][2][4][2]
#define FOR_AI_M _Pragma("unroll") for (int ai = 0; ai < 2; ++ai) _Pragma("unroll") for (int m = 0; m < 4; ++m)

struct EpiA {
    unsigned char* R; const float* rope64; const float* rope32; float inv;
    __device__ __forceinline__ void vt_store(bf16_t* T, int nheads, int b, int head, int dv0, int tseq, f32x4 v0, f32x4 v1) const {
        bf16_t* p = T + ((size_t)(b * nheads + head) * 64 + dv0) * SEQ + perm23(tseq);
#pragma unroll
        for (int k = 0; k < 4; ++k) { p[(size_t)k * SEQ] = f2bf(v0[k]); p[(size_t)(4 + k) * SEQ] = f2bf(v1[k]); }
    }
    __device__ __forceinline__ void operator()(ACC_T, const pg8::Unit& u, int wr, int wc, int fr, int fq) const {
        asm volatile("" : "+v"(fr), "+v"(fq));
        const int t = u.pn; const int row0 = u.pm * 256 + wr * 64 + fr;
        if (t >= 20) {
            bf16_t* G = (bf16_t*)(R + R_GATES);
            FOR_AI_M { const int row = row0 + ai * 128 + m * 16;
#pragma unroll
                for (int bj = 0; bj < 2; ++bj) *(u32x4*)(G + (size_t)row * 8192 + (t - 20) * 256 + bj * 128 + wc * 32 + fq * 8) = pack8(acc[ai][bj][m][0], acc[ai][bj][m][1]); }
        } else if (t < 6) {
            bf16_t* dst; int ld, col; float sc;
            if (t < 2) { dst = (bf16_t*)(R + R_AQ); ld = 512; col = (t & 1) * 256 + 64 * wc; sc = QS64 * inv; }
            else if (t < 4) { dst = (bf16_t*)(R + R_BQ); ld = 512; col = (t & 1) * 256 + 64 * wc; sc = QS64 * inv; }
            else if (t == 4) { dst = (bf16_t*)(R + (wc < 2 ? R_AKC : R_AKS)); ld = 128; col = 64 * (wc & 1); sc = inv; }
            else { dst = (bf16_t*)(R + (wc < 2 ? R_AKW : R_BK)); ld = 128; col = 64 * (wc & 1); sc = inv; }
            FOR_AI_M { const int row = row0 + ai * 128 + m * 16; const float* rp = rope64 + (size_t)row * 64 + 8 * fq;
                const f32x4 c0 = *(const f32x4*)rp, c1 = *(const f32x4*)(rp + 4), s0 = *(const f32x4*)(rp + 32), s1 = *(const f32x4*)(rp + 36);
                const f32x4 l0 = acc[ai][0][m][0], l1 = acc[ai][0][m][1], h0 = acc[ai][1][m][0], h1 = acc[ai][1][m][1];
                const f32x4 ol0 = (l0 * c0 - h0 * s0) * sc, ol1 = (l1 * c1 - h1 * s1) * sc, oh0 = (h0 * c0 + l0 * s0) * sc, oh1 = (h1 * c1 + l1 * s1) * sc;
                bf16_t* p = dst + (size_t)row * ld + col + 8 * fq;
                *(u32x4*)p = pack8(ol0, ol1); *(u32x4*)(p + 32) = pack8(oh0, oh1); }
        } else if (t < 10) {
            bf16_t* dst = (bf16_t*)(R + (t < 8 ? R_CQ : R_CK)); const float sc = (t < 8 ? QS64 : 1.f) * inv;
            FOR_AI_M { const int row = row0 + ai * 128 + m * 16;
#pragma unroll
                for (int bj = 0; bj < 2; ++bj) *(u32x4*)(dst + (size_t)row * 512 + (t & 1) * 256 + bj * 128 + wc * 32 + fq * 8) = pack8(acc[ai][bj][m][0] * sc, acc[ai][bj][m][1] * sc); }
        } else if (t < 14) {
            bf16_t* dst = (bf16_t*)(R + (t < 12 ? R_DQ : R_DK)); const float sc = (t < 12 ? QS32 : 1.f) * inv;
            FOR_AI_M { const int row = row0 + ai * 128 + m * 16; const float* rp = rope32 + (size_t)row * 32 + 4 * fq;
                const f32x4 c = *(const f32x4*)rp, s = *(const f32x4*)(rp + 16);
#pragma unroll
                for (int n = 0; n < 2; ++n) { const f32x4 lo = acc[ai][0][m][n], hi = acc[ai][1][m][n];
                    bf16_t* p = dst + (size_t)row * 512 + (t & 1) * 256 + 64 * wc + 32 * n + 4 * fq;
                    *(u32x2*)p = pack4((lo * c - hi * s) * sc); *(u32x2*)(p + 16) = pack4((hi * c + lo * s) * sc); } }
        } else {
            const int b = u.pm >> 4;
            FOR_AI_M { const int row = row0 + ai * 128 + m * 16; const int tseq = row & (SEQ - 1);
#pragma unroll
                for (int bj = 0; bj < 2; ++bj) { const f32x4 v0 = acc[ai][bj][m][0] * inv, v1 = acc[ai][bj][m][1] * inv; const int dv0 = 32 * (wc & 1) + 8 * fq, hh = wc >> 1;
                    if (t == 14) { if (bj == 0) *(u32x4*)((bf16_t*)(R + R_AVC) + (size_t)row * 128 + wc * 32 + fq * 8) = pack8(v0, v1);
                                   else vt_store((bf16_t*)(R + R_AVST), 2, b, hh, dv0, tseq, v0, v1); }
                    else if (t == 15) vt_store((bf16_t*)(R + (bj == 0 ? R_AVWT : R_BVT)), 2, b, hh, dv0, tseq, v0, v1);
                    else vt_store((bf16_t*)(R + (t < 18 ? R_CVT : R_DVT)), 8, b, (t & 1) * 4 + 2 * bj + hh, dv0, tseq, v0, v1); }
                asm volatile("s_waitcnt vmcnt(16)" ::: "memory"); }
        }
    }
};
struct EpiGate8 {
    unsigned char* G; float inv_scale;
    __device__ __forceinline__ void operator()(ACC_T, const pg8::Unit& u, int wr, int wc, int fr, int fq) const {
        asm volatile("" : "+v"(fr), "+v"(fq));
        const unsigned row0 = (unsigned)(u.pm * 256 + wr * 64 + fr), colb = (unsigned)(u.pn * 256 + wc * 32 + fq * 8);
        FOR_AI_M { const unsigned row = row0 + ai * 128 + m * 16;
#pragma unroll
            for (int bj = 0; bj < 2; ++bj) { f32x4 l0, l1;
#pragma unroll
                for (int i = 0; i < 4; ++i) { l0[i] = -__builtin_amdgcn_logf(1.f + fast_exp2(fminf(-acc[ai][bj][m][0][i] * (inv_scale * LOG2E), 100.f))); l1[i] = -__builtin_amdgcn_logf(1.f + fast_exp2(fminf(-acc[ai][bj][m][1][i] * (inv_scale * LOG2E), 100.f))); }
                *(u32x2*)(G + (row * 8192u + colb + bj * 128)) = pack8_fp8(l0, l1); } }
    }
};
struct EpiMerge {
    const unsigned char* gates; bf16_t* merged; unsigned char* merged8;
    __device__ __forceinline__ void operator()(ACC_T, const pg8::Unit& u, int wr, int wc, int fr, int fq) const {
        asm volatile("" : "+v"(fr), "+v"(fq));
        const int n = u.aux; const unsigned row0 = (unsigned)(u.pm * 256 + wr * 64 + fr), colb = (unsigned)(u.pn * 256 + wc * 32 + fq * 8);
        const unsigned char* gb = gates + n * 2048;
#pragma unroll
        for (int ai = 0; ai < 2; ++ai)
#pragma unroll
            for (int mp = 0; mp < 2; ++mp) {
                u32x2 g[2][2]; u32x4 p[2][2];
#pragma unroll
                for (int mm = 0; mm < 2; ++mm)
#pragma unroll
                    for (int bj = 0; bj < 2; ++bj) { const unsigned row = row0 + ai * 128 + (2 * mp + mm) * 16, col = colb + bj * 128;
                        g[mm][bj] = *(const u32x2*)(gb + (row * 8192u + col));
                        if (n > 0) p[mm][bj] = *(const u32x4*)(merged + (row * 2048u + col)); else p[mm][bj] = (u32x4){0u, 0u, 0u, 0u}; }
#pragma unroll
                for (int mm = 0; mm < 2; ++mm)
#pragma unroll
                    for (int bj = 0; bj < 2; ++bj) { const int m = 2 * mp + mm; const unsigned row = row0 + ai * 128 + m * 16, col = colb + bj * 128;
                        f32x4 g0, g1, p0, p1; unpack8_fp8(g[mm][bj], g0, g1); unpack8(p[mm][bj], p0, p1); g0 = sig4(g0); g1 = sig4(g1);
                        const f32x4 v0 = g0 * acc[ai][bj][m][0] + p0, v1 = g1 * acc[ai][bj][m][1] + p1;
                        if (n < 3) *(u32x4*)(merged + (row * 2048u + col)) = pack8(v0, v1); else *(u32x2*)(merged8 + (row * 2048u + col)) = pack8_fp8(v0 * MERGED8_SCALE, v1 * MERGED8_SCALE); }
                asm volatile("" ::: "memory");
            }
    }
};
#ifndef MERGE_CHAIN
#define MERGE_CHAIN 1
#endif
struct EpiMergeChain {
    const unsigned char* gates; unsigned char* merged8; float inv;
    __device__ __forceinline__ void operator()(f32x4 (&acc)[2][2][4][2], const pg8::Unit& u, int wr, int wc, int fr, int fq) const {
        asm volatile("" : "+v"(fr), "+v"(fq));
        const int n = u.aux; const unsigned row0 = (unsigned)(u.pm * 256 + wr * 64 + fr), colb = (unsigned)(u.pn * 256 + wc * 32 + fq * 8);
        const unsigned char* gb = gates + n * 2048;
#pragma unroll
        for (int ai = 0; ai < 2; ++ai)
#pragma unroll
            for (int mp = 0; mp < 2; ++mp) {
                u32x2 g[2][2], h[2][2];
#pragma unroll
                for (int mm = 0; mm < 2; ++mm)
#pragma unroll
                    for (int bj = 0; bj < 2; ++bj) { const unsigned row = row0 + ai * 128 + (2 * mp + mm) * 16, col = colb + bj * 128;
                        g[mm][bj] = *(const u32x2*)(gb + (row * 8192u + col));
                        if (n < 3) h[mm][bj] = *(const u32x2*)(gb + 2048 + (row * 8192u + col)); else h[mm][bj] = (u32x2){0u, 0u}; }
#pragma unroll
                for (int mm = 0; mm < 2; ++mm)
#pragma unroll
                    for (int bj = 0; bj < 2; ++bj) { const int m = 2 * mp + mm; const unsigned row = row0 + ai * 128 + m * 16, col = colb + bj * 128;
                        f32x4 x0, x1; unpack8_fp8(g[mm][bj], x0, x1);
                        if (n < 3) { f32x4 y0, y1; unpack8_fp8(h[mm][bj], y0, y1);
#pragma unroll
                            for (int i = 0; i < 4; ++i) { acc[ai][bj][m][0][i] *= fast_exp2(x0[i] - y0[i]); acc[ai][bj][m][1][i] *= fast_exp2(x1[i] - y1[i]); } }
                        else { f32x4 d0, d1;
#pragma unroll
                            for (int i = 0; i < 4; ++i) { d0[i] = fast_exp2(x0[i]); d1[i] = fast_exp2(x1[i]); }
                            *(u32x2*)(merged8 + (row * 2048u + col)) = pack8_fp8(acc[ai][bj][m][0] * d0 * (MERGED8_SCALE * inv), acc[ai][bj][m][1] * d1 * (MERGED8_SCALE * inv)); } }
                asm volatile("" ::: "memory");
            }
    }
};
struct EpiF32 {
    float* out; float scale;
    __device__ __forceinline__ void operator()(ACC_T, const pg8::Unit& u, int wr, int wc, int fr, int fq) const {
        asm volatile("" : "+v"(fr), "+v"(fq));
        const unsigned row0 = (unsigned)(u.pm * 256 + wr * 64 + fr), colb = (unsigned)(u.pn * 256 + wc * 32 + fq * 8);
        FOR_AI_M { const unsigned row = row0 + ai * 128 + m * 16;
#pragma unroll
            for (int bj = 0; bj < 2; ++bj) { const unsigned o = row * 2048u + colb + bj * 128; *(f32x4*)(out + o) = acc[ai][bj][m][0] * scale; *(f32x4*)(out + o + 4) = acc[ai][bj][m][1] * scale; } }
    }
};
struct EpiBf16S {
    bf16_t* out; float scale;
    __device__ __forceinline__ void operator()(ACC_T, const pg8::Unit& u, int wr, int wc, int fr, int fq) const {
        asm volatile("" : "+v"(fr), "+v"(fq));
        const unsigned row0 = (unsigned)(u.pm * 256 + wr * 64 + fr), colb = (unsigned)(u.pn * 256 + wc * 32 + fq * 8);
        FOR_AI_M { const unsigned row = row0 + ai * 128 + m * 16;
#pragma unroll
            for (int bj = 0; bj < 2; ++bj) *(u32x4*)(out + (row * 2048u + colb + bj * 128)) = pack8(acc[ai][bj][m][0] * scale, acc[ai][bj][m][1] * scale); }
    }
};
struct EpiSwiglu {
    bf16_t* act; int ld;
    __device__ __forceinline__ void operator()(ACC_T, const pg8::Unit& u, int wr, int wc, int fr, int fq) const {
        asm volatile("" : "+v"(fr), "+v"(fq));
        const int row0 = u.pm * 256 + wr * 64 + fr;
        FOR_AI_M { const int row = row0 + ai * 128 + m * 16; f32x4 o[2];
#pragma unroll
            for (int n = 0; n < 2; ++n) { const f32x4 g = acc[ai][0][m][n], up = acc[ai][1][m][n];
#pragma unroll
                for (int i = 0; i < 4; ++i) o[n][i] = g[i] * sigmoidf_(g[i]) * up[i]; }
            *(u32x4*)(act + (size_t)row * ld + u.pn * 128 + wc * 32 + fq * 8) = pack8(o[0], o[1]); }
    }
};
struct EpiSwigluF8 {
    unsigned char* act; int ld; float inv_scale;
    __device__ __forceinline__ void operator()(ACC_T, const pg8::Unit& u, int wr, int wc, int fr, int fq) const {
        asm volatile("" : "+v"(fr), "+v"(fq));
        const int row0 = u.pm * 256 + wr * 64 + fr;
        FOR_AI_M { const int row = row0 + ai * 128 + m * 16; f32x4 o[2];
#pragma unroll
            for (int n = 0; n < 2; ++n) { const f32x4 g = acc[ai][0][m][n] * inv_scale, up = acc[ai][1][m][n] * inv_scale;
#pragma unroll
                for (int i = 0; i < 4; ++i) o[n][i] = g[i] * sigmoidf_(g[i]) * up[i]; }
            *(u32x2*)(act + (size_t)row * ld + u.pn * 128 + wc * 32 + fq * 8) = pack8_fp8(o[0], o[1]); }
    }
};
struct EpiBf16 {
    bf16_t* out;
    __device__ __forceinline__ void operator()(ACC_T, const pg8::Unit& u, int wr, int wc, int fr, int fq) const {
        asm volatile("" : "+v"(fr), "+v"(fq));
        const int row0 = u.pm * 256 + wr * 64 + fr;
        FOR_AI_M { const int row = row0 + ai * 128 + m * 16;
#pragma unroll
            for (int bj = 0; bj < 2; ++bj) *(u32x4*)(out + (size_t)row * DM + u.pn * 256 + bj * 128 + wc * 32 + fq * 8) = pack8(acc[ai][bj][m][0], acc[ai][bj][m][1]); }
    }
};
struct EpiPleGate {
    const bf16_t* ptmp; bf16_t* ple; float scale;
    __device__ __forceinline__ void operator()(ACC_T, const pg8::Unit& u, int wr, int wc, int fr, int fq) const {
        asm volatile("" : "+v"(fr), "+v"(fq));
        const int row0 = u.pm * 256 + wr * 64 + fr;
        FOR_AI_M { const int row = row0 + ai * 128 + m * 16;
#pragma unroll
            for (int bj = 0; bj < 2; ++bj) { const size_t o = (size_t)row * DM + u.pn * 256 + bj * 128 + wc * 32 + fq * 8;
                f32x4 p0, p1; unpack8(ld_sc1_u32x4(ptmp + o), p0, p1);
                *(u32x4*)(ple + o) = pack8(sig4(acc[ai][bj][m][0] * scale) * p0, sig4(acc[ai][bj][m][1] * scale) * p1); }
            asm volatile("" ::: "memory"); }
    }
};
struct EpiMoeDown {
    const float* sroww; bf16_t* ys; float inv_scale;
    __device__ __forceinline__ void operator()(ACC_T, const pg8::Unit& u, int wr, int wc, int fr, int fq) const {
        asm volatile("" : "+v"(fr), "+v"(fq));
        const int row0 = u.pm * 256 + wr * 64 + fr;
        FOR_AI_M { const int row = row0 + ai * 128 + m * 16; const float w = sroww[row] * inv_scale;
#pragma unroll
            for (int bj = 0; bj < 2; ++bj) *(u32x4*)(ys + (size_t)row * DM + u.pn * 256 + bj * 128 + wc * 32 + fq * 8) = pack8(acc[ai][bj][m][0] * w, acc[ai][bj][m][1] * w); }
    }
};

struct Args { const void* in[28]; float* out; unsigned char* ws; int ph_lo, ph_hi; };
enum { IN_X = 0, IN_P, IN_POS, IN_WIN, IN_PE, IN_CW1, IN_CB1, IN_CW2, IN_SINK, IN_FOXB, IN_DLAM, IN_DGAIN, IN_WBR, IN_WOUT, IN_LN1G, IN_LN1B,
       IN_FWG, IN_FWU, IN_FWD, IN_ROUTER, IN_ROUTERB, IN_MWG, IN_MWU, IN_MWD, IN_PPROJ, IN_PGATE, IN_LN2G, IN_LN2B };
struct Frame { LAS unsigned char* lds; int tid, lane, wave, vcu, G; };

enum { MAP_PLAIN = 0, MAP_R64 = 1, MAP_R32 = 2, MAP_GU = 3 };
struct TrSeg { const float* W; bf16_t* WT; int ldw, K, ncols, ldt, kind, vbase, aoff, item0; float f8scale; int pad; };
__device__ __forceinline__ int map_row(int kind, int a) {
    if (kind == MAP_R64) { const int l = a & 255; return (a & ~255) + 128 * ((l >> 5) & 1) + 32 * (l >> 6) + (l & 31); }
    if (kind == MAP_R32) { const int l = a & 255; return (a & ~255) + 128 * ((l >> 4) & 1) + 32 * (l >> 6) + 8 * ((l >> 2) & 3) + 4 * ((l >> 5) & 1) + (l & 3); }
    if (kind == MAP_GU) return (a >> 7) * 256 + (a & 127);
    return a;
}
__device__ __forceinline__ void tr_item(const TrSeg& s, int item, LAS unsigned char* scr, int lane) {
    const int nblk = s.ncols >> 6, kb = item / nblk, nb = item - kb * nblk, k0 = kb * 64, n0 = nb * 64;
    const int q4 = lane >> 4, n4 = (lane & 15) * 4;
    f32x4 v[16];
    const float* src = s.W + (size_t)(k0 + q4 * 16) * s.ldw + n0 + n4;
#pragma unroll
    for (int kk = 0; kk < 16; ++kk) v[kk] = *(const f32x4*)(src + (size_t)kk * s.ldw);
    if (s.f8scale != 0.f) {
        const float sc = s.f8scale;
#pragma unroll
        for (int i = 0; i < 4; ++i) { u32x4 w;
#pragma unroll
            for (int j = 0; j < 4; ++j) { unsigned d = 0u; d = __builtin_amdgcn_cvt_pk_fp8_f32(v[4 * j][i] * sc, v[4 * j + 1][i] * sc, d, false); d = __builtin_amdgcn_cvt_pk_fp8_f32(v[4 * j + 2][i] * sc, v[4 * j + 3][i] * sc, d, true); w[j] = d; }
            *(LAS u32x4*)(scr + (n4 + i) * 144 + q4 * 16) = w; }
        LDS_WAIT(); asm volatile("" ::: "memory");
#pragma unroll
        for (int it = 0; it < 4; ++it) { const int n = (lane >> 2) + 16 * it, ch = lane & 3;
            const u32x4 val = *(const LAS u32x4*)(scr + n * 144 + ch * 16);
            const int vr = s.vbase + map_row(s.kind, s.aoff + n0 + n);
            *(u32x4*)((unsigned char*)s.WT + (size_t)vr * s.ldt + k0 + ch * 16) = val; }
        LDS_WAIT(); asm volatile("" ::: "memory");
        return;
    }
#pragma unroll
    for (int i = 0; i < 4; ++i) {
        u32x4 w0, w1;
        w0.x = cvt_pk_bf16(v[0][i], v[1][i]); w0.y = cvt_pk_bf16(v[2][i], v[3][i]); w0.z = cvt_pk_bf16(v[4][i], v[5][i]); w0.w = cvt_pk_bf16(v[6][i], v[7][i]);
        w1.x = cvt_pk_bf16(v[8][i], v[9][i]); w1.y = cvt_pk_bf16(v[10][i], v[11][i]); w1.z = cvt_pk_bf16(v[12][i], v[13][i]); w1.w = cvt_pk_bf16(v[14][i], v[15][i]);
        LAS unsigned char* p = scr + (n4 + i) * 144 + q4 * 32;
        *(LAS u32x4*)p = w0; *(LAS u32x4*)(p + 16) = w1;
    }
    LDS_WAIT(); asm volatile("" ::: "memory");
#pragma unroll
    for (int it = 0; it < 8; ++it) { const int n = (lane >> 3) + 8 * it, ch = lane & 7;
        const u32x4 val = *(const LAS u32x4*)(scr + n * 144 + ch * 16);
        const int vr = s.vbase + map_row(s.kind, s.aoff + n0 + n);
        *(u32x4*)(s.WT + (size_t)vr * s.ldt + k0 + ch * 8) = val; }
    LDS_WAIT(); asm volatile("" ::: "memory");
}
__device__ __forceinline__ void tr_item_f8(const TrSeg& s, int item, LAS unsigned char* scr, int lane) {
    const int nblk = s.ncols >> 6, kb = item / nblk, nb = item - kb * nblk, k0 = kb * 128, n0 = nb * 64;
    const int q4 = lane >> 4, n4 = (lane & 15) * 4;
    f32x4 v[32];
    const float* src = s.W + (size_t)(k0 + q4 * 32) * s.ldw + n0 + n4;
#pragma unroll
    for (int kk = 0; kk < 32; ++kk) v[kk] = *(const f32x4*)(src + (size_t)kk * s.ldw);
    const float sc = s.f8scale;
#pragma unroll
    for (int i = 0; i < 4; ++i) { u32x4 w0, w1;
#pragma unroll
        for (int j = 0; j < 4; ++j) { unsigned d = 0u; d = __builtin_amdgcn_cvt_pk_fp8_f32(v[4 * j][i] * sc, v[4 * j + 1][i] * sc, d, false); d = __builtin_amdgcn_cvt_pk_fp8_f32(v[4 * j + 2][i] * sc, v[4 * j + 3][i] * sc, d, true); w0[j] = d;
            unsigned e = 0u; e = __builtin_amdgcn_cvt_pk_fp8_f32(v[16 + 4 * j][i] * sc, v[17 + 4 * j][i] * sc, e, false); e = __builtin_amdgcn_cvt_pk_fp8_f32(v[18 + 4 * j][i] * sc, v[19 + 4 * j][i] * sc, e, true); w1[j] = e; }
        LAS unsigned char* p = scr + (n4 + i) * 144 + q4 * 32; *(LAS u32x4*)p = w0; *(LAS u32x4*)(p + 16) = w1; }
    LDS_WAIT(); asm volatile("" ::: "memory");
#pragma unroll
    for (int it = 0; it < 8; ++it) { const int n = (lane >> 3) + 8 * it, ch = lane & 7;
        const u32x4 val = *(const LAS u32x4*)(scr + n * 144 + ch * 16);
        const int vr = s.vbase + map_row(s.kind, s.aoff + n0 + n);
        *(u32x4*)((unsigned char*)s.WT + (size_t)vr * s.ldt + k0 + ch * 16) = val; }
    LDS_WAIT(); asm volatile("" ::: "memory");
}
__device__ __forceinline__ void p0_prologue(const Frame& F, const Args& A) {
    unsigned char* ws = A.ws;
    LAS unsigned char* scr = F.lds + F.wave * 9216;
    LAS TrSeg* tab = (LAS TrSeg*)(F.lds + 81920);
    LAS int* tabn = (LAS int*)(F.lds + 81920 + 96 * 56);
    if (F.tid == 0) {
        int n = 0, item = 0;
#define add8(W_, ldw_, K_, ncols_, WT_, ldt_, kind_, vbase_, aoff_, f8_) do { LAS TrSeg* s_ = tab + n; s_->f8scale = (f8_); s_->pad = 0; s_->W = (W_); s_->WT = (WT_); s_->ldw = (ldw_); s_->K = (K_); s_->ncols = (ncols_); s_->ldt = (ldt_); \
            s_->kind = (kind_); s_->vbase = (vbase_); s_->aoff = (aoff_); s_->item0 = item; ++n; item += ((K_) >> 6) * ((ncols_) >> 6); } while (0)
#define add(W_, ldw_, K_, ncols_, WT_, ldt_, kind_, vbase_, aoff_) add8(W_, ldw_, K_, ncols_, WT_, ldt_, kind_, vbase_, aoff_, 0.f)
        int n_now = 0, item_now = 0;
        for (int pass = 0; pass < 2; ++pass) {
#define addp(def_, ...) do { if ((def_) == pass) add(__VA_ARGS__); } while (0)
#define addp8(def_, ...) do { if ((def_) == pass) add8(__VA_ARGS__); } while (0)
            addp(1, (const float*)A.in[IN_FWG], DFF, DM, DFF, (bf16_t*)(ws + WS_WFGU), DM, MAP_GU, 0, 0);
            addp(1, (const float*)A.in[IN_FWU], DFF, DM, DFF, (bf16_t*)(ws + WS_WFGU), DM, MAP_GU, 128, 0);
#if DENSE_DOWN_FP8
            addp8(1, (const float*)A.in[IN_FWD], DM, DFF, DM, (bf16_t*)(ws + WS_WFD), DFF8, MAP_PLAIN, 0, 0, WFD_SCALE);
#else
            addp(1, (const float*)A.in[IN_FWD], DM, DFF, DM, (bf16_t*)(ws + WS_WFD), DFF, MAP_PLAIN, 0, 0);
#endif
            for (int L = 0; L < NLAYER; ++L) {
                const float* win = (const float*)A.in[IN_WIN] + (size_t)L * DM * INC; bf16_t* wa = (bf16_t*)(ws + WS_WA + L * SZ_WA);
#if QKV_FP8
#define ADDWA(W_, nc_, kind_, vb_, ao_) addp8(L, W_, INC, DM, nc_, wa, DM, kind_, vb_, ao_, WA_SCALE)
#else
#define ADDWA(W_, nc_, kind_, vb_, ao_) addp(L, W_, INC, DM, nc_, wa, DM, kind_, vb_, ao_)
#endif
                ADDWA(win + SRC_AQ, 512, MAP_R64, 0 * 256, 0);
                ADDWA(win + SRC_BQ, 512, MAP_R64, 2 * 256, 0);
                ADDWA(win + SRC_AKC, 128, MAP_R64, 4 * 256, 0);
                ADDWA(win + SRC_AKS, 128, MAP_R64, 4 * 256, 128);
                ADDWA(win + SRC_AKW, 128, MAP_R64, 5 * 256, 0);
                ADDWA(win + SRC_BK, 128, MAP_R64, 5 * 256, 128);
                ADDWA(win + SRC_CQ, 512, MAP_PLAIN, 6 * 256, 0);
                ADDWA(win + SRC_CK, 512, MAP_PLAIN, 8 * 256, 0);
                ADDWA(win + SRC_DQ, 512, MAP_R32, 10 * 256, 0);
                ADDWA(win + SRC_DK, 512, MAP_R32, 12 * 256, 0);
                ADDWA(win + SRC_AVC, 128, MAP_PLAIN, 14 * 256, 0);
                ADDWA(win + SRC_AVS, 128, MAP_PLAIN, 14 * 256, 128);
                ADDWA(win + SRC_AVW, 128, MAP_PLAIN, 15 * 256, 0);
                ADDWA(win + SRC_BV, 128, MAP_PLAIN, 15 * 256, 128);
                ADDWA(win + SRC_CV, 512, MAP_PLAIN, 16 * 256, 0);
                ADDWA(win + SRC_DV, 512, MAP_PLAIN, 18 * 256, 0);
                addp8(L, win + SRC_MG, INC, DM, 8192, (bf16_t*)(ws + WS_WAG8 + L * SZ_WAG8), DM, MAP_PLAIN, 0, 0, GATE_W_SCALE);
                for (int kv = 0; kv < 2; ++kv) addp(L, (const float*)A.in[IN_CW1] + (size_t)(L * 2 + kv) * 2048 * 256, 256, 2048, 256, (bf16_t*)(ws + WS_WC1 + (L * 2 + kv) * SZ_WC1), 2048, MAP_PLAIN, 0, 0);
#if PD_FP8
                for (int nb = 0; nb < 4; ++nb) addp8(1, (const float*)A.in[IN_WBR] + (size_t)(L * 4 + nb) * 512 * DM, DM, 512, DM, (bf16_t*)(ws + WS_WB + L * SZ_WB + (size_t)nb * DM * 512), 512, MAP_PLAIN, 0, 0, WB_SCALE);
#else
                for (int nb = 0; nb < 4; ++nb) addp(1, (const float*)A.in[IN_WBR] + (size_t)(L * 4 + nb) * 512 * DM, DM, 512, DM, (bf16_t*)(ws + WS_WB + L * SZ_WB) + (size_t)nb * DM * 512, 512, MAP_PLAIN, 0, 0);
#endif
                addp8(1, (const float*)A.in[IN_WOUT] + (size_t)L * DM * DM, DM, DM, DM, (bf16_t*)(ws + WS_WO + L * SZ_WO), DM, MAP_PLAIN, 0, 0, WO_SCALE);
                addp(1, (const float*)A.in[IN_PPROJ] + (size_t)L * PLE * DM, DM, PLE, DM, (bf16_t*)(ws + WS_WPP + L * SZ_WPP), PLE, MAP_PLAIN, 0, 0);
                if (L == 0 && !PLE0_FP8) addp(1, (const float*)A.in[IN_PGATE] + (size_t)L * DM * DM, DM, DM, DM, (bf16_t*)(ws + WS_WPG + L * SZ_WPG), DM, MAP_PLAIN, 0, 0);
                else addp8(1, (const float*)A.in[IN_PGATE] + (size_t)L * DM * DM, DM, DM, DM, (bf16_t*)(ws + WS_WPG + L * SZ_WPG), DM, MAP_PLAIN, 0, 0, PG_SCALE);
            }
            if (pass == 0) { n_now = n; item_now = item; }
#undef addp
#undef addp8
        }
        if (F.vcu == 0) {
            int* gh = (int*)(ws + WS_CTL + DEFTAB_OFF); gh[0] = n - n_now; gh[1] = item - item_now;
            for (int i = n_now; i < n; ++i) { const LAS unsigned* src = (const LAS unsigned*)(tab + i); unsigned* dst = (unsigned*)(gh + 4) + (i - n_now) * 14;
                for (int w = 0; w < 14; ++w) dst[w] = src[w];
                ((TrSeg*)dst)->item0 = tab[i].item0 - item_now; }
        }
        n = n_now; item = item_now;
        tabn[0] = n; tabn[1] = item;
#undef add
#undef add8
    }
    __syncthreads();
    const int nseg = tabn[0], nitems = tabn[1];
    const int gw = F.vcu * NWAVES + F.wave, NGW = F.G * NWAVES;
    {
        int si = 0; TrSeg s; int send;
#define LDSEG(i_) do { LAS TrSeg* t_ = tab + (i_); s.W = (const float*)(const GAS float*)(unsigned long long)t_->W; s.WT = (bf16_t*)(GAS bf16_t*)(unsigned long long)t_->WT; s.ldw = t_->ldw; s.K = t_->K; s.ncols = t_->ncols; s.ldt = t_->ldt; s.kind = t_->kind; s.vbase = t_->vbase; s.aoff = t_->aoff; s.item0 = t_->item0; s.f8scale = t_->f8scale; \
            send = ((i_) + 1 < nseg) ? tab[(i_) + 1].item0 : nitems; } while (0)
        LDSEG(0);
        for (int it = gw; it < nitems; it += NGW) {
            while (it >= send) { ++si; LDSEG(si); }
            tr_item(s, it - s.item0, scr, F.lane);
        }
    }
    const int gt = (F.vcu * NWAVES + F.wave) * 64 + F.lane, NGT = NGW * 64;
    { const float* x = (const float*)A.in[IN_X]; bf16_t* hb = (bf16_t*)(ws + WS_HB);
      unsigned char* hb8 = ws + WS_HB8;
      for (int i = gt; i < MTOK * DM / 8; i += NGT) { const f32x4 a = *(const f32x4*)(x + (size_t)i * 8), b = *(const f32x4*)(x + (size_t)i * 8 + 4); *(u32x4*)(hb + (size_t)i * 8) = pack8(a, b); *(u32x2*)(hb8 + (size_t)i * 8) = pack8_fp8(a, b); }
      const float* p = (const float*)A.in[IN_P]; bf16_t* pb = (bf16_t*)(ws + WS_PB16);
      for (int i = gt; i < 2 * MTOK * PLE / 8; i += NGT) { const f32x4 a = *(const f32x4*)(p + (size_t)i * 8), b = *(const f32x4*)(p + (size_t)i * 8 + 4); *(u32x4*)(pb + (size_t)i * 8) = pack8(a, b); } }
#if DENSE_DOWN_FP8
    for (int i = gt; i < DM * 8; i += NGT) *(u32x4*)(ws + WS_WFD + (size_t)(i >> 3) * DFF8 + DFF + (i & 7) * 16) = (u32x4){0u, 0u, 0u, 0u};
#endif
    { const int* pos = (const int*)A.in[IN_POS]; float* r64 = (float*)(ws + WS_ROPE64); float* r32 = (float*)(ws + WS_ROPE32);
      for (int i = gt; i < MTOK * 32; i += NGT) { const int tok = i >> 5, j = i & 31; const float inv = 1.0f / powf(10000.0f, (float)(2 * j) / 64.0f); const float ang = (float)pos[tok] * inv;
          float sn, cs; sincosf(ang, &sn, &cs); r64[(size_t)tok * 64 + j] = cs; r64[(size_t)tok * 64 + 32 + j] = sn; }
      for (int i = gt; i < MTOK * 16; i += NGT) { const int tok = i >> 4, j = i & 15; const float inv = 1.0f / powf(10000.0f, (float)(2 * j) / 32.0f); const float ang = (float)pos[tok] * inv;
          float sn, cs; sincosf(ang, &sn, &cs); r32[(size_t)tok * 32 + j] = cs; r32[(size_t)tok * 32 + 16 + j] = sn; } }
    for (int i = gt; i < NLAYER * 32 * DM; i += NGT) { const int L = i / (32 * DM), r = (i / DM) & 31, k = i % DM; const int sc = r < 24 ? SRC_AG + r : SRC_CF + (r - 24);
        ((bf16_t*)(ws + WS_WS))[i] = f2bf(((const float*)A.in[IN_WIN])[((size_t)L * DM + k) * INC + sc]); }
    for (int i = gw; i < NLAYER * 2 * 256; i += NGW) { const int lk = i >> 8, n = i & 255; const float* pe = (const float*)A.in[IN_PE] + (size_t)lk * 2048 + F.lane * 32; const float* w1 = (const float*)A.in[IN_CW1] + (size_t)lk * 2048 * 256 + (size_t)(F.lane * 32) * 256 + n;
        float wv[32];
#pragma unroll
        for (int j = 0; j < 32; ++j) wv[j] = w1[(size_t)j * 256];
        float sacc = 0.f;
#pragma unroll
        for (int j = 0; j < 32; ++j) sacc += pe[j] * wv[j];
        sacc = wave_sum(sacc);
        if (F.lane == 0) ((float*)(ws + WS_CVEC))[i] = sacc + ((const float*)A.in[IN_CB1])[i]; }
}

__device__ __forceinline__ void small_gates(const Frame& F, const bf16_t* hb, const bf16_t* wsm, const float* foxb, float* ga) {
    const int fr = F.lane & 15, fq = F.lane >> 4; const int half = F.wave >> 2, wq = F.wave & 3;
    LAS f32x4* part = (LAS f32x4*)F.lds + wq * 128 + F.lane * 2;
    for (int task0 = F.vcu * 4; task0 < MTOK / 16; task0 += F.G * 4) {
        const int task = task0 + wq;
        const bf16_t* ap = hb + (size_t)(task * 16 + fr) * DM + fq * 8 + half * 1024; const bf16_t* bp = wsm + (size_t)fr * DM + fq * 8 + half * 1024;
        f32x4 acc0 = {0.f, 0.f, 0.f, 0.f}, acc1 = {0.f, 0.f, 0.f, 0.f};
#pragma unroll 1
        for (int ks = 0; ks < 32; ks += 8) {
            bf16x8 a[8], b0[8], b1[8];
#pragma unroll
            for (int j = 0; j < 8; ++j) { a[j] = *(const bf16x8*)(ap + (ks + j) * 32); b0[j] = *(const bf16x8*)(bp + (ks + j) * 32); b1[j] = *(const bf16x8*)(bp + (size_t)16 * DM + (ks + j) * 32); }
#pragma unroll
            for (int j = 0; j < 8; ++j) { acc0 = __builtin_amdgcn_mfma_f32_16x16x32_bf16(b0[j], a[j], acc0, 0, 0, 0); acc1 = __builtin_amdgcn_mfma_f32_16x16x32_bf16(b1[j], a[j], acc1, 0, 0, 0); }
        }
        if (half == 1) { part[0] = acc0; part[1] = acc1; }
        __syncthreads();
        if (half == 0) {
            acc0 = acc0 + part[0]; acc1 = acc1 + part[1];
            float* o = ga + (size_t)(task * 16 + fr) * 32 + 4 * fq;
            *(f32x4*)o = sig4(acc0);
            f32x4 r;
            if (fq < 2) r = sig4(acc1);
            else {
#pragma unroll
                for (int i = 0; i < 4; ++i) { const float x = acc1[i] + foxb[4 * (fq - 2) + i]; r[i] = fminf(x, 0.f) - log1pf(expf(-fabsf(x))); }
            }
            *(f32x4*)(o + 16) = r;
        }
        __syncthreads();
    }
}

__device__ __forceinline__ float gelu_tanh(float x) { const float u = 0.7978845608028654f * (x + 0.044715f * x * x * x); const float e = __expf(2.f * u); const float th = 1.f - 2.f / (e + 1.f); return 0.5f * x * (1.f + th); }
__device__ __forceinline__ void pb_item(const Frame& F, const Args& A, int L, int item) {
    unsigned char* ws = A.ws; unsigned char* R = ws + WS_R;
    if (item < NB * 8) { const int task = item;
        const int b = task >> 3, hh = task & 7; const float* src = (const float*)(ws + WS_GA) + ((size_t)b * SEQ + 8 * F.tid) * 32 + 24 + hh;
        LAS float* wtot = (LAS float*)(F.lds + 32768);
        float v[8];
#pragma unroll
        for (int j = 0; j < 8; ++j) v[j] = src[j * 32];
#pragma unroll
        for (int j = 1; j < 8; ++j) v[j] += v[j - 1];
        float inc = v[7];
#pragma unroll
        for (int o = 1; o < 64; o <<= 1) { const float y = __shfl_up(inc, o); if (F.lane >= o) inc += y; }
        if (F.lane == 63) wtot[F.wave] = inc;
        __syncthreads();
        float base = inc - v[7];
        for (int w = 0; w < F.wave; ++w) base += wtot[w];
        f32x4 o0, o1;
#pragma unroll
        for (int j = 0; j < 4; ++j) { o0[j] = (base + v[j]) * LOG2E; o1[j] = (base + v[4 + j]) * LOG2E; }
        float* dst = (float*)(ws + WS_CUM) + (size_t)task * SEQ + 8 * F.tid;
        *(f32x4*)dst = o0; *(f32x4*)(dst + 4) = o1;
        __syncthreads();
        return;
    }
    LAS float* hid = (LAS float*)(F.lds);
    LAS float* w2s = (LAS float*)(F.lds + 32768 + 1024);
    const int fr = F.lane & 15, fq = F.lane >> 4;
    { const int u = item - NB * 8;
        const int kv = u >> 7, b = (u >> 5) & 3, h = (u >> 4) & 1, ig = u & 15;
        const bf16_t* src = (const bf16_t*)(R + (kv == 0 ? R_AKC : R_AVC)); const bf16_t* w1t = (const bf16_t*)(ws + WS_WC1 + (L * 2 + kv) * SZ_WC1);
        const float* cvec = (const float*)(ws + WS_CVEC) + (L * 2 + kv) * 256; const float* w2 = (const float*)A.in[IN_CW2] + (size_t)(L * 2 + kv) * 256 * 64;
        { f32x4 t[8];
#pragma unroll
          for (int q = 0; q < 8; ++q) t[q] = *(const f32x4*)(w2 + (size_t)(F.tid + 512 * q) * 4);
#pragma unroll
          for (int q = 0; q < 8; ++q) *(LAS f32x4*)(w2s + (F.tid + 512 * q) * 4) = t[q]; }
        int ic = 16 * ig + fr; if (ic > 254) ic = 254;
        const bf16_t* xp = src + ((size_t)b * SEQ + 16 * ic) * 128 + h * 64 + fq * 8;
        const bf16_t* wp = w1t + (size_t)(32 * F.wave + fr) * 2048 + fq * 8;
        f32x4 acc0 = {0.f, 0.f, 0.f, 0.f}, acc1 = {0.f, 0.f, 0.f, 0.f};
#pragma unroll 1
        for (int ks = 0; ks < 64; ks += 16) {
            bf16x8 a[16], b0[16], b1[16];
#pragma unroll
            for (int j = 0; j < 16; ++j) { const int k = ks + j; a[j] = *(const bf16x8*)(xp + (size_t)(k >> 1) * 128 + (k & 1) * 32); b0[j] = *(const bf16x8*)(wp + k * 32); b1[j] = *(const bf16x8*)(wp + (size_t)16 * 2048 + k * 32); }
            asm volatile("s_waitcnt vmcnt(0)" ::: "memory");
#pragma unroll
            for (int j = 0; j < 16; ++j) { acc0 = __builtin_amdgcn_mfma_f32_16x16x32_bf16(b0[j], a[j], acc0, 0, 0, 0); acc1 = __builtin_amdgcn_mfma_f32_16x16x32_bf16(b1[j], a[j], acc1, 0, 0, 0); }
        }
#pragma unroll
        for (int i = 0; i < 4; ++i) { const int c0 = 32 * F.wave + 4 * fq + i; hid[fr * 260 + c0] = gelu_tanh(acc0[i] + cvec[c0]); hid[fr * 260 + c0 + 16] = gelu_tanh(acc1[i] + cvec[c0 + 16]); }
        __syncthreads();
        { const int r = F.tid >> 5, c0 = 2 * (F.tid & 31); float o0 = 0.f, o1 = 0.f;
#pragma unroll 16
          for (int k = 0; k < 256; ++k) { const float hv = hid[r * 260 + k]; const f32x2 w = *(const LAS f32x2*)(w2s + k * 64 + c0); o0 += hv * w.x; o1 += hv * w.y; }
          const int i = 16 * ig + r; if (i == 255) { o0 = 0.f; o1 = 0.f; }
          if (kv == 0) { *(unsigned*)((bf16_t*)(ws + WS_KC) + ((size_t)(b * 2 + h) * 256 + i) * 64 + c0) = cvt_pk_bf16(o0, o1); }
          else { bf16_t* vt = (bf16_t*)(ws + WS_VCT) + ((size_t)(b * 2 + h) * 64 + c0) * 256 + perm23(i); vt[0] = f2bf(o0); vt[256] = f2bf(o1); } }
        __syncthreads();
    }
}

__device__ __forceinline__ void ln_finish(f32x4 (&v)[8], const float* g, const float* bt, float* outf, bf16_t* outb, int lane, unsigned char* out8 = nullptr) {
    float s = 0.f;
#pragma unroll
    for (int j = 0; j < 8; ++j) s += (v[j][0] + v[j][1]) + (v[j][2] + v[j][3]);
    const float mean = wave_sum(s) * (1.f / DM); float s2 = 0.f;
#pragma unroll
    for (int j = 0; j < 8; ++j) { v[j] = v[j] - mean; s2 += (v[j][0] * v[j][0] + v[j][1] * v[j][1]) + (v[j][2] * v[j][2] + v[j][3] * v[j][3]); }
    const float rstd = 1.f / sqrtf(wave_sum(s2) * (1.f / DM) + LN_EPS);
#pragma unroll
    for (int j = 0; j < 8; ++j) { const int c = 4 * lane + 256 * j; v[j] = v[j] * rstd * *(const f32x4*)(g + c) + *(const f32x4*)(bt + c);
        if (outf) *(f32x4*)(outf + c) = v[j];
        if (outb) *(u32x2*)(outb + c) = pack4(v[j]);
        if (out8) { unsigned w = 0u; w = __builtin_amdgcn_cvt_pk_fp8_f32(v[j][0], v[j][1], w, false); w = __builtin_amdgcn_cvt_pk_fp8_f32(v[j][2], v[j][3], w, true); *(unsigned*)(out8 + c) = w; } }
}

#if PRE_BF16
typedef u32x2 PRE_T;
#define LDPRE(base_, off_) (*(const u32x2*)((const bf16_t*)(base_) + (off_)))
__device__ __forceinline__ f32x4 CVPRE(u32x2 w) { f32x4 r; r[0] = bflo(w.x); r[1] = bfhi(w.x); r[2] = bflo(w.y); r[3] = bfhi(w.y); return r; }
#else
typedef f32x4 PRE_T;
#define LDPRE(base_, off_) (*(const f32x4*)((const float*)(base_) + (off_)))
__device__ __forceinline__ f32x4 CVPRE(f32x4 w) { return w; }
#endif
__device__ __forceinline__ void pf_phase(const Frame& F, const Args& A, int L, bool moe, const float* hin) {
    unsigned char* ws = A.ws; const float* pre = (const float*)(ws + WS_R + R_PRE);
    const float* g = (const float*)A.in[IN_LN1G] + L * DM; const float* bt = (const float*)A.in[IN_LN1B] + L * DM;
    float* hf = (float*)(ws + WS_HF); bf16_t* hb = (bf16_t*)(ws + WS_HB) + (size_t)MTOK * DM;
    LAS float* wr = (LAS float*)F.lds;
    LAS int* cnt = (LAS int*)(F.lds + 65536);
    if (moe) { const float* rw = (const float*)A.in[IN_ROUTER];
        for (int i = F.tid; i < DM * NEXP; i += NTHREADS) { const int d = i >> 3, e = i & 7; wr[e * DM + d] = rw[i]; }
    }
    for (int c = F.vcu; c < MTOK / 64; c += F.G) {
        if (moe) { if (F.tid < 8) cnt[F.tid] = 0; }
        __syncthreads();
        f32x4 na[8]; PRE_T nb[8];
        { const size_t o0 = (size_t)(64 * c + 8 * F.wave) * DM + 4 * F.lane;
#pragma unroll
          for (int q = 0; q < 8; ++q) { na[q] = *(const f32x4*)(hin + o0 + 256 * q); nb[q] = LDPRE(pre, o0 + 256 * q); } }
#pragma unroll 1
        for (int j = 0; j < 8; ++j) {
            const int row = 64 * c + 8 * F.wave + j;
            f32x4 v[8];
#pragma unroll
            for (int q = 0; q < 8; ++q) v[q] = na[q] * ALPHA + CVPRE(nb[q]);
            if (j + 1 < 8) { const size_t o1 = (size_t)(row + 1) * DM + 4 * F.lane;
#pragma unroll
                for (int q = 0; q < 8; ++q) { na[q] = *(const f32x4*)(hin + o1 + 256 * q); nb[q] = LDPRE(pre, o1 + 256 * q); } }
            ln_finish(v, g, bt, RES_BF16 ? nullptr : hf + (size_t)row * DM, (moe && !RES_BF16) ? nullptr : hb + (size_t)row * DM, F.lane, (moe || PLE0_FP8) ? ws + WS_HB8 + (size_t)row * DM : nullptr);
            if (moe) {
                float lg[8];
#pragma unroll
                for (int e = 0; e < 8; ++e) { float s = 0.f;
#pragma unroll
                    for (int q = 0; q < 8; ++q) { const f32x4 w = *(const LAS f32x4*)(wr + e * DM + 4 * F.lane + 256 * q); s += (v[q][0] * w[0] + v[q][1] * w[1]) + (v[q][2] * w[2] + v[q][3] * w[3]); }
                    lg[e] = wave_sum(s) + ((const float*)A.in[IN_ROUTERB])[e]; }
                int i0 = 0; float v0 = lg[0];
#pragma unroll
                for (int e = 1; e < 8; ++e) if (lg[e] > v0) { v0 = lg[e]; i0 = e; }
                int i1 = -1; float v1 = -3.0e38f;
#pragma unroll
                for (int e = 0; e < 8; ++e) if (e != i0 && lg[e] > v1) { v1 = lg[e]; i1 = e; }
                const float e1 = __expf(v1 - v0), w0 = 1.f / (1.f + e1), w1 = e1 * w0;
                if (F.lane == 0) { int* re = (int*)(ws + WS_ROUTE + RT_E); float* rwt = (float*)(ws + WS_ROUTE + RT_W);
                    re[2 * row] = i0; re[2 * row + 1] = i1; rwt[2 * row] = w0; rwt[2 * row + 1] = w1;
                    __hip_atomic_fetch_add(cnt + i0, 1, __ATOMIC_RELAXED, __HIP_MEMORY_SCOPE_WORKGROUP); __hip_atomic_fetch_add(cnt + i1, 1, __ATOMIC_RELAXED, __HIP_MEMORY_SCOPE_WORKGROUP); }
            }
        }
        __syncthreads();
        if (moe && F.tid < 8) ((int*)(ws + WS_ROUTE + RT_CNT))[c * 8 + F.tid] = cnt[F.tid];
    }
}

__device__ __forceinline__ void moe_scatter(const Frame& F, const Args& A) {
    unsigned char* ws = A.ws;
    const int* cntg = (const int*)(ws + WS_ROUTE + RT_CNT); const int* re = (const int*)(ws + WS_ROUTE + RT_E); const float* rwt = (const float*)(ws + WS_ROUTE + RT_W);
    int* toksrow = (int*)(ws + WS_ROUTE + RT_TOKSROW); float* sroww = (float*)(ws + WS_ROUTE + RT_SROWW); int* panel = (int*)(ws + WS_ROUTE + RT_PANEL);
    const bf16_t* hb = (const bf16_t*)(ws + WS_HB) + (size_t)MTOK * DM; unsigned char* hs = ws + WS_R + R_HS;
    LAS int* tot = (LAS int*)F.lds; LAS int* part = tot + 8; LAS int* off = tot + 16; LAS int* ee = tot + 32; LAS int* srow = tot + 160;
    for (int c = F.vcu; c < MTOK / 64; c += F.G) {
        { const int e = F.wave; int t = 0, p = 0;
#pragma unroll
          for (int q = 0; q < 4; ++q) { const int cc = 4 * F.lane + q; const int v = cntg[cc * 8 + e]; t += v; p += (cc < c) ? v : 0; }
#pragma unroll
          for (int o = 1; o < 64; o <<= 1) { t += __shfl_xor(t, o); p += __shfl_xor(p, o); }
          if (F.lane == 0) { tot[e] = t; part[e] = p; } }
        if (F.tid < 128) ee[F.tid] = re[128 * c + F.tid];
        __syncthreads();
        if (F.tid == 0) { int o = 0, np = 0;
            for (int e = 0; e < 8; ++e) { off[e] = o; const int npan = (tot[e] + 255) >> 8;
                if (c == 0) for (int q = 0; q < npan; ++q) panel[1 + np + q] = e;
                np += npan; o += npan * 256; }
            if (c == 0) panel[0] = np; }
        __syncthreads();
        if (F.tid < 128) { const int e = ee[F.tid]; int rank = 0; for (int q = 0; q < F.tid; ++q) rank += (ee[q] == e) ? 1 : 0;
            const int sr = off[e] + part[e] + rank; srow[F.tid] = sr; toksrow[128 * c + F.tid] = sr; sroww[sr] = rwt[128 * c + F.tid]; }
        __syncthreads();
        for (int q = 0; q < 16; ++q) { const int ent = F.wave * 16 + q; const int tok = 64 * c + (ent >> 1); const int sr = srow[ent];
            const u32x4* s = (const u32x4*)(ws + WS_HB8 + (size_t)tok * DM); u32x4* d = (u32x4*)(hs + (size_t)sr * DM);
#pragma unroll
            for (int k = 0; k < 2; ++k) d[F.lane + 64 * k] = s[F.lane + 64 * k]; }
        __syncthreads();
    }
}

__device__ __forceinline__ void pi_phase(const Frame& F, const Args& A, int L, bool moe) {
    unsigned char* ws = A.ws;
    const float* g = (const float*)A.in[IN_LN2G] + L * DM; const float* bt = (const float*)A.in[IN_LN2B] + L * DM;
    const bool last = (L == NLAYER - 1);
    float* outf = last ? A.out : (float*)(ws + WS_HF) + (size_t)MTOK * DM; bf16_t* outb = last ? nullptr : (bf16_t*)(ws + WS_HB);
    const int gw = F.vcu * NWAVES + F.wave, NGW = F.G * NWAVES;
    const bf16_t* hb1 = (const bf16_t*)(ws + WS_HB) + (size_t)MTOK * DM; const float* hf1 = (const float*)(ws + WS_HF);
    const float* pre2 = (const float*)(ws + WS_R + R_PRE2); const bf16_t* ple = moe ? (const bf16_t*)(ws + WS_HF + (size_t)MTOK * DM * 4) : (const bf16_t*)(ws + WS_R + R_PLE);
    const int* ts = (const int*)(ws + WS_ROUTE + RT_TOKSROW); const bf16_t* ys = (const bf16_t*)(ws + WS_R + R_YS);
    u32x2 nh[8], np[8], ny0[8], ny1[8]; PRE_T nf[8]; f32x4 nhf[8]; int t0n = 0, t1n = 0;
#define PI_LOAD(row_, i0_, i1_) do { const size_t o_ = (size_t)(row_) * DM + 4 * F.lane; _Pragma("unroll") for (int q = 0; q < 8; ++q) { \
        if (RES_BF16) nh[q] = *(const u32x2*)(hb1 + o_ + 256 * q); else nhf[q] = *(const f32x4*)(hf1 + o_ + 256 * q); \
        np[q] = *(const u32x2*)(ple + o_ + 256 * q); \
        if (!moe) nf[q] = LDPRE(pre2, o_ + 256 * q); \
        else { ny0[q] = *(const u32x2*)(ys + (size_t)(i0_) * DM + 4 * F.lane + 256 * q); ny1[q] = *(const u32x2*)(ys + (size_t)(i1_) * DM + 4 * F.lane + 256 * q); } } } while (0)
    if (gw < MTOK) { if (moe) { t0n = ts[2 * gw]; t1n = ts[2 * gw + 1]; } PI_LOAD(gw, t0n, t1n); if (moe && gw + NGW < MTOK) { t0n = ts[2 * (gw + NGW)]; t1n = ts[2 * (gw + NGW) + 1]; } }
#pragma unroll 1
    for (int row = gw; row < MTOK; row += NGW) {
        f32x4 v[8];
#pragma unroll
        for (int q = 0; q < 8; ++q) { f32x4 h; if (RES_BF16) { h[0] = bflo(nh[q].x); h[1] = bfhi(nh[q].x); h[2] = bflo(nh[q].y); h[3] = bfhi(nh[q].y); } else h = nhf[q];
            f32x4 r; const u32x2 p = np[q];
            if (!moe) { r[0] = bflo(p.x); r[1] = bfhi(p.x); r[2] = bflo(p.y); r[3] = bfhi(p.y); r = CVPRE(nf[q]) + r; }
            else { const u32x2 a = ny0[q], b = ny1[q]; r[0] = (bflo(a.x) + bflo(b.x)) + bflo(p.x); r[1] = (bfhi(a.x) + bfhi(b.x)) + bfhi(p.x); r[2] = (bflo(a.y) + bflo(b.y)) + bflo(p.y); r[3] = (bfhi(a.y) + bfhi(b.y)) + bfhi(p.y); }
            v[q] = h * ALPHA + r; }
        const int nrow = row + NGW;
        if (nrow < MTOK) { PI_LOAD(nrow, t0n, t1n); if (moe && nrow + NGW < MTOK) { t0n = ts[2 * (nrow + NGW)]; t1n = ts[2 * (nrow + NGW) + 1]; } }
        ln_finish(v, g, bt, outf + (size_t)row * DM, outb ? outb + (size_t)row * DM : nullptr, F.lane, last ? nullptr : ws + WS_HB8 + (size_t)row * DM);
    }
#undef PI_LOAD
}

namespace att {
constexpr int TP = 144, TILE_B = 64 * TP, STAGE_B = 2 * TILE_B + 256;
constexpr int L_WS = 2 * STAGE_B;
constexpr int IMP_P = 68;
constexpr int L_IMP = L_WS + 8 * 256;
constexpr int L_SEL = L_IMP + 4 * 64 * IMP_P * 4;
constexpr int L_UID = L_SEL + 512;
static_assert(L_UID + 64 <= RING_BYTES, "attention LDS map");
constexpr int NEGBIG_I = -(1 << 29);
constexpr float NEG_INF = -__builtin_inff();

struct Stream { const bf16_t* K; const bf16_t* VT; const float* bias; int ldk, ldv; };
struct State { float m, l; f32x16 o0, o1; };
__device__ __forceinline__ void state_init(State& S) { S.m = 0.f; S.l = -1.f;
#pragma unroll
    for (int r = 0; r < 16; ++r) { S.o0[r] = 0.f; S.o1[r] = 0.f; } }
__device__ __forceinline__ float swap_max(float v) { auto rr = __builtin_amdgcn_permlane32_swap(__float_as_uint(v), __float_as_uint(v), false, false); return fmaxf(__uint_as_float(rr[0]), __uint_as_float(rr[1])); }
__device__ __forceinline__ float swap_sum(float v) { auto rr = __builtin_amdgcn_permlane32_swap(__float_as_uint(v), __float_as_uint(v), false, false); return __uint_as_float(rr[0]) + __uint_as_float(rr[1]); }

template <bool BIAS>
__device__ __forceinline__ void stage_issue(const Stream& s, int tile, int tid, u32x4& kr, u32x4& vr, f32x4& br) {
    const int row = tid >> 3, ch = tid & 7;
    kr = *(const u32x4*)(s.K + (size_t)(tile * 64 + row) * s.ldk + ch * 8);
    vr = *(const u32x4*)(s.VT + (size_t)row * s.ldv + tile * 64 + ch * 8);
    if (BIAS) { if (tid < 16) br = *(const f32x4*)(s.bias + tile * 64 + tid * 4); }
}
template <bool BIAS>
__device__ __forceinline__ void stage_write(LAS unsigned char* st, int tid, const u32x4& kr, const u32x4& vr, const f32x4& br) {
    const int row = tid >> 3, ch = tid & 7;
    *(LAS u32x4*)(st + row * TP + ch * 16) = kr; *(LAS u32x4*)(st + TILE_B + row * TP + ch * 16) = vr;
    if (BIAS) { if (tid < 16) *(LAS f32x4*)(st + 2 * TILE_B + tid * 16) = br; }
}
template <bool BIAS, int D0A, int D0B>
__device__ __forceinline__ void tile_scores(const LAS unsigned char* st, const bf16x8 (&qf)[4], int kb, int kv_lo, int kv_hi, bool need_lo, bool need_hi, float cinit, f32x16& p0, f32x16& p1, int r32, int hi) {
    const LAS unsigned char* kp = st + r32 * TP + hi * 16;
    bf16x8 kf0[D0B - D0A], kf1[D0B - D0A];
#pragma unroll
    for (int d0 = D0A; d0 < D0B; ++d0) { kf0[d0 - D0A] = *(const LAS bf16x8*)(kp + d0 * 32); kf1[d0 - D0A] = *(const LAS bf16x8*)(kp + 32 * TP + d0 * 32); }
    if (BIAS) {
        const LAS float* bp = (const LAS float*)(st + 2 * TILE_B) + 4 * hi; f32x4 b0[4], b1[4];
#pragma unroll
        for (int g = 0; g < 4; ++g) { b0[g] = *(const LAS f32x4*)(bp + 8 * g); b1[g] = *(const LAS f32x4*)(bp + 32 + 8 * g); }
        LDS_WAIT(); __builtin_amdgcn_sched_barrier(0);
#pragma unroll
        for (int g = 0; g < 4; ++g)
#pragma unroll
            for (int i = 0; i < 4; ++i) { p0[4 * g + i] = cinit - b0[g][i]; p1[4 * g + i] = cinit - b1[g][i]; }
    } else {
#pragma unroll
        for (int r = 0; r < 16; ++r) { p0[r] = cinit; p1[r] = cinit; }
        LDS_WAIT(); __builtin_amdgcn_sched_barrier(0);
    }
#pragma unroll
    for (int d0 = D0A; d0 < D0B; ++d0) { p0 = __builtin_amdgcn_mfma_f32_32x32x16_bf16(kf0[d0 - D0A], qf[d0], p0, 0, 0, 0); p1 = __builtin_amdgcn_mfma_f32_32x32x16_bf16(kf1[d0 - D0A], qf[d0], p1, 0, 0, 0); }
    if (need_hi) { asm volatile("; mask hi" ::: "memory"); const int thr = kv_hi - kb - 4 * hi;
#pragma unroll
        for (int r = 0; r < 16; ++r) { const int c = (r & 3) + 8 * (r >> 2); if (c > thr) p0[r] = NEG_INF; if (c + 32 > thr) p1[r] = NEG_INF; } }
    if (need_lo) { asm volatile("; mask lo" ::: "memory"); const int thr = kv_lo - kb - 4 * hi;
#pragma unroll
        for (int r = 0; r < 16; ++r) { const int c = (r & 3) + 8 * (r >> 2); if (c < thr) p0[r] = NEG_INF; if (c + 32 < thr) p1[r] = NEG_INF; } }
}
constexpr float RESC_THR = 8.0f;
#define MAX3F(a, b, c) __builtin_fmaxf(__builtin_fmaxf((a), (b)), (c))
template <bool BIAS, int D0A, int D0B, bool NOPV = false>
__device__ __forceinline__ void tile_compute(const LAS unsigned char* st, const bf16x8 (&qf)[4], int kb, int kv_lo, int kv_hi, bool need_lo, bool need_hi, float cinit, State& S, LAS float* wsf, int r32, int hi) {
    f32x16 p0, p1;
    tile_scores<BIAS, D0A, D0B>(st, qf, kb, kv_lo, kv_hi, need_lo, need_hi, cinit - S.m, p0, p1, r32, hi);
    __builtin_amdgcn_sched_barrier(0);
    bf16x8 vf0[4], vf1[4];
    if (!NOPV) { const LAS unsigned char* vp_ = st + TILE_B + r32 * TP + hi * 16;
#pragma unroll
        for (int s = 0; s < 4; ++s) { vf0[s] = *(const LAS bf16x8*)(vp_ + s * 32); vf1[s] = *(const LAS bf16x8*)(vp_ + 32 * TP + s * 32); }
        __builtin_amdgcn_sched_barrier(0); }
    float ma = MAX3F(p0[0], p0[1], p1[0]), mb = MAX3F(p0[2], p0[3], p1[1]); ma = MAX3F(ma, p1[2], p1[3]);
#pragma unroll
    for (int r = 4; r < 16; r += 4) { ma = MAX3F(ma, p0[r], p0[r + 1]); mb = MAX3F(mb, p0[r + 2], p0[r + 3]); ma = MAX3F(ma, p1[r], p1[r + 1]); mb = MAX3F(mb, p1[r + 2], p1[r + 3]); }
    const float mx = swap_max(fmaxf(ma, mb));
    const bool fresh = (S.l < 0.f);
    float dl = fresh ? (mx > -1.0e30f ? mx : 0.f) : fmaxf(mx, 0.f);
    const bool move = fresh ? (mx > -1.0e30f) : (dl > RESC_THR);
    if (__any(move)) {
        if (!move) dl = 0.f;
        S.m += dl;
#pragma unroll
        for (int r = 0; r < 16; ++r) { p0[r] -= dl; p1[r] -= dl; }
        const float alpha = fast_exp2(-dl);
        if (fresh) { if (mx > -1.0e30f) S.l = 0.f; } else S.l *= alpha;
        if (!NOPV) {
            if (hi == 0) wsf[r32] = fresh ? 1.f : alpha;
            LDS_WAIT();
#pragma unroll
            for (int g = 0; g < 4; ++g) { const f32x4 a = *(const LAS f32x4*)(wsf + 8 * g + 4 * hi);
#pragma unroll
                for (int i = 0; i < 4; ++i) { S.o0[4 * g + i] *= a[i]; S.o1[4 * g + i] *= a[i]; } }
            LDS_WAIT();
        }
    }
    float sum = 0.f;
#pragma unroll
    for (int r = 0; r < 16; ++r) { p0[r] = fast_exp2(p0[r]); p1[r] = fast_exp2(p1[r]); sum += p0[r] + p1[r]; }
    if (S.l >= 0.f) S.l += sum;
    if (NOPV) return;
    u32x4 pw[4];
#pragma unroll
    for (int k = 0; k < 4; ++k) { pw[0][k] = cvt_pk_bf16(p0[2 * k], p0[2 * k + 1]); pw[1][k] = cvt_pk_bf16(p0[8 + 2 * k], p0[9 + 2 * k]); pw[2][k] = cvt_pk_bf16(p1[2 * k], p1[2 * k + 1]); pw[3][k] = cvt_pk_bf16(p1[8 + 2 * k], p1[9 + 2 * k]); }
    LDS_WAIT(); __builtin_amdgcn_sched_barrier(0);
#pragma unroll
    for (int s = 0; s < 4; ++s) {
        const bf16x8 pa = __builtin_bit_cast(bf16x8, pw[s]);
        S.o0 = __builtin_amdgcn_mfma_f32_32x32x16_bf16(pa, vf0[s], S.o0, 0, 0, 0); S.o1 = __builtin_amdgcn_mfma_f32_32x32x16_bf16(pa, vf1[s], S.o1, 0, 0, 0);
    }
}
__device__ __forceinline__ void seg_finish(const State& S, float gate, float extra_l, f32x16& a0, f32x16& a1, LAS float* wsf, int r32, int hi) {
    const float lt = swap_sum(fmaxf(S.l, 0.f)) + extra_l; const float f = lt > 0.f ? gate / lt : 0.f;
    if (hi == 0) wsf[r32] = f;
    LDS_WAIT();
#pragma unroll
    for (int g = 0; g < 4; ++g) { const f32x4 a = *(const LAS f32x4*)(wsf + 8 * g + 4 * hi);
#pragma unroll
        for (int i = 0; i < 4; ++i) { a0[4 * g + i] += S.o0[4 * g + i] * a[i]; a1[4 * g + i] += S.o1[4 * g + i] * a[i]; } }
    LDS_WAIT();
}
__device__ __forceinline__ void seg_finish_lds(const State& S, float gate, LAS float* accl, bool first, LAS float* wsf, int r32, int hi) {
    const float lt = swap_sum(fmaxf(S.l, 0.f)); const float f = lt > 0.f ? gate / lt : 0.f;
    if (hi == 0) wsf[r32] = f;
    LDS_WAIT();
#pragma unroll
    for (int g = 0; g < 4; ++g) { const f32x4 a = *(const LAS f32x4*)(wsf + 8 * g + 4 * hi);
#pragma unroll
        for (int i = 0; i < 4; ++i) { LAS float* p = accl + (8 * g + 4 * hi + i) * 64 + r32; const float x0 = S.o0[4 * g + i] * a[i], x1 = S.o1[4 * g + i] * a[i];
            if (first) { p[0] = x0; p[32] = x1; } else { p[0] += x0; p[32] += x1; } } }
    LDS_WAIT();
}
template <bool BIAS, bool SEL, bool DUAL, bool NOPV = false>
__device__ __forceinline__ void run_seg(LAS unsigned char* lds, const Stream& s, int t_lo, int t_hi, const bf16x8 (&qf)[4], int kv_lo, int kv_hi, unsigned sel_lo, unsigned sel_hi,
                                        State& S, State& S2, LAS float* wsf, int tid, int r32, int hi) {
    asm volatile("" : "+v"(tid));
    u32x4 kr, vr; f32x4 br = {0.f, 0.f, 0.f, 0.f};
    const int hi_min = __builtin_amdgcn_readlane(kv_hi, 0), hi_max = __builtin_amdgcn_readlane(kv_hi, 31), lo_min = __builtin_amdgcn_readlane(kv_lo, 0), lo_max = __builtin_amdgcn_readlane(kv_lo, 31);
    stage_issue<BIAS>(s, t_lo, tid, kr, vr, br); stage_write<BIAS>(lds, tid, kr, vr, br);
    __syncthreads();
    for (int t = t_lo; t < t_hi; ++t) {
        const int cur = (t - t_lo) & 1; const bool more = (t + 1 < t_hi);
        if (more) stage_issue<BIAS>(s, t + 1, tid, kr, vr, br);
        const int kb = 64 * t;
        bool active = !(kb > hi_max || kb + 63 < lo_min);
        float cinit = 0.f;
        if (SEL) { const unsigned bit = (t < 32) ? ((sel_lo >> t) & 1u) : ((sel_hi >> (t - 32)) & 1u); cinit = bit ? 0.f : NEG_INF; active = active && __any(bit != 0u); }
        if (active) {
            const LAS unsigned char* st = lds + cur * STAGE_B; const bool nlo = kb < lo_max, nhi = kb + 63 > hi_min;
            if (DUAL) { tile_compute<false, 0, 2>(st, qf, kb, kv_lo, kv_hi, nlo, nhi, cinit, S, wsf, r32, hi); tile_compute<false, 2, 4>(st, qf, kb, kv_lo, kv_hi, nlo, nhi, cinit, S2, wsf, r32, hi); }
            else tile_compute<BIAS, 0, 4, NOPV>(st, qf, kb, kv_lo, kv_hi, nlo, nhi, cinit, S, wsf, r32, hi);
        }
        if (more) stage_write<BIAS>(lds + (cur ^ 1) * STAGE_B, tid, kr, vr, br);
        __syncthreads();
    }
}
__device__ __forceinline__ void load_q(bf16x8 (&qf)[4], const bf16_t* qrow, int hi) {
#pragma unroll
    for (int d0 = 0; d0 < 4; ++d0) qf[d0] = *(const bf16x8*)(qrow + d0 * 16 + hi * 8);
}
#if PD_FP8
typedef unsigned char br_t;
__device__ __forceinline__ void store_o(const f32x16& a0, const f32x16& a1, br_t* base, int hi, int r32) {
#pragma unroll
    for (int r = 0; r < 16; ++r) { const int q = (r & 3) + 8 * (r >> 2) + 4 * hi; br_t* p = base + (size_t)q * DM + r32; const unsigned w = __builtin_amdgcn_cvt_pk_fp8_f32(a0[r] * BR8_SCALE, a1[r] * BR8_SCALE, 0u, false); p[0] = (br_t)(w & 0xffu); p[32] = (br_t)((w >> 8) & 0xffu); }
}
#else
typedef bf16_t br_t;
#endif
#if !PD_FP8
__device__ __forceinline__ void store_o(const f32x16& a0, const f32x16& a1, bf16_t* base, int hi, int r32) {
#pragma unroll
    for (int r = 0; r < 16; ++r) { const int q = (r & 3) + 8 * (r >> 2) + 4 * hi; bf16_t* p = base + (size_t)q * DM + r32; p[0] = f2bf(a0[r]); p[32] = f2bf(a1[r]); }
}
#endif

struct Ctx { LAS unsigned char* lds; unsigned char* ws; unsigned char* R; const float* dlam; const float* dgain; const float* sink; int L, tid, lane, wave, r32, hi; LAS float* wsf; };

__device__ __forceinline__ void fox_unit(const Ctx& C, int b, int h, int qb) {
    const int tq = 256 * qb + 32 * C.wave + C.r32;
    bf16x8 qf[4]; load_q(qf, (const bf16_t*)(C.R + R_CQ) + ((size_t)b * SEQ + tq) * 512 + h * 64, C.hi);
    Stream s; s.K = (const bf16_t*)(C.R + R_CK) + (size_t)b * SEQ * 512 + h * 64; s.ldk = 512; s.VT = (const bf16_t*)(C.R + R_CVT) + (size_t)(b * 8 + h) * 64 * SEQ; s.ldv = SEQ;
    s.bias = (const float*)(C.ws + WS_CUM) + (size_t)(b * 8 + h) * SEQ;
    State S; state_init(S);
    run_seg<true, false, false>(C.lds, s, 0, 4 * (qb + 1), qf, NEGBIG_I, tq, 0u, 0u, S, S, C.wsf, C.tid, C.r32, C.hi);
    f32x16 a0, a1;
#pragma unroll
    for (int r = 0; r < 16; ++r) { a0[r] = 0.f; a1[r] = 0.f; }
    seg_finish(S, 1.f, 0.f, a0, a1, C.wsf, C.r32, C.hi);
    store_o(a0, a1, (br_t*)(C.R + R_BR) + ((size_t)b * SEQ + 256 * qb + 32 * C.wave) * DM + 2 * 512 + h * 64, C.hi, C.r32);
}
__device__ __forceinline__ void diff_unit(const Ctx& C, int b, int h, int qb) {
    const int tq = 256 * qb + 32 * C.wave + C.r32;
    bf16x8 qf[4]; load_q(qf, (const bf16_t*)(C.R + R_DQ) + ((size_t)b * SEQ + tq) * 512 + h * 64, C.hi);
    Stream s; s.K = (const bf16_t*)(C.R + R_DK) + (size_t)b * SEQ * 512 + h * 64; s.ldk = 512; s.VT = (const bf16_t*)(C.R + R_DVT) + (size_t)(b * 8 + h) * 64 * SEQ; s.ldv = SEQ; s.bias = nullptr;
    const float* lf = C.dlam + C.L * 128; const int j = C.lane & 31;
    const float sa = wave_sum(C.lane < 32 ? lf[j] * lf[32 + j] : 0.f), sb = wave_sum(C.lane < 32 ? lf[64 + j] * lf[96 + j] : 0.f);
    const float lam_init = C.L == 0 ? 0.2f : 0.35550906759096314f;
    const float lam = __expf(sa) - __expf(sb) + lam_init;
    State S0, S1; state_init(S0); state_init(S1);
    run_seg<false, false, true>(C.lds, s, 0, 4 * (qb + 1), qf, NEGBIG_I, tq, 0u, 0u, S0, S1, C.wsf, C.tid, C.r32, C.hi);
    f32x16 a0, a1;
#pragma unroll
    for (int r = 0; r < 16; ++r) { a0[r] = 0.f; a1[r] = 0.f; }
    seg_finish(S0, 1.f, 0.f, a0, a1, C.wsf, C.r32, C.hi);
    seg_finish(S1, -lam, 0.f, a0, a1, C.wsf, C.r32, C.hi);
    const float* gain = C.dgain + C.L * 64; const float g0 = gain[C.r32] * (1.f - lam_init), g1 = gain[32 + C.r32] * (1.f - lam_init);
#pragma unroll
    for (int r = 0; r < 16; ++r) { float ss = a0[r] * a0[r] + a1[r] * a1[r];
#pragma unroll
        for (int o = 1; o < 32; o <<= 1) ss += __shfl_xor(ss, o);
        const float rs = 1.f / sqrtf(ss * (1.f / 64.f) + LN_EPS); a0[r] = a0[r] * rs * g0; a1[r] = a1[r] * rs * g1; }
    store_o(a0, a1, (br_t*)(C.R + R_BR) + ((size_t)b * SEQ + 256 * qb + 32 * C.wave) * DM + 3 * 512 + h * 64, C.hi, C.r32);
}
__device__ __forceinline__ void swa_unit(const Ctx& C, int b, int kvh, int tt) {
    const int g = C.wave & 3, sub = C.wave >> 2, hq = kvh * 4 + g; const int tq = 64 * tt + 32 * sub + C.r32;
    bf16x8 qf[4]; load_q(qf, (const bf16_t*)(C.R + R_BQ) + ((size_t)b * SEQ + tq) * 512 + hq * 64, C.hi);
    Stream s; s.K = (const bf16_t*)(C.R + R_BK) + (size_t)b * SEQ * 128 + kvh * 64; s.ldk = 128; s.VT = (const bf16_t*)(C.R + R_BVT) + (size_t)(b * 2 + kvh) * 64 * SEQ; s.ldv = SEQ; s.bias = nullptr;
    State S; state_init(S);
    run_seg<false, false, false>(C.lds, s, tt >= 2 ? tt - 2 : 0, tt + 1, qf, tq - 127, tq, 0u, 0u, S, S, C.wsf, C.tid, C.r32, C.hi);
    const float sink2 = C.sink[C.L * 8 + hq] * LOG2E;
    f32x16 a0, a1;
#pragma unroll
    for (int r = 0; r < 16; ++r) { a0[r] = 0.f; a1[r] = 0.f; }
    seg_finish(S, 1.f, fast_exp2(sink2 - S.m), a0, a1, C.wsf, C.r32, C.hi);
    store_o(a0, a1, (br_t*)(C.R + R_BR) + ((size_t)b * SEQ + 64 * tt + 32 * sub) * DM + 1 * 512 + hq * 64, C.hi, C.r32);
}
__device__ __forceinline__ void nsa_unit(const Ctx& C, int b, int kvh, int tt) {
    const int g = C.wave & 3, sub = C.wave >> 2, hq = kvh * 4 + g; const int tq = 64 * tt + 32 * sub + C.r32;
    const int tid = C.tid, r32 = C.r32, hi = C.hi;
    bf16x8 qf[4]; load_q(qf, (const bf16_t*)(C.R + R_AQ) + ((size_t)b * SEQ + tq) * 512 + hq * 64, hi);
    LAS float* tbl = (LAS float*)(C.lds + L_IMP); LAS unsigned* selw = (LAS unsigned*)(C.lds + L_SEL);
    LAS float* accl = tbl + C.wave * 2048;
    unsigned char* wsb; { unsigned long long x_ = (unsigned long long)C.ws; asm volatile("" : "+s"(x_)); wsb = (unsigned char*)(GAS unsigned char*)x_; }
    Stream sc; sc.K = (const bf16_t*)(wsb + WS_KC) + (size_t)(b * 2 + kvh) * 256 * 64; sc.ldk = 64; sc.VT = (const bf16_t*)(wsb + WS_VCT) + (size_t)(b * 2 + kvh) * 64 * 256; sc.ldv = 256; sc.bias = nullptr;
    const int kvhi_c = (tq - 31) >> 4; const int ntc = ((4 * tt + 2) >> 6) + 1;
    State S; state_init(S);
    run_seg<false, false, false>(C.lds, sc, 0, ntc, qf, NEGBIG_I, kvhi_c, 0u, 0u, S, S, C.wsf, tid, r32, hi);
    const float m1 = S.m; const float l1 = swap_sum(fmaxf(S.l, 0.f)); const float rl1 = l1 > 0.f ? 1.f / l1 : 0.f;
    for (int i = tid; i < 4 * 64 * IMP_P; i += NTHREADS) tbl[i] = 0.f;
    {
        int tid2 = C.tid; asm volatile("" : "+v"(tid2));
        u32x4 kr, vr; f32x4 br = {0.f, 0.f, 0.f, 0.f};
        const int hi_min = __builtin_amdgcn_readlane(kvhi_c, 0), hi_max = __builtin_amdgcn_readlane(kvhi_c, 31);
        stage_issue<false>(sc, 0, tid2, kr, vr, br); stage_write<false>(C.lds, tid2, kr, vr, br);
        __syncthreads();
        LAS float* trow = tbl + (g * 64 + 32 * sub + r32) * IMP_P;
        for (int t = 0; t < ntc; ++t) {
            const int cur = t & 1; const bool more = (t + 1 < ntc);
            if (more) stage_issue<false>(sc, t + 1, tid2, kr, vr, br);
            const int kb = 64 * t;
            if (kb <= hi_max) {
                f32x16 p0, p1;
                tile_scores<false, 0, 4>(C.lds + cur * STAGE_B, qf, kb, NEGBIG_I, kvhi_c, false, kb + 63 > hi_min, 0.f, p0, p1, r32, hi);
#pragma unroll
                for (int r = 0; r < 16; ++r) { p0[r] = fast_exp2(p0[r] - m1) * rl1; p1[r] = fast_exp2(p1[r] - m1) * rl1; }
#pragma unroll
                for (int g4 = 0; g4 < 4; ++g4) {
                    const float x0 = 2.f * ((p0[4 * g4] + p0[4 * g4 + 1]) + p0[4 * g4 + 2]) + p0[4 * g4 + 3], x1 = 2.f * ((p1[4 * g4] + p1[4 * g4 + 1]) + p1[4 * g4 + 2]) + p1[4 * g4 + 3];
                    const int j = 16 * t + 2 * g4 + hi;
                    __hip_atomic_fetch_add(trow + j, x0, __ATOMIC_RELAXED, __HIP_MEMORY_SCOPE_WORKGROUP); __hip_atomic_fetch_add(trow + j + 8, x1, __ATOMIC_RELAXED, __HIP_MEMORY_SCOPE_WORKGROUP);
                    asm volatile("" ::: "memory");
                    __hip_atomic_fetch_add(trow + j + 1, p0[4 * g4 + 3], __ATOMIC_RELAXED, __HIP_MEMORY_SCOPE_WORKGROUP); __hip_atomic_fetch_add(trow + j + 9, p1[4 * g4 + 3], __ATOMIC_RELAXED, __HIP_MEMORY_SCOPE_WORKGROUP);
                    asm volatile("" ::: "memory");
                }
            }
            if (more) stage_write<false>(C.lds + (cur ^ 1) * STAGE_B, tid2, kr, vr, br);
            __syncthreads();
        }
    }
    {
        const int tok = tid >> 3, part = tid & 7; LAS float* t0 = tbl + tok * IMP_P;
        float my[8];
#pragma unroll
        for (int jj = 0; jj < 8; ++jj) { const int j = 8 * part + jj; float v = ((t0[j] + t0[64 * IMP_P + j]) + t0[2 * 64 * IMP_P + j]) + t0[3 * 64 * IMP_P + j];
            if (j == 0 || j == tt || j == tt - 1) v = 1.0e9f; else if (j > tt) v = -1.0e9f; my[jj] = v; }
        __syncthreads();
#pragma unroll
        for (int jj = 0; jj < 8; ++jj) t0[8 * part + jj] = my[jj];
        __syncthreads();
        int cnt[8];
#pragma unroll
        for (int jj = 0; jj < 8; ++jj) cnt[jj] = 0;
        for (int k4 = 0; k4 < 16; ++k4) { const f32x4 x = *(const LAS f32x4*)(t0 + 4 * k4);
#pragma unroll
            for (int i = 0; i < 4; ++i) { const int k = 4 * k4 + i;
#pragma unroll
                for (int jj = 0; jj < 8; ++jj) { const int j = 8 * part + jj; cnt[jj] += (x[i] > my[jj] || (x[i] == my[jj] && k < j)) ? 1 : 0; } } }
        unsigned bits = 0u;
#pragma unroll
        for (int jj = 0; jj < 8; ++jj) bits |= (cnt[jj] < 16 ? 1u : 0u) << jj;
        unsigned wlo = part < 4 ? bits << (8 * part) : 0u, whi = part >= 4 ? bits << (8 * (part - 4)) : 0u;
#pragma unroll
        for (int o = 1; o < 8; o <<= 1) { wlo |= __shfl_xor(wlo, o); whi |= __shfl_xor(whi, o); }
        if (part == 0) { selw[2 * tok] = wlo; selw[2 * tok + 1] = whi; }
        __syncthreads();
    }
    const float* gp = (const float*)(C.ws + WS_GA) + ((size_t)b * SEQ + tq) * 32 + hq * 3;
    seg_finish_lds(S, gp[0], accl, true, C.wsf, r32, hi);
    {
        const unsigned sel_lo = selw[2 * (32 * sub + r32)], sel_hi = selw[2 * (32 * sub + r32) + 1];
        unsigned char* Rb; { unsigned long long x_ = (unsigned long long)C.R; asm volatile("" : "+s"(x_)); Rb = (unsigned char*)(GAS unsigned char*)x_; }
        Stream ss; ss.K = (const bf16_t*)(Rb + R_AKS) + (size_t)b * SEQ * 128 + kvh * 64; ss.ldk = 128; ss.VT = (const bf16_t*)(Rb + R_AVST) + (size_t)(b * 2 + kvh) * 64 * SEQ; ss.ldv = SEQ; ss.bias = nullptr;
        state_init(S);
        run_seg<false, true, false>(C.lds, ss, 0, tt + 1, qf, NEGBIG_I, tq, sel_lo, sel_hi, S, S, C.wsf, tid, r32, hi);
        seg_finish_lds(S, gp[1], accl, false, C.wsf, r32, hi);
    }
    {
        unsigned char* Rb; { unsigned long long x_ = (unsigned long long)C.R; asm volatile("" : "+s"(x_)); Rb = (unsigned char*)(GAS unsigned char*)x_; }
        Stream sw; sw.K = (const bf16_t*)(Rb + R_AKW) + (size_t)b * SEQ * 128 + kvh * 64; sw.ldk = 128; sw.VT = (const bf16_t*)(Rb + R_AVWT) + (size_t)(b * 2 + kvh) * 64 * SEQ; sw.ldv = SEQ; sw.bias = nullptr;
        state_init(S);
        run_seg<false, false, false>(C.lds, sw, tt >= 8 ? tt - 8 : 0, tt + 1, qf, tq - 511, tq, 0u, 0u, S, S, C.wsf, tid, r32, hi);
        seg_finish_lds(S, gp[2], accl, false, C.wsf, r32, hi);
    }
    { unsigned char* Rb; { unsigned long long x_ = (unsigned long long)C.R; asm volatile("" : "+s"(x_)); Rb = (unsigned char*)(GAS unsigned char*)x_; }
      br_t* ob = (br_t*)(Rb + R_BR) + ((size_t)b * SEQ + 64 * tt + 32 * sub) * DM + 0 * 512 + hq * 64;
#pragma unroll
      for (int i = 0; i < 4; ++i) { const int row = 8 * i + (C.lane >> 3), ch = C.lane & 7; const f32x4 x0 = *(const LAS f32x4*)(accl + row * 64 + ch * 8), x1 = *(const LAS f32x4*)(accl + row * 64 + ch * 8 + 4);
#if PD_FP8
          *(u32x2*)(ob + (size_t)row * DM + ch * 8) = pack8_fp8(x0 * BR8_SCALE, x1 * BR8_SCALE); } }
#else
          *(u32x4*)(ob + (size_t)row * DM + ch * 8) = pack8(x0, x1); } }
#endif
    __syncthreads();
}
constexpr int CONV_ITEMS_PER_MAT = (DM / 128) * (DFE / 64), CONV_BATCHES = 12 * CONV_ITEMS_PER_MAT / 32;
__device__ __forceinline__ void conv_batch(LAS unsigned char* lds0, const Args& A, int L, int batch, int wave, int lane) {
    LAS unsigned char* scr = lds0 + wave * 9216;
#pragma unroll 1
    for (int j = 0; j < 4; ++j) {
        const int item = batch * 32 + wave * 4 + j; const int mat = item / CONV_ITEMS_PER_MAT, local = item - mat * CONV_ITEMS_PER_MAT; const int e = 4 * L + mat / 3, which = mat - (mat / 3) * 3;
        TrSeg s; s.item0 = 0; s.pad = 0; s.aoff = 0;
        if (which < 2) { s.W = (const float*)A.in[which == 0 ? IN_MWG : IN_MWU] + (size_t)e * DM * DFE; s.ldw = DFE; s.K = DM; s.ncols = DFE; s.WT = (bf16_t*)(A.ws + WS_WMGU + (size_t)e * 2 * DFE * DM); s.ldt = DM; s.kind = MAP_GU; s.vbase = which * 128; s.f8scale = MOE_WGU_SCALE; }
        else { s.W = (const float*)A.in[IN_MWD] + (size_t)e * DFE * DM; s.ldw = DM; s.K = DFE; s.ncols = DM; s.WT = (bf16_t*)(A.ws + WS_WMD + (size_t)e * DM * DFE); s.ldt = DFE; s.kind = MAP_PLAIN; s.vbase = 0; s.f8scale = MOE_WD_SCALE; }
        tr_item_f8(s, local, scr, lane);
    }
}
constexpr int DEF_ITEMS = 3 * (DM / 64) * (DFF / 64) + (4 * 8 * 32 + 32 * 32 + 4 * 32 + 32 * 32) + (80 * 32 + 128 * 32 + 2 * 128 + 4 * 8 * 32 + 32 * 32 + 4 * 32 + 32 * 32), SMALL_BATCHES = (DEF_ITEMS + 31) / 32;
__device__ __forceinline__ void conv_small(LAS unsigned char* lds0, const Args& A, int batch, int wave, int lane) {
    LAS unsigned char* scr = lds0 + wave * 9216;
    const int* gh = (const int*)(A.ws + WS_CTL + DEFTAB_OFF); const TrSeg* gtab = (const TrSeg*)(gh + 4);
    const int nseg = gh[0], nitems = gh[1];
    int si = 0;
#pragma unroll 1
    for (int j = 0; j < 4; ++j) {
        const int item = batch * 32 + wave * 4 + j; if (item >= nitems) break;
        while (si + 1 < nseg && item >= gtab[si + 1].item0) ++si;
        const TrSeg* t = gtab + si; TrSeg s; s.W = t->W; s.WT = t->WT; s.ldw = t->ldw; s.K = t->K; s.ncols = t->ncols; s.ldt = t->ldt; s.kind = t->kind; s.vbase = t->vbase; s.aoff = t->aoff; s.item0 = t->item0; s.f8scale = t->f8scale; s.pad = 0;
        tr_item(s, item - s.item0, scr, lane);
    }
}
constexpr int NUNITS = 2048, NPB = NB * 8 + 256, QLEN = NPB + NUNITS + CONV_BATCHES;
#ifndef ATT_MASK
#define ATT_MASK 15
#endif
#define ATT_CTX() Ctx C; { int t_ = wave0 * 64 + lane_id(); asm volatile("" : "+v"(t_)); C.tid = t_; C.lane = t_ & 63; C.wave = __builtin_amdgcn_readfirstlane(t_ >> 6); C.r32 = C.lane & 31; C.hi = C.lane >> 5; \
      unsigned l_ = 0u; asm volatile("" : "+s"(l_)); C.lds = lds0 + l_; unsigned long long w_ = (unsigned long long)A.ws; asm volatile("" : "+s"(w_)); C.ws = (unsigned char*)(GAS unsigned char*)w_; C.R = C.ws + WS_R; \
      C.dlam = (const float*)A.in[IN_DLAM]; C.dgain = (const float*)A.in[IN_DGAIN]; C.sink = (const float*)A.in[IN_SINK]; C.L = L; C.wsf = (LAS float*)(C.lds + L_WS) + C.wave * 64; }
#define ATT_FETCH() do { if (wave0 == 0 && lane_id() == 0) uidp[0] = (int)__hip_atomic_fetch_add(qhead, 1u, __ATOMIC_RELAXED, __HIP_MEMORY_SCOPE_AGENT); __syncthreads(); pos = uidp[0]; __syncthreads(); } while (0)
#define ATT_NEXT_FROM(have) do { bool have_ = (have); const int cb_ = (L == 0) ? CONV_BATCHES + SMALL_BATCHES : CONV_BATCHES, per_ = (L == 0) ? 2 : 4; for (;;) { if (!have_) ATT_FETCH(); have_ = false; const int p_ = pos - NPB; \
      if (p_ >= NUNITS + cb_) { id = NUNITS; break; } \
      if (p_ < per_ * cb_) { const int q_ = p_ / per_, r_ = p_ - q_ * per_; \
          if (r_ == per_ - 1) { if (L == 0 && q_ < SMALL_BATCHES) conv_small(lds0, A, q_, wave0, lane_id()); else conv_batch(lds0, A, L, L == 0 ? q_ - SMALL_BATCHES : q_, wave0, lane_id()); __syncthreads(); continue; } \
          id = (per_ - 1) * q_ + r_; break; } \
      id = p_ - cb_; break; } } while (0)
#define ATT_NEXT() ATT_NEXT_FROM(false)
__device__ __forceinline__ void attn_phase(const Frame& F, const Args& A, int L, int rep) {
    LAS unsigned char* lds0 = F.lds; const int wave0 = F.wave;
    LAS int* uidp = (LAS int*)(lds0 + L_UID);
    unsigned* qhead = (unsigned*)(A.ws + WS_CTL) + CW_ATTQ + 64 * L + 128 * rep;
    unsigned* pbdone = (unsigned*)(A.ws + WS_CTL) + CW_PBDONE + 64 * L + 128 * rep;
    int pos, id; ATT_FETCH();
    while (pos < NPB) {
        pb_item(F, A, L, pos);
        asm volatile("s_waitcnt vmcnt(0)" ::: "memory"); __syncthreads();
        if (wave0 == 0 && lane_id() == 0) { __builtin_amdgcn_fence(__ATOMIC_RELEASE, "agent"); asm volatile("s_waitcnt vmcnt(0)" ::: "memory"); (void)__hip_atomic_fetch_add(pbdone, 1u, __ATOMIC_RELAXED, __HIP_MEMORY_SCOPE_AGENT); }
        ATT_FETCH();
    }
    ATT_NEXT_FROM(true);
    { ATT_CTX(); while (id < 512) { if (ATT_MASK & 1) diff_unit(C, (id & 31) >> 3, id & 7, 15 - (id >> 5)); ATT_NEXT(); } }
    { if (wave0 == 0 && lane_id() == 0) { unsigned sp = 0u; while (__hip_atomic_load(pbdone, __ATOMIC_RELAXED, __HIP_MEMORY_SCOPE_AGENT) < (unsigned)NPB) { __builtin_amdgcn_s_sleep(2); if (++sp > (1u << 22)) break; }
          __builtin_amdgcn_fence(__ATOMIC_ACQUIRE, "agent"); asm volatile("s_waitcnt vmcnt(0)" ::: "memory"); }
      __syncthreads(); }
    { ATT_CTX(); while (id < 1024) { const int q = id - 512; if (ATT_MASK & 2) fox_unit(C, (q & 31) >> 3, q & 7, 15 - (q >> 5)); ATT_NEXT(); } }
    { ATT_CTX(); while (id < 1536) { const int q = id - 1024; if (ATT_MASK & 4) nsa_unit(C, (q & 7) >> 1, q & 1, 63 - (q >> 3)); ATT_NEXT(); } }
    { ATT_CTX(); while (id < 2048) { const int q = id - 1536; if (ATT_MASK & 8) swa_unit(C, (q & 7) >> 1, q & 1, q >> 3); ATT_NEXT(); } }
}
}

constexpr int NPHASE = 20;
__device__ __forceinline__ Args load_args() {
    Args a;
#if defined(__HIP_DEVICE_COMPILE__)
    const unsigned long long __attribute__((address_space(4)))* kp = (const unsigned long long __attribute__((address_space(4)))*)__builtin_amdgcn_kernarg_segment_ptr(); asm volatile("" : "+s"(kp));
#pragma unroll
    for (int i = 0; i < 28; ++i) a.in[i] = (const void*)(const GAS void*)kp[i];
    a.out = (float*)(GAS float*)kp[28]; a.ws = (unsigned char*)(GAS unsigned char*)kp[29]; const unsigned long long w = kp[30]; a.ph_lo = (int)(unsigned)w; a.ph_hi = (int)(unsigned)(w >> 32);
#else
    for (int i = 0; i < 28; ++i) a.in[i] = nullptr; a.out = nullptr; a.ws = nullptr; a.ph_lo = 0; a.ph_hi = 0;
#endif
    return a;
}
static_assert(sizeof(Args) == 31 * 8, "Args layout");
#ifndef KMASK
#define KMASK 0xffff
#endif
#define KEN(kind) (KIND < 0 ? (((KMASK) >> (kind)) & 1) != 0 : KIND == (kind))
#define PHASE_ENV() \
    Frame F; { int t_ = wave_s * 64 + lane_id(); asm volatile("" : "+v"(t_)); F.tid = t_; F.lane = t_ & 63; F.wave = __builtin_amdgcn_readfirstlane(t_ >> 6); \
      unsigned l_ = 0u; asm volatile("" : "+s"(l_)); F.lds = (LAS unsigned char*)lds_raw + l_; F.G = gridDim.x; const int bx_ = blockIdx.x; F.vcu = (F.G % 8 == 0) ? (bx_ % 8) * (F.G / 8) + bx_ / 8 : bx_; } \
    const Args args = load_args(); \
    unsigned char* ws = args.ws; unsigned char* R = ws + WS_R; const int c = (int)blockIdx.x; (void)R; (void)c; \
    const float* hin = (L == 0) ? (const float*)args.in[IN_X] : (const float*)(ws + WS_HF) + (size_t)MTOK * DM; (void)hin; \
    const bf16_t* hbin = (const bf16_t*)(ws + WS_HB); (void)hbin; const bf16_t* hb1 = (const bf16_t*)(ws + WS_HB) + (size_t)MTOK * DM; (void)hb1;

#if MK_PER_PHASE
#define GRID_BAR() do { } while (0)
#else
#define GRID_BAR() do { XcdBarrier b_ = bar; { unsigned long long p_ = (unsigned long long)b_.bar; asm volatile("" : "+s"(p_)); b_.bar = (unsigned*)(GAS unsigned*)p_; } xcd_barrier_impl(b_.bar, b_.x, b_.st); } while (0)
#endif
#if MK_PER_PHASE
#define IN(k) (lo <= (k) && (k) < hi)
#else
#define IN(k) true
#endif
#define SEAM(k) do { if (IN(k) && IN((k) + 1)) GRID_BAR(); } while (0)
#ifndef REPEAT_KIND
#define REPEAT_KIND -1
#endif
#define REP(kind) for (int rep_ = 0; rep_ < ((REPEAT_KIND == (kind)) ? 2 : 1); ++rep_)


template <int KIND, int L> __device__ __forceinline__ void layer_phases(const int lo, const int hi, const XcdBarrier bar, const int wave_s) {
    extern __shared__ __attribute__((aligned(16))) unsigned char lds_raw[];
    (void)lo; (void)hi; (void)bar;
        const int base = 1 + 9 * L;
        if (KEN(1) && IN(base + 0)) REP(1) { if (rep_) GRID_BAR();
            { PHASE_ENV(); small_gates(F, hbin, (const bf16_t*)(ws + WS_WS + L * SZ_WS), (const float*)args.in[IN_FOXB] + L * 8, (float*)(ws + WS_GA)); }
            { PHASE_ENV();
#if QKV_FP8
              pg8::StaticOrder8 S{ws + WS_HB8, ws + WS_WA + L * SZ_WA, DM, DM, MTOK / 256, 20, F.G, c};
              EpiA E{R, (const float*)(ws + WS_ROPE64), (const float*)(ws + WS_ROPE32), 1.f / WA_SCALE};
              pg8::gemm_phase<EpiA, pg8::StaticOrder8, true>(F.lds, F.tid, DM, DM, DM, S, E); }
#else
              pg8::StaticOrder S{hbin, (const bf16_t*)(ws + WS_WA + L * SZ_WA), DM, DM, MTOK / 256, 20, F.G, c};
              EpiA E{R, (const float*)(ws + WS_ROPE64), (const float*)(ws + WS_ROPE32), 1.f};
              pg8::gemm_phase(F.lds, F.tid, DM, DM, DM, S, E); }
#endif
            { PHASE_ENV();
              pg8::StaticOrder8 S{ws + WS_HB8, ws + WS_WAG8 + L * SZ_WAG8, DM, DM, MTOK / 256, 8192 / 256, F.G, c};
              EpiGate8 E{R + R_GATES, 1.f / GATE_W_SCALE};
              pg8::gemm_phase<EpiGate8, pg8::StaticOrder8, true>(F.lds, F.tid, DM, DM, DM, S, E); }
        }
        SEAM(base + 0);
        if (KEN(3) && IN(base + 2)) REP(3) { if (rep_) GRID_BAR(); PHASE_ENV(); att::attn_phase(F, args, L, rep_); }
        SEAM(base + 2);
        if (KEN(4) && IN(base + 3)) REP(4) { if (rep_) GRID_BAR(); PHASE_ENV();
            pg8::MergeOrder S{(const bf16_t*)(R + R_BR), (const bf16_t*)(ws + WS_WB + L * SZ_WB), F.G, c};
#if MERGE_CHAIN
#if PD_FP8
            pg8::MergeOrder8 S8{R + R_BR, ws + WS_WB + L * SZ_WB, F.G, c};
            EpiMergeChain E{R + R_GATES, R + R_MERGED8, 1.f / (BR8_SCALE * WB_SCALE)};
            pg8::gemm_phase<EpiMergeChain, pg8::MergeOrder8, true, true>(F.lds, F.tid, 512, DM, 512, S8, E);
#else
            EpiMergeChain E{R + R_GATES, R + R_MERGED8, 1.f};
            pg8::gemm_phase<EpiMergeChain, pg8::MergeOrder, false, true>(F.lds, F.tid, 512, DM, 512, S, E);
#endif
#else
            EpiMerge E{R + R_GATES, (bf16_t*)(R + R_MERGED), R + R_MERGED8};
            pg8::gemm_phase(F.lds, F.tid, 512, DM, 512, S, E);
#endif
        }
        SEAM(base + 3);
        if (KEN(5) && IN(base + 4)) { PHASE_ENV();
            pg8::StaticOrder8 S{R + R_MERGED8, ws + WS_WO + L * SZ_WO, DM, DM, MTOK / 256, DM / 256, F.G, c};
#if PRE_BF16
            EpiBf16S E{(bf16_t*)(R + R_PRE), 1.f / (WO_SCALE * MERGED8_SCALE)};
            pg8::gemm_phase<EpiBf16S, pg8::StaticOrder8, true>(F.lds, F.tid, DM, DM, DM, S, E);
#else
            EpiF32 E{(float*)(R + R_PRE), 1.f / (WO_SCALE * MERGED8_SCALE)};
            pg8::gemm_phase<EpiF32, pg8::StaticOrder8, true>(F.lds, F.tid, DM, DM, DM, S, E);
#endif
        }
        SEAM(base + 4);
        if (KEN(6) && IN(base + 5)) REP(6) { if (rep_) GRID_BAR(); PHASE_ENV(); pf_phase(F, args, L, L == 1, hin); }
        SEAM(base + 5);
        if (L == 0) {
            if (KEN(7) && IN(base + 6)) {
#if DENSE_DOWN_FP8
                { PHASE_ENV(); for (int i = F.vcu * NTHREADS + F.tid; i < MTOK * 8; i += F.G * NTHREADS) *(u32x4*)(R + R_ACT + (size_t)(i >> 3) * DFF8 + DFF + (i & 7) * 16) = (u32x4){0u, 0u, 0u, 0u}; }
#endif
                { PHASE_ENV(); pg8::StaticOrder S{hb1, (const bf16_t*)(ws + WS_WFGU), DM, DM, MTOK / 256, 2 * DFF / 256, F.G, c};
#if DENSE_DOWN_FP8
                  EpiSwigluF8 E{R + R_ACT, DFF8, 1.f};
#else
                  EpiSwiglu E{(bf16_t*)(R + R_ACT), DFF};
#endif
                  pg8::gemm_phase(F.lds, F.tid, DM, DM, DM, S, E); }
                { PHASE_ENV(); pg8::StaticOrder S{(const bf16_t*)(ws + WS_PB16) + (size_t)L * MTOK * PLE, (const bf16_t*)(ws + WS_WPP + L * SZ_WPP), PLE, PLE, MTOK / 256, DM / 256, F.G, c}; EpiBf16 E{(bf16_t*)(R + R_PTMP)}; int kp = PLE; asm volatile("" : "+s"(kp)); pg8::gemm_phase(F.lds, F.tid, kp, PLE, PLE, S, E); }
#if PLE0_FP8
                { PHASE_ENV(); pg8::StaticOrder8 S{ws + WS_HB8, ws + WS_WPG + L * SZ_WPG, DM, DM, MTOK / 256, DM / 256, F.G, c}; EpiPleGate E{(const bf16_t*)(R + R_PTMP), (bf16_t*)(R + R_PLE), 1.f / PG_SCALE}; pg8::gemm_phase<EpiPleGate, pg8::StaticOrder8, true>(F.lds, F.tid, DM, DM, DM, S, E); }
#else
                { PHASE_ENV(); pg8::StaticOrder S{hb1, (const bf16_t*)(ws + WS_WPG + L * SZ_WPG), DM, DM, MTOK / 256, DM / 256, F.G, c}; EpiPleGate E{(const bf16_t*)(R + R_PTMP), (bf16_t*)(R + R_PLE), 1.f}; pg8::gemm_phase(F.lds, F.tid, DM, DM, DM, S, E); }
#endif
            }
            SEAM(base + 6);
            if (KEN(8) && IN(base + 7)) { PHASE_ENV();
#if DENSE_DOWN_FP8
                pg8::StaticOrder8 S{R + R_ACT, ws + WS_WFD, DFF8, DFF8, MTOK / 256, DM / 256, F.G, c};
                EpiF32 E{(float*)(R + R_PRE2), 1.f / WFD_SCALE};
                pg8::gemm_phase<EpiF32, pg8::StaticOrder8, true>(F.lds, F.tid, DFF8, DFF8, DFF8, S, E);
#else
                pg8::StaticOrder S{(const bf16_t*)(R + R_ACT), (const bf16_t*)(ws + WS_WFD), DFF, DFF, MTOK / 256, DM / 256, F.G, c};
#if PRE_BF16
                EpiBf16S E{(bf16_t*)(R + R_PRE2), 1.f};
#else
                EpiF32 E{(float*)(R + R_PRE2), 1.f};
#endif
                pg8::gemm_phase(F.lds, F.tid, DFF, DFF, DFF, S, E);
#endif
            }
            SEAM(base + 7);
            if (KEN(9) && IN(base + 8)) { PHASE_ENV(); pi_phase(F, args, L, false); }
            SEAM(base + 8);
        } else {
            if (KEN(10) && IN(base + 6)) {
                { PHASE_ENV(); moe_scatter(F, args); }
                { PHASE_ENV(); bf16_t* ptmp = (bf16_t*)(ws + WS_HF + (size_t)MTOK * DM * 4) + (size_t)MTOK * DM;
                  pg8::StaticOrder S{(const bf16_t*)(ws + WS_PB16) + (size_t)L * MTOK * PLE, (const bf16_t*)(ws + WS_WPP + L * SZ_WPP), PLE, PLE, MTOK / 256, DM / 256, F.G, c}; EpiBf16 E{ptmp}; int kp = PLE; asm volatile("" : "+s"(kp)); pg8::gemm_phase(F.lds, F.tid, kp, PLE, PLE, S, E); }
                { PHASE_ENV(); bf16_t* ple = (bf16_t*)(ws + WS_HF + (size_t)MTOK * DM * 4); bf16_t* ptmp = ple + (size_t)MTOK * DM;
                  pg8::StaticOrder8 S{ws + WS_HB8, ws + WS_WPG + L * SZ_WPG, DM, DM, MTOK / 256, DM / 256, F.G, c}; EpiPleGate E{ptmp, ple, 1.f / PG_SCALE}; pg8::gemm_phase<EpiPleGate, pg8::StaticOrder8, true>(F.lds, F.tid, DM, DM, DM, S, E); }
            }
            SEAM(base + 6);
            if (KEN(11) && IN(base + 7)) REP(11) { if (rep_) GRID_BAR(); PHASE_ENV(); const int* panel = (const int*)(ws + WS_ROUTE + RT_PANEL);
                pg8::MoeOrder S{R + R_HS, ws + WS_WMGU, panel, DM, DM, 2 * DFE / 256, F.G, c}; EpiSwigluF8 E{R + R_ACTS, DFE, 1.f / MOE_WGU_SCALE};
                pg8::gemm_phase<EpiSwigluF8, pg8::MoeOrder, true>(F.lds, F.tid, DM, DM, DM, S, E);
            }
            SEAM(base + 7);
            if (KEN(12) && IN(base + 8)) REP(12) { if (rep_) GRID_BAR(); PHASE_ENV(); const int* panel = (const int*)(ws + WS_ROUTE + RT_PANEL);
                pg8::MoeOrder S{R + R_ACTS, ws + WS_WMD, panel, DFE, DFE, DM / 256, F.G, c}; EpiMoeDown E{(const float*)(ws + WS_ROUTE + RT_SROWW), (bf16_t*)(R + R_YS), 1.f / MOE_WD_SCALE};
                pg8::gemm_phase<EpiMoeDown, pg8::MoeOrder, true>(F.lds, F.tid, DFE, DFE, DFE, S, E);
            }
            SEAM(base + 8);
            if (KEN(13) && IN(base + 9)) { PHASE_ENV(); pi_phase(F, args, L, true); }
        }
}

template <int KIND> __global__ void __launch_bounds__(NTHREADS, 2) mk_fwd(Args args0) {
    extern __shared__ __attribute__((aligned(16))) unsigned char lds_raw[];
    const int wave_s = __builtin_amdgcn_readfirstlane((int)threadIdx.x >> 6);
    for (int u = threadIdx.x; u < 64; u += NTHREADS) ((LAS unsigned*)((LAS unsigned char*)lds_raw + RING_BYTES))[u + 64] = 0u;
    __syncthreads();
    const int lo = args0.ph_lo, hi = args0.ph_hi; (void)lo; (void)hi;
#if !MK_PER_PHASE
    XcdBarrier bar = xcd_barrier_post((unsigned*)(args0.ws + WS_CTL) + CW_BAR, (volatile LAS unsigned*)((LAS unsigned char*)lds_raw + MISC_OFF) + 8);
#else
    XcdBarrier bar; bar.bar = nullptr; bar.x = 0u; bar.st = nullptr;
#endif
    if (KEN(0) && IN(0)) REP(0) { if (rep_) GRID_BAR(); const int L = 0; PHASE_ENV(); p0_prologue(F, args); } SEAM(0);

    layer_phases<KIND, 0>(lo, hi, bar, wave_s);
    layer_phases<KIND, 1>(lo, hi, bar, wave_s);
}

__global__ void dbg_bf16_out(const bf16_t* src, float* out, size_t n) { for (size_t i = (size_t)blockIdx.x * blockDim.x + threadIdx.x; i < n; i += (size_t)gridDim.x * blockDim.x) out[i] = bf2f(src[i]); }
__global__ void fill_const(float* out, int n, float v) { for (int i = blockIdx.x * blockDim.x + threadIdx.x; i < n; i += gridDim.x * blockDim.x) out[i] = v; }

typedef void (*kern_t)(Args);
static kern_t kernel_of_kind(int k) {
    switch (k) { case 0: return mk_fwd<0>; case 1: return mk_fwd<1>; case 2: return mk_fwd<2>; case 3: return mk_fwd<3>; case 4: return mk_fwd<4>; case 5: return mk_fwd<5>; case 6: return mk_fwd<6>;
                 case 7: return mk_fwd<7>; case 8: return mk_fwd<8>; case 9: return mk_fwd<9>; case 10: return mk_fwd<10>; case 11: return mk_fwd<11>; case 12: return mk_fwd<12>; default: return mk_fwd<13>; }
}
static const int kind_of_phase[NPHASE] = {0, 1, 2, 3, 4, 5, 6, 7, 8, 9, 1, 2, 3, 4, 5, 6, 10, 11, 12, 13};
extern "C" void kernel_launch(void* const* d_in, const int* in_sizes, int n_in, void* d_out, int out_size, void* d_ws, size_t ws_size, hipStream_t stream) {
    static int grid = 0;
    if (grid == 0) {
        int dev = 0, cus = 0; bool ok = true;
        if (hipGetDevice(&dev) != hipSuccess || hipDeviceGetAttribute(&cus, hipDeviceAttributeMultiprocessorCount, dev) != hipSuccess) { fprintf(stderr, "kernel_launch: device query failed\n"); ok = false; }
#if MK_PER_PHASE
        for (int k = 0; k < 14 && ok; ++k) if (hipFuncSetAttribute((const void*)kernel_of_kind(k), hipFuncAttributeMaxDynamicSharedMemorySize, LDS_BYTES) != hipSuccess) { fprintf(stderr, "kernel_launch: hipFuncSetAttribute failed\n"); ok = false; }
#else
        if (ok && hipFuncSetAttribute((const void*)mk_fwd<-1>, hipFuncAttributeMaxDynamicSharedMemorySize, LDS_BYTES) != hipSuccess) { fprintf(stderr, "kernel_launch: hipFuncSetAttribute failed\n"); ok = false; }
        if (ok) { int per_cu = 0; (void)hipOccupancyMaxActiveBlocksPerMultiprocessor(&per_cu, (const void*)mk_fwd<-1>, NTHREADS, LDS_BYTES); (void)hipGetLastError(); }
#endif
        grid = ok ? cus : -1;
    }
    if (grid < 0 || n_in != 28 || out_size != MTOK * DM || ws_size < WS_END) {
        fprintf(stderr, "kernel_launch: bad configuration (grid %d, n_in %d, out %d, ws %zu, need %zu)\n", grid, n_in, out_size, ws_size, (size_t)WS_END);
        hipLaunchKernelGGL(fill_const, dim3(1024), dim3(256), 0, stream, (float*)d_out, out_size, ws_size < WS_END ? 1000.0f : 100.0f);
        return;
    }
    (void)hipMemsetAsync((char*)d_ws + WS_CTL, 0, CTL_BYTES, stream);
    Args a{};
    for (int i = 0; i < 28; ++i) a.in[i] = d_in[i];
    a.out = (float*)d_out; a.ws = (unsigned char*)d_ws;
#if MK_PER_PHASE
#ifndef DBG_STOP_AFTER
#define DBG_STOP_AFTER (NPHASE - 1)
#endif
#ifndef DBG_REPEAT_PHASE
#define DBG_REPEAT_PHASE -1
#endif
    for (int p = 0; p <= DBG_STOP_AFTER; ++p) { a.ph_lo = p; a.ph_hi = p + 1; hipLaunchKernelGGL(kernel_of_kind(kind_of_phase[p]), dim3(grid), dim3(NTHREADS), LDS_BYTES, stream, a);
        if (p == DBG_REPEAT_PHASE) { (void)hipMemsetAsync((char*)d_ws + WS_CTL, 0, CTL_BYTES, stream); hipLaunchKernelGGL(kernel_of_kind(kind_of_phase[p]), dim3(grid), dim3(NTHREADS), LDS_BYTES, stream, a); } }
#ifdef DBG_BF16_OFF
    hipLaunchKernelGGL(dbg_bf16_out, dim3(2048), dim3(256), 0, stream, (const bf16_t*)((char*)d_ws + (DBG_BF16_OFF)), (float*)d_out, (size_t)MTOK * DM);
#endif
#ifdef DBG_COPY_OFF
    (void)hipMemcpyAsync(d_out, (char*)d_ws + (DBG_COPY_OFF), (size_t)MTOK * DM * 4, hipMemcpyDeviceToDevice, stream);
#endif
#else
    a.ph_lo = 0; a.ph_hi = NPHASE;
    hipLaunchKernelGGL(mk_fwd<-1>, dim3(grid), dim3(NTHREADS), LDS_BYTES, stream, a);
#endif
}
```

```cpp
#include <hip/hip_runtime.h>
#include <cstdio>
#include <cstdint>

#ifndef MK_PER_PHASE
#define MK_PER_PHASE 0
#endif

#define LAS __attribute__((address_space(3)))
#define GAS __attribute__((address_space(1)))
typedef unsigned short bf16_t;
typedef short bf16x8 __attribute__((ext_vector_type(8)));
typedef float f32x2 __attribute__((ext_vector_type(2)));
typedef float f32x4 __attribute__((ext_vector_type(4)));
typedef float f32x16 __attribute__((ext_vector_type(16)));
typedef unsigned u32x2 __attribute__((ext_vector_type(2)));
typedef unsigned u32x4 __attribute__((ext_vector_type(4)));
typedef GAS unsigned gu32;

constexpr int NB = 4, SEQ = 4096, DM = 2048, MTOK = NB * SEQ, NLAYER = 2;
constexpr int INC = 13344;
constexpr int DFF = 5504, NEXP = 8, DFE = 7168, PLE = 256;
constexpr int NA = 13312;
constexpr float ALPHA = 1.41421356237309515f;
constexpr float LN_EPS = 1e-5f;
constexpr float LOG2E = 1.4426950408889634f;
constexpr float QS64 = 0.125f * LOG2E;
constexpr float QS32 = 0.17677669529663687f * LOG2E;
constexpr int MOE_ROWS = 2 * MTOK + NEXP * 256;
constexpr int MOE_PANELS = MOE_ROWS / 256;

constexpr int SRC_AQ = 0, SRC_AKC = 512, SRC_AVC = 640, SRC_AKS = 768, SRC_AVS = 896, SRC_AKW = 1024, SRC_AVW = 1152, SRC_AG = 1280,
              SRC_BQ = 1304, SRC_BK = 1816, SRC_BV = 1944, SRC_CQ = 2072, SRC_CK = 2584, SRC_CV = 3096, SRC_CF = 3608,
              SRC_DQ = 3616, SRC_DK = 4128, SRC_DV = 4640, SRC_MG = 5152;

constexpr size_t al256(size_t x) { return (x + 255) & ~(size_t)255; }
constexpr size_t WS_CTL = 0, CTL_BYTES = 1u << 20;
constexpr size_t SZ_WA = (size_t)NA * DM * 2, SZ_WS = 32 * DM * 2, SZ_WC1 = 256 * 2048 * 2, SZ_WB = (size_t)4 * DM * 512 * 2, SZ_WO = (size_t)DM * DM * 2,
                 SZ_WFGU = (size_t)2 * DFF * DM * 2, SZ_WFD = (size_t)DM * DFF * 2, SZ_WMGU = (size_t)NEXP * 2 * DFE * DM  , SZ_WMD = (size_t)NEXP * DM * DFE  ,
                 SZ_WPG = (size_t)DM * DM * 2, SZ_WPP = (size_t)DM * PLE * 2;
constexpr size_t WS_WA = WS_CTL + CTL_BYTES;
constexpr size_t WS_WS = WS_WA + 2 * SZ_WA;
constexpr size_t WS_WC1 = WS_WS + 2 * SZ_WS;
constexpr size_t WS_CVEC = WS_WC1 + 4 * SZ_WC1;
constexpr size_t WS_WB = WS_CVEC + 4096;
constexpr size_t WS_WO = WS_WB + 2 * SZ_WB;
constexpr size_t WS_WFGU = WS_WO + 2 * SZ_WO;
constexpr size_t WS_WFD = WS_WFGU + SZ_WFGU;
constexpr size_t WS_WMGU = WS_WFD + SZ_WFD;
constexpr size_t WS_WMD = WS_WMGU + SZ_WMGU;
constexpr size_t WS_WPG = WS_WMD + SZ_WMD;
constexpr size_t WS_WPP = WS_WPG + 2 * SZ_WPG;
constexpr size_t WS_WAG8 = WS_WPP + 2 * SZ_WPP;
constexpr size_t SZ_WAG8 = (size_t)8192 * DM;
constexpr size_t WS_HB8 = WS_WAG8 + 2 * SZ_WAG8;
constexpr size_t WS_ROPE64 = WS_HB8 + (size_t)MTOK * DM;
constexpr size_t WS_ROPE32 = WS_ROPE64 + (size_t)MTOK * 64 * 4;
constexpr size_t WS_PB16 = WS_ROPE32 + (size_t)MTOK * 32 * 4;
constexpr size_t WS_GA = WS_PB16 + (size_t)2 * MTOK * PLE * 2;
constexpr size_t WS_CUM = WS_GA + (size_t)MTOK * 32 * 4;
constexpr size_t WS_KC = WS_CUM + (size_t)NB * 8 * SEQ * 4;
constexpr size_t WS_VCT = WS_KC + (size_t)NB * 2 * 256 * 64 * 2;
constexpr size_t WS_ROUTE = WS_VCT + (size_t)NB * 2 * 256 * 64 * 2;
constexpr size_t RT_E = 0, RT_W = (size_t)MTOK * 2 * 4, RT_CNT = RT_W + (size_t)MTOK * 2 * 4, RT_TOKSROW = RT_CNT + 256 * 8 * 4,
                 RT_SROWW = RT_TOKSROW + (size_t)MTOK * 2 * 4, RT_PANEL = RT_SROWW + (size_t)MOE_ROWS * 4, RT_END = RT_PANEL + 1024;
constexpr size_t WS_HF = al256(WS_ROUTE + RT_END);
constexpr size_t WS_HB = WS_HF + (size_t)2 * MTOK * DM * 4;
constexpr size_t WS_R = WS_HB + (size_t)2 * MTOK * DM * 2;
constexpr size_t R_AQ = 0, SZ_Q = (size_t)MTOK * 512 * 2, SZ_K2 = (size_t)MTOK * 128 * 2;
constexpr size_t R_BQ = R_AQ + SZ_Q, R_CQ = R_BQ + SZ_Q, R_DQ = R_CQ + SZ_Q, R_CK = R_DQ + SZ_Q, R_DK = R_CK + SZ_Q;
constexpr size_t R_AKC = R_DK + SZ_Q, R_AKS = R_AKC + SZ_K2, R_AKW = R_AKS + SZ_K2, R_BK = R_AKW + SZ_K2, R_AVC = R_BK + SZ_K2;
constexpr size_t R_AVST = R_AVC + SZ_K2, R_AVWT = R_AVST + SZ_K2, R_BVT = R_AVWT + SZ_K2, R_CVT = R_BVT + SZ_K2, R_DVT = R_CVT + SZ_Q;
constexpr size_t R_QKV_END = R_DVT + SZ_Q;
constexpr size_t R_PART = 0;
static_assert((size_t)MTOK * DM * 4 <= R_QKV_END, "merge partial fits over the qkv set");
constexpr size_t R_GATES = R_QKV_END;
constexpr size_t R_PRE = R_GATES;
constexpr size_t R_BR = R_GATES + (size_t)MTOK * 8192 * 2;
constexpr size_t R_MERGED = R_BR + (size_t)MTOK * DM * 2;
constexpr size_t R_MERGED8 = R_MERGED + (size_t)MTOK * DM * 2;
constexpr size_t R_MIX_END = R_MERGED8 + (size_t)MTOK * DM;
constexpr size_t R_ACT = 0;
constexpr size_t R_PLE = R_ACT + (size_t)MTOK * DFF * 2;
constexpr size_t R_PTMP = R_PLE + (size_t)MTOK * DM * 2;
constexpr size_t R_PRE2 = R_PTMP + (size_t)MTOK * DM * 2;
constexpr size_t R_FFN_END = R_PRE2 + (size_t)MTOK * DM * 4;
constexpr size_t R_HS = 0;
constexpr size_t R_ACTS = R_HS + (size_t)MOE_ROWS * DM;
constexpr size_t R_YS = R_ACTS + (size_t)MOE_ROWS * DFE;
constexpr size_t R_MOE_END = R_YS + (size_t)MOE_ROWS * DM * 2;
#ifndef QKV_FP8
#define QKV_FP8 1
#endif
#ifndef PD_FP8
#define PD_FP8 1
#endif
constexpr float BR8_SCALE = 16.f, WB_SCALE = 32.f;
#ifndef PRE_BF16
#define PRE_BF16 1
#endif
#ifndef RES_BF16
#define RES_BF16 1
#endif
#ifndef PLE0_FP8
#define PLE0_FP8 1
#endif
#ifndef DENSE_DOWN_FP8
#define DENSE_DOWN_FP8 0
#endif
constexpr float WA_SCALE = 32.f;
constexpr int DFF8 = 5632;
constexpr float WFD_SCALE = 128.f;
constexpr float MOE_WGU_SCALE = 32.f, MOE_WD_SCALE = 128.f, GATE_W_SCALE = 32.f, WO_SCALE = 64.f, MERGED8_SCALE = 4.f, PG_SCALE = 32.f;
constexpr size_t R_SIZE = R_MOE_END > R_MIX_END ? (R_MOE_END > R_FFN_END ? R_MOE_END : R_FFN_END) : (R_MIX_END > R_FFN_END ? R_MIX_END : R_FFN_END);
constexpr size_t WS_END = WS_R + R_SIZE;

constexpr int CW_TMO = 0;
constexpr int CW_ATTQ = 64;
constexpr int CW_PBDONE = 1024;
constexpr int CW_BAR = 4096;
constexpr int DEFTAB_OFF = 65536;

constexpr int LDS_BYTES = 147456;
constexpr int RING_BYTES = 131072;
constexpr int MISC_OFF = RING_BYTES + 320;
constexpr int NWAVES = 8, NTHREADS = 512;

typedef __bf16 bf16x2_t __attribute__((ext_vector_type(2)));
__device__ __forceinline__ unsigned cvt_pk_bf16(float lo, float hi) { const f32x2 v = {lo, hi}; const bf16x2_t b = __builtin_convertvector(v, bf16x2_t); return __builtin_bit_cast(unsigned, b); }
__device__ __forceinline__ float bf2f(unsigned short b) { return __uint_as_float((unsigned)b << 16); }
__device__ __forceinline__ float bflo(unsigned w) { return __uint_as_float(w << 16); }
__device__ __forceinline__ float bfhi(unsigned w) { return __uint_as_float(w & 0xffff0000u); }
__device__ __forceinline__ bf16_t f2bf(float f) { return (bf16_t)(cvt_pk_bf16(f, 0.f) & 0xffffu); }
__device__ __forceinline__ float fast_exp2(float x) { return __builtin_amdgcn_exp2f(x); }
__device__ __forceinline__ float fast_rcp(float x) { return __builtin_amdgcn_rcpf(x); }
__device__ __forceinline__ float sigmoidf_(float x) { return fast_rcp(1.f + fast_exp2(-x * LOG2E)); }
__device__ __forceinline__ float wave_sum(float v) {
#pragma unroll
    for (int o = 1; o < 64; o <<= 1) v += __shfl_xor(v, o);
    return v;
}
__device__ __forceinline__ int lane_id() { int l; asm volatile("v_mbcnt_lo_u32_b32 %0, -1, 0\n\tv_mbcnt_hi_u32_b32 %0, -1, %0" : "=v"(l)); return l; }
__device__ __forceinline__ int perm23(int t) { return (t & ~12) | ((t & 4) << 1) | ((t & 8) >> 1); }
#define LDS_WAIT() asm volatile("s_waitcnt lgkmcnt(0)" ::: "memory")
#define VM_WAIT() asm volatile("s_waitcnt vmcnt(0)" ::: "memory")

#define XB_TMO      128
#define XB_XCNT(j)  (256  + 64 * (j))
#define XB_XSUB(j)  (1280 + 64 * (j))
#define XB_XGEN(j)  (2304 + 64 * (j))
#define XB_TOP      3328
#define XB_TOPGEN   3392
#define XCD_BAR_WORDS 3456
#define XB_SPIN_CAP (1u << 18)
__device__ __forceinline__ unsigned xb_ld(unsigned* p)              { return __hip_atomic_load(p, __ATOMIC_RELAXED, __HIP_MEMORY_SCOPE_AGENT); }
__device__ __forceinline__ unsigned xb_add(unsigned* p, unsigned v) { return __hip_atomic_fetch_add(p, v, __ATOMIC_RELAXED, __HIP_MEMORY_SCOPE_AGENT); }
__device__ __forceinline__ unsigned xb_xcc_id() { return (unsigned)__builtin_amdgcn_s_getreg((3 << 11) | 20) & 0xFu; }
#define XB_SPIN(cond, bar) do { unsigned _sp = 0; while (cond) { __builtin_amdgcn_s_sleep(1); \
    if ((++_sp & 255u) == 0u) { if (xb_ld(&(bar)[XB_TMO])) break; if (_sp > XB_SPIN_CAP) { atomicAdd(&(bar)[XB_TMO], 1u); break; } } } } while (0)
struct XcdBarrier { unsigned* bar; unsigned x; volatile LAS unsigned* st; };
__device__ __forceinline__ XcdBarrier xcd_barrier_post(unsigned* bar, volatile LAS unsigned* st) {
    XcdBarrier b; b.bar = bar; b.x = xb_xcc_id(); b.st = st;
    if (threadIdx.x == 0) (void)xb_add(&bar[XB_XCNT(b.x)], 1u);
    return b;
}
__device__ __forceinline__ void xcd_barrier_complete(unsigned* bar, unsigned x, unsigned& nloc, unsigned& nx) {
    const unsigned G = gridDim.x * gridDim.y * gridDim.z;
    unsigned sum, cnt, mine, sp = 0u;
    for (;;) {
        sum = 0u; cnt = 0u; mine = 0u;
#pragma unroll
        for (unsigned j = 0; j < 16; ++j) { const unsigned c = xb_ld(&bar[XB_XCNT(j)]); sum += c; cnt += (c > 0u) ? 1u : 0u; mine = (j == x) ? c : mine; }
        if (sum == G) break;
        __builtin_amdgcn_s_sleep(1);
        if ((++sp & 255u) == 0u) { if (xb_ld(&bar[XB_TMO])) break; if (sp > XB_SPIN_CAP) { atomicAdd(&bar[XB_TMO], 1u); break; } }
    }
    nloc = mine > 0u ? mine : 1u; nx = cnt > 0u ? cnt : 1u;
}
__device__ __noinline__ void xcd_barrier_impl(unsigned* bar_, unsigned x_, volatile LAS unsigned* st_) {
    XcdBarrier b; b.bar = bar_; b.x = x_; b.st = st_;
    asm volatile("s_waitcnt vmcnt(0)" ::: "memory");
    __syncthreads();
    if (threadIdx.x == 0) {
        unsigned* bar = b.bar;
        __builtin_amdgcn_s_waitcnt(0);
        unsigned nloc = b.st[0], nx = b.st[1];
        if (nloc == 0u) { xcd_barrier_complete(bar, b.x, nloc, nx); b.st[0] = nloc; b.st[1] = nx; }
        const unsigned old = xb_add(&bar[XB_XSUB(b.x)], 1u);
        const unsigned gen = old / nloc;
        if (old + 1u == (gen + 1u) * nloc) {
            __builtin_amdgcn_fence(__ATOMIC_RELEASE, "agent");
            asm volatile("s_waitcnt vmcnt(0)" ::: "memory");
            const unsigned og = xb_add(&bar[XB_TOP], 1u);
            const unsigned tg = og / nx;
            if (og + 1u == (tg + 1u) * nx) xb_add(&bar[XB_TOPGEN], 1u);
            else XB_SPIN(xb_ld(&bar[XB_TOPGEN]) == tg, bar);
            __builtin_amdgcn_fence(__ATOMIC_ACQUIRE, "agent");
            xb_add(&bar[XB_XGEN(b.x)], 1u);
            asm volatile("s_waitcnt vmcnt(0)" ::: "memory");
        } else {
            XB_SPIN(xb_ld(&bar[XB_XGEN(b.x)]) == gen, bar);
            __builtin_amdgcn_fence(__ATOMIC_ACQUIRE, "agent");
            asm volatile("s_waitcnt vmcnt(0)" ::: "memory");
        }
    }
    __syncthreads();
}

namespace pg8 {
typedef int v4i_t __attribute__((ext_vector_type(4))); typedef int v8i_t __attribute__((ext_vector_type(8)));
constexpr int BM = 256, BK = 64, HALF = 128, HTB = HALF * BK * 2, STAGE_BYTES = 8 * HTB, NXCD = 8, WGM = 8;
__host__ __device__ __forceinline__ int lds_byte(int r, int c) { const int st = (r >> 4) * 2 + (c >> 5), rr = r & 15, cc = c & 31, ob = rr * 64 + cc * 2; return st * 1024 + (ob ^ (((ob >> 9) & 1) << 5)); }
__host__ __device__ __forceinline__ void stage_rc(int b, int& R, int& C) { const int st = b / 1024, sb = b % 1024, swz = sb ^ (((sb >> 9) & 1) << 5); R = (st >> 1) * 16 + swz / 64; C = (st & 1) * 32 + (swz % 64) / 2; }
__host__ __device__ __forceinline__ int perm32(int rho) { const int n = rho >> 4, i = rho & 15; return 8 * (i >> 2) + 4 * n + (i & 3); }

struct Unit { int pm, pn, aux; const char* a; const char* b; };

__device__ __forceinline__ bool tile_of(int i, int G, int c, int nM, int nN, int& pm, int& pn) {
    const int nwg = nM * nN; const long L = (long)i * G + c; if (L >= nwg) return false;
    int wgid = (int)L; { const int q = nwg / NXCD, r = nwg % NXCD, xcd = wgid % NXCD, off = wgid / NXCD; wgid = (xcd < r ? xcd * (q + 1) : r * (q + 1) + (xcd - r) * q) + off; }
    const int nig = WGM * nN, gid = wgid / nig, fm = gid * WGM, gsz = (nM - fm) < WGM ? (nM - fm) : WGM;
    pm = fm + ((wgid % nig) % gsz); pn = (wgid % nig) / gsz; return true;
}
struct StaticOrder {
    const bf16_t* A; const bf16_t* Bt; int lda, ldb, nM, nN, G, c;
    __device__ __forceinline__ bool next(int i, Unit& u) const {
        if (!tile_of(i, G, c, nM, nN, u.pm, u.pn)) return false;
        u.aux = 0; u.a = (const char*)(A + (size_t)u.pm * BM * lda); u.b = (const char*)(Bt + (size_t)u.pn * BM * ldb); return true;
    }
};
struct StaticOrder8 {
    const unsigned char* A; const unsigned char* Bt; int lda, ldb, nM, nN, G, c;
    __device__ __forceinline__ bool next(int i, Unit& u) const {
        if (!tile_of(i, G, c, nM, nN, u.pm, u.pn)) return false;
        u.aux = 0; u.a = (const char*)(A + (size_t)u.pm * BM * lda); u.b = (const char*)(Bt + (size_t)u.pn * BM * ldb); return true;
    }
};
struct MergeOrder {
    const bf16_t* BR; const bf16_t* WbT; int G, c;
    __device__ __forceinline__ bool next(int i, Unit& u) const {
        if (!tile_of(i >> 2, G, c, MTOK / BM, DM / BM, u.pm, u.pn)) return false;
        const int n = i & 3; u.aux = n; u.a = (const char*)(BR + (size_t)u.pm * BM * DM + n * 512); u.b = (const char*)(WbT + (size_t)n * DM * 512 + (size_t)u.pn * BM * 512); return true;
    }
};
struct MergeOrder8 {
    const unsigned char* BR; const unsigned char* WbT; int G, c;
    __device__ __forceinline__ bool next(int i, Unit& u) const {
        if (!tile_of(i >> 2, G, c, MTOK / BM, DM / BM, u.pm, u.pn)) return false;
        const int n = i & 3; u.aux = n; u.a = (const char*)(BR + (size_t)u.pm * BM * DM + n * 512); u.b = (const char*)(WbT + (size_t)n * DM * 512 + (size_t)u.pn * BM * 512); return true;
    }
};
struct MoeOrder {
    const unsigned char* A; const unsigned char* W; const int* panel; int lda, ldb, nN, G, c;
    __device__ __forceinline__ bool next(int i, Unit& u) const {
        const int nP = panel[0]; const long L = (long)i * G + c; if (L >= (long)nP * nN) return false;
        const int nig = WGM * nN, gid = (int)(L / nig), within = (int)(L % nig), fm = gid * WGM, gsz = (nP - fm) < WGM ? (nP - fm) : WGM;
        u.pm = fm + within % gsz; u.pn = within / gsz; const int e = panel[1 + u.pm]; u.aux = e;
        u.a = (const char*)(A + (size_t)u.pm * BM * lda); u.b = (const char*)(W + ((size_t)e * nN + u.pn) * BM * ldb); return true;
    }
};

template <class Epi, class Sched, bool FP8 = false, bool CHAIN = false>
__device__ __forceinline__ void gemm_phase(LAS unsigned char* lds, const int tid, const int K, const int lda, const int ldb, const Sched& S, const Epi& E) {
    constexpr int ES = FP8 ? 1 : 2;
    const int wid = __builtin_amdgcn_readfirstlane(tid >> 6), lane = tid & 63, wr = wid >> 2, wc = wid & 3, fr = lane & 15, fq = lane >> 4;
    const int nt = K * ES / 128;
    unsigned voffA[2], voffB[2];
#pragma unroll
    for (int i = 0; i < 2; ++i) { int R, C; stage_rc(tid * 16 + i * 8192, R, C); const int Rb = (R & ~31) + perm32(R & 31);
        voffA[i] = (unsigned)(R * lda * ES + C * 2); voffB[i] = (unsigned)(Rb * ldb * ES + C * 2); }
    const size_t kstep = (size_t)(BK * 2);
    const size_t hstepA = (size_t)HALF * lda * ES, hstepB = (size_t)HALF * ldb * ES;
    const unsigned ldsw = (unsigned)wid * 1024u;
    const int aoff = lds_byte(wr * 64 + fr, fq * 8), boff = lds_byte(wc * 32 + fr, fq * 8);
#define PG8_SA(b, h) (((b) * 2 + (h)) * HTB)
#define PG8_SB(b, h) ((4 + (b) * 2 + (h)) * HTB)
#define PG8_STAGE(bufoff, gbase, voff) do { _Pragma("unroll") for (int _i = 0; _i < 2; ++_i) \
        __builtin_amdgcn_global_load_lds((const unsigned*)((const char*)(gbase) + (voff)[_i]), (LAS unsigned*)(lds + (bufoff) + ldsw + _i * 8192), 16, 0, 0); } while (0)
#define PG8_LDA(dst, b, h) do { _Pragma("unroll") for (int m = 0; m < 4; ++m) { const v4i_t lo_ = *(const LAS v4i_t*)(lds + PG8_SA(b, h) + aoff + m * 2048), hi_ = *(const LAS v4i_t*)(lds + PG8_SA(b, h) + aoff + m * 2048 + 1024); \
        dst[m] = __builtin_shufflevector(lo_, hi_, 0, 1, 2, 3, 4, 5, 6, 7); } } while (0)
#define PG8_LDB(dst, b, h) do { _Pragma("unroll") for (int n = 0; n < 2; ++n) { const v4i_t lo_ = *(const LAS v4i_t*)(lds + PG8_SB(b, h) + boff + n * 2048), hi_ = *(const LAS v4i_t*)(lds + PG8_SB(b, h) + boff + n * 2048 + 1024); \
        dst[n] = __builtin_shufflevector(lo_, hi_, 0, 1, 2, 3, 4, 5, 6, 7); } } while (0)
#define PG8_MMA(ai, bj, At, Bt) do { __builtin_amdgcn_s_setprio(1); _Pragma("unroll") for (int m = 0; m < 4; ++m) _Pragma("unroll") for (int n = 0; n < 2; ++n) { \
        if constexpr (FP8) asm volatile("v_mfma_scale_f32_16x16x128_f8f6f4 %0, %1, %2, %0, %3, %3 op_sel_hi:[0,0,0]" : "+v"(acc[ai][bj][m][n]) : "v"(Bt[n]), "v"(At[m]), "v"(0x7f7f7f7f));   \
        else { acc[ai][bj][m][n] = __builtin_amdgcn_mfma_f32_16x16x32_bf16(__builtin_bit_cast(bf16x8, __builtin_shufflevector(Bt[n], Bt[n], 0, 1, 2, 3)), __builtin_bit_cast(bf16x8, __builtin_shufflevector(At[m], At[m], 0, 1, 2, 3)), acc[ai][bj][m][n], 0, 0, 0); \
               acc[ai][bj][m][n] = __builtin_amdgcn_mfma_f32_16x16x32_bf16(__builtin_bit_cast(bf16x8, __builtin_shufflevector(Bt[n], Bt[n], 4, 5, 6, 7)), __builtin_bit_cast(bf16x8, __builtin_shufflevector(At[m], At[m], 4, 5, 6, 7)), acc[ai][bj][m][n], 0, 0, 0); } } __builtin_amdgcn_s_setprio(0); } while (0)
#define PG8_WAIT_V(n) asm volatile("s_waitcnt vmcnt(" #n ")" ::: "memory")
#define PG8_WAIT_L(n) asm volatile("s_waitcnt lgkmcnt(" #n ")" ::: "memory")
#define PG8_BAR __builtin_amdgcn_s_barrier()
#define PG8_SCHED __builtin_amdgcn_sched_barrier(0)
    Unit cur, nxt; int ui = 0;
    if (!S.next(0, cur)) return;
    f32x4 acc[2][2][4][2];
#pragma unroll
    for (int a = 0; a < 2; ++a)
#pragma unroll
        for (int b = 0; b < 2; ++b)
#pragma unroll
            for (int m = 0; m < 4; ++m)
#pragma unroll
                for (int n = 0; n < 2; ++n) acc[a][b][m][n] = (f32x4){0.f, 0.f, 0.f, 0.f};
    v8i_t At[4], B0[2], B1[2];
    const char* cA = cur.a; const char* cB = cur.b;
    PG8_STAGE(PG8_SB(0, 0), cB, voffB); PG8_STAGE(PG8_SB(0, 1), cB + hstepB, voffB); PG8_STAGE(PG8_SA(0, 0), cA, voffA); PG8_STAGE(PG8_SA(0, 1), cA + hstepA, voffA);
    if (wr == 1) PG8_BAR;
    PG8_WAIT_V(2); PG8_BAR;
    PG8_STAGE(PG8_SB(1, 0), cB + kstep, voffB); PG8_STAGE(PG8_SA(1, 0), cA + kstep, voffA); PG8_STAGE(PG8_SB(1, 1), cB + hstepB + kstep, voffB);
    PG8_WAIT_V(6); PG8_BAR;
    for (;;) {
        const bool has_next = S.next(ui + 1, nxt);
        const char* nA = has_next ? nxt.a : cA; const char* nB = has_next ? nxt.b : cB;
        for (int t = 0; t < nt; t += 2) {
            const bool last = (t == nt - 2);
            const char* a1 = cA + (size_t)(t + 1) * kstep;
            const char* a2 = last ? nA : cA + (size_t)(t + 2) * kstep; const char* b2 = last ? nB : cB + (size_t)(t + 2) * kstep;
            const char* a3 = a2 + kstep; const char* b3 = b2 + kstep;
            PG8_LDB(B0, 0, 0); PG8_LDB(B1, 0, 1); PG8_SCHED; PG8_LDA(At, 0, 0); PG8_STAGE(PG8_SA(1, 1), a1 + hstepA, voffA);
            PG8_WAIT_V(8); PG8_WAIT_L(0); PG8_BAR; PG8_MMA(0, 0, At, B0); PG8_MMA(0, 1, At, B1); PG8_BAR; PG8_SCHED;
            PG8_LDA(At, 0, 1); PG8_STAGE(PG8_SB(0, 0), b2, voffB); PG8_STAGE(PG8_SB(0, 1), b2 + hstepB, voffB); PG8_STAGE(PG8_SA(0, 0), a2, voffA);
            PG8_WAIT_V(8); PG8_WAIT_L(0); PG8_BAR; PG8_MMA(1, 0, At, B0); PG8_MMA(1, 1, At, B1); PG8_BAR; PG8_SCHED;
            PG8_LDB(B0, 1, 0); PG8_LDB(B1, 1, 1); PG8_SCHED; PG8_LDA(At, 1, 0); PG8_STAGE(PG8_SA(0, 1), a2 + hstepA, voffA);
            PG8_WAIT_V(8); PG8_WAIT_L(0); PG8_BAR; PG8_MMA(0, 0, At, B0); PG8_MMA(0, 1, At, B1); PG8_BAR; PG8_SCHED;
            PG8_LDA(At, 1, 1); PG8_STAGE(PG8_SB(1, 0), b3, voffB); PG8_STAGE(PG8_SB(1, 1), b3 + hstepB, voffB); PG8_STAGE(PG8_SA(1, 0), a3, voffA);
            PG8_WAIT_V(8); PG8_WAIT_L(0); PG8_BAR; PG8_MMA(1, 0, At, B0); PG8_MMA(1, 1, At, B1); PG8_BAR; PG8_SCHED;
        }
        if (wr == 0) PG8_BAR;
        E(acc, cur, wr, wc, fr, fq);
        if (!has_next) break;
        if (!CHAIN || cur.aux == 3) {
#pragma unroll
        for (int a = 0; a < 2; ++a)
#pragma unroll
            for (int b = 0; b < 2; ++b)
#pragma unroll
                for (int m = 0; m < 4; ++m)
#pragma unroll
                    for (int n = 0; n < 2; ++n) acc[a][b][m][n] = (f32x4){0.f, 0.f, 0.f, 0.f};
        }
        cur = nxt; cA = nA; cB = nB; ++ui;
        if (wr == 1) PG8_BAR;
    }
    PG8_WAIT_V(0);
    PG8_BAR;
#undef PG8_SA
#undef PG8_SB
#undef PG8_STAGE
#undef PG8_LDA
#undef PG8_LDB
#undef PG8_MMA
#undef PG8_WAIT_V
#undef PG8_WAIT_L
#undef PG8_BAR
#undef PG8_SCHED
}
}

template <class Epi, class Sched>
__device__ __noinline__ void gemm_call(LAS unsigned char* lds, int K, int lda, int ldb, Sched S, Epi E) { pg8::gemm_phase(lds, K, lda, ldb, S, E); }

__device__ __forceinline__ u32x4 pack8(f32x4 a, f32x4 b) { u32x4 w; w.x = cvt_pk_bf16(a[0], a[1]); w.y = cvt_pk_bf16(a[2], a[3]); w.z = cvt_pk_bf16(b[0], b[1]); w.w = cvt_pk_bf16(b[2], b[3]); return w; }
__device__ __forceinline__ u32x2 pack4(f32x4 a) { u32x2 w; w.x = cvt_pk_bf16(a[0], a[1]); w.y = cvt_pk_bf16(a[2], a[3]); return w; }
__device__ __forceinline__ u32x2 pack8_fp8(f32x4 a, f32x4 b) { unsigned w0 = 0u, w1 = 0u;
    w0 = __builtin_amdgcn_cvt_pk_fp8_f32(a[0], a[1], w0, false); w0 = __builtin_amdgcn_cvt_pk_fp8_f32(a[2], a[3], w0, true);
    w1 = __builtin_amdgcn_cvt_pk_fp8_f32(b[0], b[1], w1, false); w1 = __builtin_amdgcn_cvt_pk_fp8_f32(b[2], b[3], w1, true); u32x2 r; r.x = w0; r.y = w1; return r; }
__device__ __forceinline__ void unpack8_fp8(u32x2 w, f32x4& a, f32x4& b) { typedef float f2 __attribute__((ext_vector_type(2)));
    const f2 a0 = __builtin_amdgcn_cvt_pk_f32_fp8(w.x, false), a1 = __builtin_amdgcn_cvt_pk_f32_fp8(w.x, true), b0 = __builtin_amdgcn_cvt_pk_f32_fp8(w.y, false), b1 = __builtin_amdgcn_cvt_pk_f32_fp8(w.y, true);
    a[0] = a0[0]; a[1] = a0[1]; a[2] = a1[0]; a[3] = a1[1]; b[0] = b0[0]; b[1] = b0[1]; b[2] = b1[0]; b[3] = b1[1]; }
__device__ __forceinline__ f32x4 sig4(f32x4 v) { f32x4 r; r[0] = sigmoidf_(v[0]); r[1] = sigmoidf_(v[1]); r[2] = sigmoidf_(v[2]); r[3] = sigmoidf_(v[3]); return r; }
__device__ __forceinline__ f32x4 ld_sc1_f32x4(const float* p) { typedef unsigned long long u64; const u64 a = __hip_atomic_load((const u64*)p, __ATOMIC_RELAXED, __HIP_MEMORY_SCOPE_AGENT), b = __hip_atomic_load((const u64*)p + 1, __ATOMIC_RELAXED, __HIP_MEMORY_SCOPE_AGENT);
    f32x4 r; r[0] = __uint_as_float((unsigned)a); r[1] = __uint_as_float((unsigned)(a >> 32)); r[2] = __uint_as_float((unsigned)b); r[3] = __uint_as_float((unsigned)(b >> 32)); return r; }
__device__ __forceinline__ u32x4 ld_sc1_u32x4(const void* p) { typedef unsigned long long u64; const u64 a = __hip_atomic_load((const u64*)p, __ATOMIC_RELAXED, __HIP_MEMORY_SCOPE_AGENT), b = __hip_atomic_load((const u64*)p + 1, __ATOMIC_RELAXED, __HIP_MEMORY_SCOPE_AGENT);
    u32x4 r; r.x = (unsigned)a; r.y = (unsigned)(a >> 32); r.z = (unsigned)b; r.w = (unsigned)(b >> 32); return r; }
__device__ __forceinline__ void unpack8(u32x4 w, f32x4& a, f32x4& b) { a[0] = bflo(w.x); a[1] = bfhi(w.x); a[2] = bflo(w.y); a[3] = bfhi(w.y); b[0] = bflo(w.z); b[1] = bfhi(w.z); b[2] = bflo(w.w); b[3] = bfhi(w.w); }

#define ACC_T const f32x4 (&acc)[2][2][4][2]
#define FOR_AI_M _Pragma("unroll") for (int ai = 0; ai < 2; ++ai) _Pragma("unroll") for (int m = 0; m < 4; ++m)

struct EpiA {
    unsigned char* R; const float* rope64; const float* rope32; float inv;
    __device__ __forceinline__ void vt_store(bf16_t* T, int nheads, int b, int head, int dv0, int tseq, f32x4 v0, f32x4 v1) const {
        bf16_t* p = T + ((size_t)(b * nheads + head) * 64 + dv0) * SEQ + perm23(tseq);
#pragma unroll
        for (int k = 0; k < 4; ++k) { p[(size_t)k * SEQ] = f2bf(v0[k]); p[(size_t)(4 + k) * SEQ] = f2bf(v1[k]); }
    }
    __device__ __forceinline__ void operator()(ACC_T, const pg8::Unit& u, int wr, int wc, int fr, int fq) const {
        asm volatile("" : "+v"(fr), "+v"(fq));
        const int t = u.pn; const int row0 = u.pm * 256 + wr * 64 + fr;
        if (t >= 20) {
            bf16_t* G = (bf16_t*)(R + R_GATES);
            FOR_AI_M { const int row = row0 + ai * 128 + m * 16;
#pragma unroll
                for (int bj = 0; bj < 2; ++bj) *(u32x4*)(G + (size_t)row * 8192 + (t - 20) * 256 + bj * 128 + wc * 32 + fq * 8) = pack8(acc[ai][bj][m][0], acc[ai][bj][m][1]); }
        } else if (t < 6) {
            bf16_t* dst; int ld, col; float sc;
            if (t < 2) { dst = (bf16_t*)(R + R_AQ); ld = 512; col = (t & 1) * 256 + 64 * wc; sc = QS64 * inv; }
            else if (t < 4) { dst = (bf16_t*)(R + R_BQ); ld = 512; col = (t & 1) * 256 + 64 * wc; sc = QS64 * inv; }
            else if (t == 4) { dst = (bf16_t*)(R + (wc < 2 ? R_AKC : R_AKS)); ld = 128; col = 64 * (wc & 1); sc = inv; }
            else { dst = (bf16_t*)(R + (wc < 2 ? R_AKW : R_BK)); ld = 128; col = 64 * (wc & 1); sc = inv; }
            FOR_AI_M { const int row = row0 + ai * 128 + m * 16; const float* rp = rope64 + (size_t)row * 64 + 8 * fq;
                const f32x4 c0 = *(const f32x4*)rp, c1 = *(const f32x4*)(rp + 4), s0 = *(const f32x4*)(rp + 32), s1 = *(const f32x4*)(rp + 36);
                const f32x4 l0 = acc[ai][0][m][0], l1 = acc[ai][0][m][1], h0 = acc[ai][1][m][0], h1 = acc[ai][1][m][1];
                const f32x4 ol0 = (l0 * c0 - h0 * s0) * sc, ol1 = (l1 * c1 - h1 * s1) * sc, oh0 = (h0 * c0 + l0 * s0) * sc, oh1 = (h1 * c1 + l1 * s1) * sc;
                bf16_t* p = dst + (size_t)row * ld + col + 8 * fq;
                *(u32x4*)p = pack8(ol0, ol1); *(u32x4*)(p + 32) = pack8(oh0, oh1); }
        } else if (t < 10) {
            bf16_t* dst = (bf16_t*)(R + (t < 8 ? R_CQ : R_CK)); const float sc = (t < 8 ? QS64 : 1.f) * inv;
            FOR_AI_M { const int row = row0 + ai * 128 + m * 16;
#pragma unroll
                for (int bj = 0; bj < 2; ++bj) *(u32x4*)(dst + (size_t)row * 512 + (t & 1) * 256 + bj * 128 + wc * 32 + fq * 8) = pack8(acc[ai][bj][m][0] * sc, acc[ai][bj][m][1] * sc); }
        } else if (t < 14) {
            bf16_t* dst = (bf16_t*)(R + (t < 12 ? R_DQ : R_DK)); const float sc = (t < 12 ? QS32 : 1.f) * inv;
            FOR_AI_M { const int row = row0 + ai * 128 + m * 16; const float* rp = rope32 + (size_t)row * 32 + 4 * fq;
                const f32x4 c = *(const f32x4*)rp, s = *(const f32x4*)(rp + 16);
#pragma unroll
                for (int n = 0; n < 2; ++n) { const f32x4 lo = acc[ai][0][m][n], hi = acc[ai][1][m][n];
                    bf16_t* p = dst + (size_t)row * 512 + (t & 1) * 256 + 64 * wc + 32 * n + 4 * fq;
                    *(u32x2*)p = pack4((lo * c - hi * s) * sc); *(u32x2*)(p + 16) = pack4((hi * c + lo * s) * sc); } }
        } else {
            const int b = u.pm >> 4;
            FOR_AI_M { const int row = row0 + ai * 128 + m * 16; const int tseq = row & (SEQ - 1);
#pragma unroll
                for (int bj = 0; bj < 2; ++bj) { const f32x4 v0 = acc[ai][bj][m][0] * inv, v1 = acc[ai][bj][m][1] * inv; const int dv0 = 32 * (wc & 1) + 8 * fq, hh = wc >> 1;
                    if (t == 14) { if (bj == 0) *(u32x4*)((bf16_t*)(R + R_AVC) + (size_t)row * 128 + wc * 32 + fq * 8) = pack8(v0, v1);
                                   else vt_store((bf16_t*)(R + R_AVST), 2, b, hh, dv0, tseq, v0, v1); }
                    else if (t == 15) vt_store((bf16_t*)(R + (bj == 0 ? R_AVWT : R_BVT)), 2, b, hh, dv0, tseq, v0, v1);
                    else vt_store((bf16_t*)(R + (t < 18 ? R_CVT : R_DVT)), 8, b, (t & 1) * 4 + 2 * bj + hh, dv0, tseq, v0, v1); }
                asm volatile("s_waitcnt vmcnt(16)" ::: "memory"); }
        }
    }
};
struct EpiGate8 {
    unsigned char* G; float inv_scale;
    __device__ __forceinline__ void operator()(ACC_T, const pg8::Unit& u, int wr, int wc, int fr, int fq) const {
        asm volatile("" : "+v"(fr), "+v"(fq));
        const unsigned row0 = (unsigned)(u.pm * 256 + wr * 64 + fr), colb = (unsigned)(u.pn * 256 + wc * 32 + fq * 8);
        FOR_AI_M { const unsigned row = row0 + ai * 128 + m * 16;
#pragma unroll
            for (int bj = 0; bj < 2; ++bj) { f32x4 l0, l1;
#pragma unroll
                for (int i = 0; i < 4; ++i) { l0[i] = -__builtin_amdgcn_logf(1.f + fast_exp2(fminf(-acc[ai][bj][m][0][i] * (inv_scale * LOG2E), 100.f))); l1[i] = -__builtin_amdgcn_logf(1.f + fast_exp2(fminf(-acc[ai][bj][m][1][i] * (inv_scale * LOG2E), 100.f))); }
                *(u32x2*)(G + (row * 8192u + colb + bj * 128)) = pack8_fp8(l0, l1); } }
    }
};
struct EpiMerge {
    const unsigned char* gates; bf16_t* merged; unsigned char* merged8;
    __device__ __forceinline__ void operator()(ACC_T, const pg8::Unit& u, int wr, int wc, int fr, int fq) const {
        asm volatile("" : "+v"(fr), "+v"(fq));
        const int n = u.aux; const unsigned row0 = (unsigned)(u.pm * 256 + wr * 64 + fr), colb = (unsigned)(u.pn * 256 + wc * 32 + fq * 8);
        const unsigned char* gb = gates + n * 2048;
#pragma unroll
        for (int ai = 0; ai < 2; ++ai)
#pragma unroll
            for (int mp = 0; mp < 2; ++mp) {
                u32x2 g[2][2]; u32x4 p[2][2];
#pragma unroll
                for (int mm = 0; mm < 2; ++mm)
#pragma unroll
                    for (int bj = 0; bj < 2; ++bj) { const unsigned row = row0 + ai * 128 + (2 * mp + mm) * 16, col = colb + bj * 128;
                        g[mm][bj] = *(const u32x2*)(gb + (row * 8192u + col));
                        if (n > 0) p[mm][bj] = *(const u32x4*)(merged + (row * 2048u + col)); else p[mm][bj] = (u32x4){0u, 0u, 0u, 0u}; }
#pragma unroll
                for (int mm = 0; mm < 2; ++mm)
#pragma unroll
                    for (int bj = 0; bj < 2; ++bj) { const int m = 2 * mp + mm; const unsigned row = row0 + ai * 128 + m * 16, col = colb + bj * 128;
                        f32x4 g0, g1, p0, p1; unpack8_fp8(g[mm][bj], g0, g1); unpack8(p[mm][bj], p0, p1); g0 = sig4(g0); g1 = sig4(g1);
                        const f32x4 v0 = g0 * acc[ai][bj][m][0] + p0, v1 = g1 * acc[ai][bj][m][1] + p1;
                        if (n < 3) *(u32x4*)(merged + (row * 2048u + col)) = pack8(v0, v1); else *(u32x2*)(merged8 + (row * 2048u + col)) = pack8_fp8(v0 * MERGED8_SCALE, v1 * MERGED8_SCALE); }
                asm volatile("" ::: "memory");
            }
    }
};
#ifndef MERGE_CHAIN
#define MERGE_CHAIN 1
#endif
struct EpiMergeChain {
    const unsigned char* gates; unsigned char* merged8; float inv;
    __device__ __forceinline__ void operator()(f32x4 (&acc)[2][2][4][2], const pg8::Unit& u, int wr, int wc, int fr, int fq) const {
        asm volatile("" : "+v"(fr), "+v"(fq));
        const int n = u.aux; const unsigned row0 = (unsigned)(u.pm * 256 + wr * 64 + fr), colb = (unsigned)(u.pn * 256 + wc * 32 + fq * 8);
        const unsigned char* gb = gates + n * 2048;
#pragma unroll
        for (int ai = 0; ai < 2; ++ai)
#pragma unroll
            for (int mp = 0; mp < 2; ++mp) {
                u32x2 g[2][2], h[2][2];
#pragma unroll
                for (int mm = 0; mm < 2; ++mm)
#pragma unroll
                    for (int bj = 0; bj < 2; ++bj) { const unsigned row = row0 + ai * 128 + (2 * mp + mm) * 16, col = colb + bj * 128;
                        g[mm][bj] = *(const u32x2*)(gb + (row * 8192u + col));
                        if (n < 3) h[mm][bj] = *(const u32x2*)(gb + 2048 + (row * 8192u + col)); else h[mm][bj] = (u32x2){0u, 0u}; }
#pragma unroll
                for (int mm = 0; mm < 2; ++mm)
#pragma unroll
                    for (int bj = 0; bj < 2; ++bj) { const int m = 2 * mp + mm; const unsigned row = row0 + ai * 128 + m * 16, col = colb + bj * 128;
                        f32x4 x0, x1; unpack8_fp8(g[mm][bj], x0, x1);
                        if (n < 3) { f32x4 y0, y1; unpack8_fp8(h[mm][bj], y0, y1);
#pragma unroll
                            for (int i = 0; i < 4; ++i) { acc[ai][bj][m][0][i] *= fast_exp2(x0[i] - y0[i]); acc[ai][bj][m][1][i] *= fast_exp2(x1[i] - y1[i]); } }
                        else { f32x4 d0, d1;
#pragma unroll
                            for (int i = 0; i < 4; ++i) { d0[i] = fast_exp2(x0[i]); d1[i] = fast_exp2(x1[i]); }
                            *(u32x2*)(merged8 + (row * 2048u + col)) = pack8_fp8(acc[ai][bj][m][0] * d0 * (MERGED8_SCALE * inv), acc[ai][bj][m][1] * d1 * (MERGED8_SCALE * inv)); } }
                asm volatile("" ::: "memory");
            }
    }
};
struct EpiF32 {
    float* out; float scale;
    __device__ __forceinline__ void operator()(ACC_T, const pg8::Unit& u, int wr, int wc, int fr, int fq) const {
        asm volatile("" : "+v"(fr), "+v"(fq));
        const unsigned row0 = (unsigned)(u.pm * 256 + wr * 64 + fr), colb = (unsigned)(u.pn * 256 + wc * 32 + fq * 8);
        FOR_AI_M { const unsigned row = row0 + ai * 128 + m * 16;
#pragma unroll
            for (int bj = 0; bj < 2; ++bj) { const unsigned o = row * 2048u + colb + bj * 128; *(f32x4*)(out + o) = acc[ai][bj][m][0] * scale; *(f32x4*)(out + o + 4) = acc[ai][bj][m][1] * scale; } }
    }
};
struct EpiBf16S {
    bf16_t* out; float scale;
    __device__ __forceinline__ void operator()(ACC_T, const pg8::Unit& u, int wr, int wc, int fr, int fq) const {
        asm volatile("" : "+v"(fr), "+v"(fq));
        const unsigned row0 = (unsigned)(u.pm * 256 + wr * 64 + fr), colb = (unsigned)(u.pn * 256 + wc * 32 + fq * 8);
        FOR_AI_M { const unsigned row = row0 + ai * 128 + m * 16;
#pragma unroll
            for (int bj = 0; bj < 2; ++bj) *(u32x4*)(out + (row * 2048u + colb + bj * 128)) = pack8(acc[ai][bj][m][0] * scale, acc[ai][bj][m][1] * scale); }
    }
};
struct EpiSwiglu {
    bf16_t* act; int ld;
    __device__ __forceinline__ void operator()(ACC_T, const pg8::Unit& u, int wr, int wc, int fr, int fq) const {
        asm volatile("" : "+v"(fr), "+v"(fq));
        const int row0 = u.pm * 256 + wr * 64 + fr;
        FOR_AI_M { const int row = row0 + ai * 128 + m * 16; f32x4 o[2];
#pragma unroll
            for (int n = 0; n < 2; ++n) { const f32x4 g = acc[ai][0][m][n], up = acc[ai][1][m][n];
#pragma unroll
                for (int i = 0; i < 4; ++i) o[n][i] = g[i] * sigmoidf_(g[i]) * up[i]; }
            *(u32x4*)(act + (size_t)row * ld + u.pn * 128 + wc * 32 + fq * 8) = pack8(o[0], o[1]); }
    }
};
struct EpiSwigluF8 {
    unsigned char* act; int ld; float inv_scale;
    __device__ __forceinline__ void operator()(ACC_T, const pg8::Unit& u, int wr, int wc, int fr, int fq) const {
        asm volatile("" : "+v"(fr), "+v"(fq));
        const int row0 = u.pm * 256 + wr * 64 + fr;
        FOR_AI_M { const int row = row0 + ai * 128 + m * 16; f32x4 o[2];
#pragma unroll
            for (int n = 0; n < 2; ++n) { const f32x4 g = acc[ai][0][m][n] * inv_scale, up = acc[ai][1][m][n] * inv_scale;
#pragma unroll
                for (int i = 0; i < 4; ++i) o[n][i] = g[i] * sigmoidf_(g[i]) * up[i]; }
            *(u32x2*)(act + (size_t)row * ld + u.pn * 128 + wc * 32 + fq * 8) = pack8_fp8(o[0], o[1]); }
    }
};
struct EpiBf16 {
    bf16_t* out;
    __device__ __forceinline__ void operator()(ACC_T, const pg8::Unit& u, int wr, int wc, int fr, int fq) const {
        asm volatile("" : "+v"(fr), "+v"(fq));
        const int row0 = u.pm * 256 + wr * 64 + fr;
        FOR_AI_M { const int row = row0 + ai * 128 + m * 16;
#pragma unroll
            for (int bj = 0; bj < 2; ++bj) *(u32x4*)(out + (size_t)row * DM + u.pn * 256 + bj * 128 + wc * 32 + fq * 8) = pack8(acc[ai][bj][m][0], acc[ai][bj][m][1]); }
    }
};
struct EpiPleGate {
    const bf16_t* ptmp; bf16_t* ple; float scale;
    __device__ __forceinline__ void operator()(ACC_T, const pg8::Unit& u, int wr, int wc, int fr, int fq) const {
        asm volatile("" : "+v"(fr), "+v"(fq));
        const int row0 = u.pm * 256 + wr * 64 + fr;
        FOR_AI_M { const int row = row0 + ai * 128 + m * 16;
#pragma unroll
            for (int bj = 0; bj < 2; ++bj) { const size_t o = (size_t)row * DM + u.pn * 256 + bj * 128 + wc * 32 + fq * 8;
                f32x4 p0, p1; unpack8(ld_sc1_u32x4(ptmp + o), p0, p1);
                *(u32x4*)(ple + o) = pack8(sig4(acc[ai][bj][m][0] * scale) * p0, sig4(acc[ai][bj][m][1] * scale) * p1); }
            asm volatile("" ::: "memory"); }
    }
};
struct EpiMoeDown {
    const float* sroww; bf16_t* ys; float inv_scale;
    __device__ __forceinline__ void operator()(ACC_T, const pg8::Unit& u, int wr, int wc, int fr, int fq) const {
        asm volatile("" : "+v"(fr), "+v"(fq));
        const int row0 = u.pm * 256 + wr * 64 + fr;
        FOR_AI_M { const int row = row0 + ai * 128 + m * 16; const float w = sroww[row] * inv_scale;
#pragma unroll
            for (int bj = 0; bj < 2; ++bj) *(u32x4*)(ys + (size_t)row * DM + u.pn * 256 + bj * 128 + wc * 32 + fq * 8) = pack8(acc[ai][bj][m][0] * w, acc[ai][bj][m][1] * w); }
    }
};

struct Args { const void* in[28]; float* out; unsigned char* ws; int ph_lo, ph_hi; };
enum { IN_X = 0, IN_P, IN_POS, IN_WIN, IN_PE, IN_CW1, IN_CB1, IN_CW2, IN_SINK, IN_FOXB, IN_DLAM, IN_DGAIN, IN_WBR, IN_WOUT, IN_LN1G, IN_LN1B,
       IN_FWG, IN_FWU, IN_FWD, IN_ROUTER, IN_ROUTERB, IN_MWG, IN_MWU, IN_MWD, IN_PPROJ, IN_PGATE, IN_LN2G, IN_LN2B };
struct Frame { LAS unsigned char* lds; int tid, lane, wave, vcu, G; };

enum { MAP_PLAIN = 0, MAP_R64 = 1, MAP_R32 = 2, MAP_GU = 3 };
struct TrSeg { const float* W; bf16_t* WT; int ldw, K, ncols, ldt, kind, vbase, aoff, item0; float f8scale; int pad; };
__device__ __forceinline__ int map_row(int kind, int a) {
    if (kind == MAP_R64) { const int l = a & 255; return (a & ~255) + 128 * ((l >> 5) & 1) + 32 * (l >> 6) + (l & 31); }
    if (kind == MAP_R32) { const int l = a & 255; return (a & ~255) + 128 * ((l >> 4) & 1) + 32 * (l >> 6) + 8 * ((l >> 2) & 3) + 4 * ((l >> 5) & 1) + (l & 3); }
    if (kind == MAP_GU) return (a >> 7) * 256 + (a & 127);
    return a;
}
__device__ __forceinline__ void tr_item(const TrSeg& s, int item, LAS unsigned char* scr, int lane) {
    const int nblk = s.ncols >> 6, kb = item / nblk, nb = item - kb * nblk, k0 = kb * 64, n0 = nb * 64;
    const int q4 = lane >> 4, n4 = (lane & 15) * 4;
    f32x4 v[16];
    const float* src = s.W + (size_t)(k0 + q4 * 16) * s.ldw + n0 + n4;
#pragma unroll
    for (int kk = 0; kk < 16; ++kk) v[kk] = *(const f32x4*)(src + (size_t)kk * s.ldw);
    if (s.f8scale != 0.f) {
        const float sc = s.f8scale;
#pragma unroll
        for (int i = 0; i < 4; ++i) { u32x4 w;
#pragma unroll
            for (int j = 0; j < 4; ++j) { unsigned d = 0u; d = __builtin_amdgcn_cvt_pk_fp8_f32(v[4 * j][i] * sc, v[4 * j + 1][i] * sc, d, false); d = __builtin_amdgcn_cvt_pk_fp8_f32(v[4 * j + 2][i] * sc, v[4 * j + 3][i] * sc, d, true); w[j] = d; }
            *(LAS u32x4*)(scr + (n4 + i) * 144 + q4 * 16) = w; }
        LDS_WAIT(); asm volatile("" ::: "memory");
#pragma unroll
        for (int it = 0; it < 4; ++it) { const int n = (lane >> 2) + 16 * it, ch = lane & 3;
            const u32x4 val = *(const LAS u32x4*)(scr + n * 144 + ch * 16);
            const int vr = s.vbase + map_row(s.kind, s.aoff + n0 + n);
            *(u32x4*)((unsigned char*)s.WT + (size_t)vr * s.ldt + k0 + ch * 16) = val; }
        LDS_WAIT(); asm volatile("" ::: "memory");
        return;
    }
#pragma unroll
    for (int i = 0; i < 4; ++i) {
        u32x4 w0, w1;
        w0.x = cvt_pk_bf16(v[0][i], v[1][i]); w0.y = cvt_pk_bf16(v[2][i], v[3][i]); w0.z = cvt_pk_bf16(v[4][i], v[5][i]); w0.w = cvt_pk_bf16(v[6][i], v[7][i]);
        w1.x = cvt_pk_bf16(v[8][i], v[9][i]); w1.y = cvt_pk_bf16(v[10][i], v[11][i]); w1.z = cvt_pk_bf16(v[12][i], v[13][i]); w1.w = cvt_pk_bf16(v[14][i], v[15][i]);
        LAS unsigned char* p = scr + (n4 + i) * 144 + q4 * 32;
        *(LAS u32x4*)p = w0; *(LAS u32x4*)(p + 16) = w1;
    }
    LDS_WAIT(); asm volatile("" ::: "memory");
#pragma unroll
    for (int it = 0; it < 8; ++it) { const int n = (lane >> 3) + 8 * it, ch = lane & 7;
        const u32x4 val = *(const LAS u32x4*)(scr + n * 144 + ch * 16);
        const int vr = s.vbase + map_row(s.kind, s.aoff + n0 + n);
        *(u32x4*)(s.WT + (size_t)vr * s.ldt + k0 + ch * 8) = val; }
    LDS_WAIT(); asm volatile("" ::: "memory");
}
__device__ __forceinline__ void tr_item_f8(const TrSeg& s, int item, LAS unsigned char* scr, int lane) {
    const int nblk = s.ncols >> 6, kb = item / nblk, nb = item - kb * nblk, k0 = kb * 128, n0 = nb * 64;
    const int q4 = lane >> 4, n4 = (lane & 15) * 4;
    f32x4 v[32];
    const float* src = s.W + (size_t)(k0 + q4 * 32) * s.ldw + n0 + n4;
#pragma unroll
    for (int kk = 0; kk < 32; ++kk) v[kk] = *(const f32x4*)(src + (size_t)kk * s.ldw);
    const float sc = s.f8scale;
#pragma unroll
    for (int i = 0; i < 4; ++i) { u32x4 w0, w1;
#pragma unroll
        for (int j = 0; j < 4; ++j) { unsigned d = 0u; d = __builtin_amdgcn_cvt_pk_fp8_f32(v[4 * j][i] * sc, v[4 * j + 1][i] * sc, d, false); d = __builtin_amdgcn_cvt_pk_fp8_f32(v[4 * j + 2][i] * sc, v[4 * j + 3][i] * sc, d, true); w0[j] = d;
            unsigned e = 0u; e = __builtin_amdgcn_cvt_pk_fp8_f32(v[16 + 4 * j][i] * sc, v[17 + 4 * j][i] * sc, e, false); e = __builtin_amdgcn_cvt_pk_fp8_f32(v[18 + 4 * j][i] * sc, v[19 + 4 * j][i] * sc, e, true); w1[j] = e; }
        LAS unsigned char* p = scr + (n4 + i) * 144 + q4 * 32; *(LAS u32x4*)p = w0; *(LAS u32x4*)(p + 16) = w1; }
    LDS_WAIT(); asm volatile("" ::: "memory");
#pragma unroll
    for (int it = 0; it < 8; ++it) { const int n = (lane >> 3) + 8 * it, ch = lane & 7;
        const u32x4 val = *(const LAS u32x4*)(scr + n * 144 + ch * 16);
        const int vr = s.vbase + map_row(s.kind, s.aoff + n0 + n);
        *(u32x4*)((unsigned char*)s.WT + (size_t)vr * s.ldt + k0 + ch * 16) = val; }
    LDS_WAIT(); asm volatile("" ::: "memory");
}
__device__ __forceinline__ void p0_prologue(const Frame& F, const Args& A) {
    unsigned char* ws = A.ws;
    LAS unsigned char* scr = F.lds + F.wave * 9216;
    LAS TrSeg* tab = (LAS TrSeg*)(F.lds + 81920);
    LAS int* tabn = (LAS int*)(F.lds + 81920 + 96 * 56);
    if (F.tid == 0) {
        int n = 0, item = 0;
#define add8(W_, ldw_, K_, ncols_, WT_, ldt_, kind_, vbase_, aoff_, f8_) do { LAS TrSeg* s_ = tab + n; s_->f8scale = (f8_); s_->pad = 0; s_->W = (W_); s_->WT = (WT_); s_->ldw = (ldw_); s_->K = (K_); s_->ncols = (ncols_); s_->ldt = (ldt_); \
            s_->kind = (kind_); s_->vbase = (vbase_); s_->aoff = (aoff_); s_->item0 = item; ++n; item += ((K_) >> 6) * ((ncols_) >> 6); } while (0)
#define add(W_, ldw_, K_, ncols_, WT_, ldt_, kind_, vbase_, aoff_) add8(W_, ldw_, K_, ncols_, WT_, ldt_, kind_, vbase_, aoff_, 0.f)
        int n_now = 0, item_now = 0;
        for (int pass = 0; pass < 2; ++pass) {
#define addp(def_, ...) do { if ((def_) == pass) add(__VA_ARGS__); } while (0)
#define addp8(def_, ...) do { if ((def_) == pass) add8(__VA_ARGS__); } while (0)
            addp(1, (const float*)A.in[IN_FWG], DFF, DM, DFF, (bf16_t*)(ws + WS_WFGU), DM, MAP_GU, 0, 0);
            addp(1, (const float*)A.in[IN_FWU], DFF, DM, DFF, (bf16_t*)(ws + WS_WFGU), DM, MAP_GU, 128, 0);
#if DENSE_DOWN_FP8
            addp8(1, (const float*)A.in[IN_FWD], DM, DFF, DM, (bf16_t*)(ws + WS_WFD), DFF8, MAP_PLAIN, 0, 0, WFD_SCALE);
#else
            addp(1, (const float*)A.in[IN_FWD], DM, DFF, DM, (bf16_t*)(ws + WS_WFD), DFF, MAP_PLAIN, 0, 0);
#endif
            for (int L = 0; L < NLAYER; ++L) {
                const float* win = (const float*)A.in[IN_WIN] + (size_t)L * DM * INC; bf16_t* wa = (bf16_t*)(ws + WS_WA + L * SZ_WA);
#if QKV_FP8
#define ADDWA(W_, nc_, kind_, vb_, ao_) addp8(L, W_, INC, DM, nc_, wa, DM, kind_, vb_, ao_, WA_SCALE)
#else
#define ADDWA(W_, nc_, kind_, vb_, ao_) addp(L, W_, INC, DM, nc_, wa, DM, kind_, vb_, ao_)
#endif
                ADDWA(win + SRC_AQ, 512, MAP_R64, 0 * 256, 0);
                ADDWA(win + SRC_BQ, 512, MAP_R64, 2 * 256, 0);
                ADDWA(win + SRC_AKC, 128, MAP_R64, 4 * 256, 0);
                ADDWA(win + SRC_AKS, 128, MAP_R64, 4 * 256, 128);
                ADDWA(win + SRC_AKW, 128, MAP_R64, 5 * 256, 0);
                ADDWA(win + SRC_BK, 128, MAP_R64, 5 * 256, 128);
                ADDWA(win + SRC_CQ, 512, MAP_PLAIN, 6 * 256, 0);
                ADDWA(win + SRC_CK, 512, MAP_PLAIN, 8 * 256, 0);
                ADDWA(win + SRC_DQ, 512, MAP_R32, 10 * 256, 0);
                ADDWA(win + SRC_DK, 512, MAP_R32, 12 * 256, 0);
                ADDWA(win + SRC_AVC, 128, MAP_PLAIN, 14 * 256, 0);
                ADDWA(win + SRC_AVS, 128, MAP_PLAIN, 14 * 256, 128);
                ADDWA(win + SRC_AVW, 128, MAP_PLAIN, 15 * 256, 0);
                ADDWA(win + SRC_BV, 128, MAP_PLAIN, 15 * 256, 128);
                ADDWA(win + SRC_CV, 512, MAP_PLAIN, 16 * 256, 0);
                ADDWA(win + SRC_DV, 512, MAP_PLAIN, 18 * 256, 0);
                addp8(L, win + SRC_MG, INC, DM, 8192, (bf16_t*)(ws + WS_WAG8 + L * SZ_WAG8), DM, MAP_PLAIN, 0, 0, GATE_W_SCALE);
                for (int kv = 0; kv < 2; ++kv) addp(L, (const float*)A.in[IN_CW1] + (size_t)(L * 2 + kv) * 2048 * 256, 256, 2048, 256, (bf16_t*)(ws + WS_WC1 + (L * 2 + kv) * SZ_WC1), 2048, MAP_PLAIN, 0, 0);
#if PD_FP8
                for (int nb = 0; nb < 4; ++nb) addp8(1, (const float*)A.in[IN_WBR] + (size_t)(L * 4 + nb) * 512 * DM, DM, 512, DM, (bf16_t*)(ws + WS_WB + L * SZ_WB + (size_t)nb * DM * 512), 512, MAP_PLAIN, 0, 0, WB_SCALE);
#else
                for (int nb = 0; nb < 4; ++nb) addp(1, (const float*)A.in[IN_WBR] + (size_t)(L * 4 + nb) * 512 * DM, DM, 512, DM, (bf16_t*)(ws + WS_WB + L * SZ_WB) + (size_t)nb * DM * 512, 512, MAP_PLAIN, 0, 0);
#endif
                addp8(1, (const float*)A.in[IN_WOUT] + (size_t)L * DM * DM, DM, DM, DM, (bf16_t*)(ws + WS_WO + L * SZ_WO), DM, MAP_PLAIN, 0, 0, WO_SCALE);
                addp(1, (const float*)A.in[IN_PPROJ] + (size_t)L * PLE * DM, DM, PLE, DM, (bf16_t*)(ws + WS_WPP + L * SZ_WPP), PLE, MAP_PLAIN, 0, 0);
                if (L == 0 && !PLE0_FP8) addp(1, (const float*)A.in[IN_PGATE] + (size_t)L * DM * DM, DM, DM, DM, (bf16_t*)(ws + WS_WPG + L * SZ_WPG), DM, MAP_PLAIN, 0, 0);
                else addp8(1, (const float*)A.in[IN_PGATE] + (size_t)L * DM * DM, DM, DM, DM, (bf16_t*)(ws + WS_WPG + L * SZ_WPG), DM, MAP_PLAIN, 0, 0, PG_SCALE);
            }
            if (pass == 0) { n_now = n; item_now = item; }
#undef addp
#undef addp8
        }
        if (F.vcu == 0) {
            int* gh = (int*)(ws + WS_CTL + DEFTAB_OFF); gh[0] = n - n_now; gh[1] = item - item_now;
            for (int i = n_now; i < n; ++i) { const LAS unsigned* src = (const LAS unsigned*)(tab + i); unsigned* dst = (unsigned*)(gh + 4) + (i - n_now) * 14;
                for (int w = 0; w < 14; ++w) dst[w] = src[w];
                ((TrSeg*)dst)->item0 = tab[i].item0 - item_now; }
        }
        n = n_now; item = item_now;
        tabn[0] = n; tabn[1] = item;
#undef add
#undef add8
    }
    __syncthreads();
    const int nseg = tabn[0], nitems = tabn[1];
    const int gw = F.vcu * NWAVES + F.wave, NGW = F.G * NWAVES;
    {
        int si = 0; TrSeg s; int send;
#define LDSEG(i_) do { LAS TrSeg* t_ = tab + (i_); s.W = (const float*)(const GAS float*)(unsigned long long)t_->W; s.WT = (bf16_t*)(GAS bf16_t*)(unsigned long long)t_->WT; s.ldw = t_->ldw; s.K = t_->K; s.ncols = t_->ncols; s.ldt = t_->ldt; s.kind = t_->kind; s.vbase = t_->vbase; s.aoff = t_->aoff; s.item0 = t_->item0; s.f8scale = t_->f8scale; \
            send = ((i_) + 1 < nseg) ? tab[(i_) + 1].item0 : nitems; } while (0)
        LDSEG(0);
        for (int it = gw; it < nitems; it += NGW) {
            while (it >= send) { ++si; LDSEG(si); }
            tr_item(s, it - s.item0, scr, F.lane);
        }
    }
    const int gt = (F.vcu * NWAVES + F.wave) * 64 + F.lane, NGT = NGW * 64;
    { const float* x = (const float*)A.in[IN_X]; bf16_t* hb = (bf16_t*)(ws + WS_HB);
      unsigned char* hb8 = ws + WS_HB8;
      for (int i = gt; i < MTOK * DM / 8; i += NGT) { const f32x4 a = *(const f32x4*)(x + (size_t)i * 8), b = *(const f32x4*)(x + (size_t)i * 8 + 4); *(u32x4*)(hb + (size_t)i * 8) = pack8(a, b); *(u32x2*)(hb8 + (size_t)i * 8) = pack8_fp8(a, b); }
      const float* p = (const float*)A.in[IN_P]; bf16_t* pb = (bf16_t*)(ws + WS_PB16);
      for (int i = gt; i < 2 * MTOK * PLE / 8; i += NGT) { const f32x4 a = *(const f32x4*)(p + (size_t)i * 8), b = *(const f32x4*)(p + (size_t)i * 8 + 4); *(u32x4*)(pb + (size_t)i * 8) = pack8(a, b); } }
#if DENSE_DOWN_FP8
    for (int i = gt; i < DM * 8; i += NGT) *(u32x4*)(ws + WS_WFD + (size_t)(i >> 3) * DFF8 + DFF + (i & 7) * 16) = (u32x4){0u, 0u, 0u, 0u};
#endif
    { const int* pos = (const int*)A.in[IN_POS]; float* r64 = (float*)(ws + WS_ROPE64); float* r32 = (float*)(ws + WS_ROPE32);
      for (int i = gt; i < MTOK * 32; i += NGT) { const int tok = i >> 5, j = i & 31; const float inv = 1.0f / powf(10000.0f, (float)(2 * j) / 64.0f); const float ang = (float)pos[tok] * inv;
          float sn, cs; sincosf(ang, &sn, &cs); r64[(size_t)tok * 64 + j] = cs; r64[(size_t)tok * 64 + 32 + j] = sn; }
      for (int i = gt; i < MTOK * 16; i += NGT) { const int tok = i >> 4, j = i & 15; const float inv = 1.0f / powf(10000.0f, (float)(2 * j) / 32.0f); const float ang = (float)pos[tok] * inv;
          float sn, cs; sincosf(ang, &sn, &cs); r32[(size_t)tok * 32 + j] = cs; r32[(size_t)tok * 32 + 16 + j] = sn; } }
    for (int i = gt; i < NLAYER * 32 * DM; i += NGT) { const int L = i / (32 * DM), r = (i / DM) & 31, k = i % DM; const int sc = r < 24 ? SRC_AG + r : SRC_CF + (r - 24);
        ((bf16_t*)(ws + WS_WS))[i] = f2bf(((const float*)A.in[IN_WIN])[((size_t)L * DM + k) * INC + sc]); }
    for (int i = gw; i < NLAYER * 2 * 256; i += NGW) { const int lk = i >> 8, n = i & 255; const float* pe = (const float*)A.in[IN_PE] + (size_t)lk * 2048 + F.lane * 32; const float* w1 = (const float*)A.in[IN_CW1] + (size_t)lk * 2048 * 256 + (size_t)(F.lane * 32) * 256 + n;
        float wv[32];
#pragma unroll
        for (int j = 0; j < 32; ++j) wv[j] = w1[(size_t)j * 256];
        float sacc = 0.f;
#pragma unroll
        for (int j = 0; j < 32; ++j) sacc += pe[j] * wv[j];
        sacc = wave_sum(sacc);
        if (F.lane == 0) ((float*)(ws + WS_CVEC))[i] = sacc + ((const float*)A.in[IN_CB1])[i]; }
}

__device__ __forceinline__ void small_gates(const Frame& F, const bf16_t* hb, const bf16_t* wsm, const float* foxb, float* ga) {
    const int fr = F.lane & 15, fq = F.lane >> 4; const int half = F.wave >> 2, wq = F.wave & 3;
    LAS f32x4* part = (LAS f32x4*)F.lds + wq * 128 + F.lane * 2;
    for (int task0 = F.vcu * 4; task0 < MTOK / 16; task0 += F.G * 4) {
        const int task = task0 + wq;
        const bf16_t* ap = hb + (size_t)(task * 16 + fr) * DM + fq * 8 + half * 1024; const bf16_t* bp = wsm + (size_t)fr * DM + fq * 8 + half * 1024;
        f32x4 acc0 = {0.f, 0.f, 0.f, 0.f}, acc1 = {0.f, 0.f, 0.f, 0.f};
#pragma unroll 1
        for (int ks = 0; ks < 32; ks += 8) {
            bf16x8 a[8], b0[8], b1[8];
#pragma unroll
            for (int j = 0; j < 8; ++j) { a[j] = *(const bf16x8*)(ap + (ks + j) * 32); b0[j] = *(const bf16x8*)(bp + (ks + j) * 32); b1[j] = *(const bf16x8*)(bp + (size_t)16 * DM + (ks + j) * 32); }
#pragma unroll
            for (int j = 0; j < 8; ++j) { acc0 = __builtin_amdgcn_mfma_f32_16x16x32_bf16(b0[j], a[j], acc0, 0, 0, 0); acc1 = __builtin_amdgcn_mfma_f32_16x16x32_bf16(b1[j], a[j], acc1, 0, 0, 0); }
        }
        if (half == 1) { part[0] = acc0; part[1] = acc1; }
        __syncthreads();
        if (half == 0) {
            acc0 = acc0 + part[0]; acc1 = acc1 + part[1];
            float* o = ga + (size_t)(task * 16 + fr) * 32 + 4 * fq;
            *(f32x4*)o = sig4(acc0);
            f32x4 r;
            if (fq < 2) r = sig4(acc1);
            else {
#pragma unroll
                for (int i = 0; i < 4; ++i) { const float x = acc1[i] + foxb[4 * (fq - 2) + i]; r[i] = fminf(x, 0.f) - log1pf(expf(-fabsf(x))); }
            }
            *(f32x4*)(o + 16) = r;
        }
        __syncthreads();
    }
}

__device__ __forceinline__ float gelu_tanh(float x) { const float u = 0.7978845608028654f * (x + 0.044715f * x * x * x); const float e = __expf(2.f * u); const float th = 1.f - 2.f / (e + 1.f); return 0.5f * x * (1.f + th); }
__device__ __forceinline__ void pb_item(const Frame& F, const Args& A, int L, int item) {
    unsigned char* ws = A.ws; unsigned char* R = ws + WS_R;
    if (item < NB * 8) { const int task = item;
        const int b = task >> 3, hh = task & 7; const float* src = (const float*)(ws + WS_GA) + ((size_t)b * SEQ + 8 * F.tid) * 32 + 24 + hh;
        LAS float* wtot = (LAS float*)(F.lds + 32768);
        float v[8];
#pragma unroll
        for (int j = 0; j < 8; ++j) v[j] = src[j * 32];
#pragma unroll
        for (int j = 1; j < 8; ++j) v[j] += v[j - 1];
        float inc = v[7];
#pragma unroll
        for (int o = 1; o < 64; o <<= 1) { const float y = __shfl_up(inc, o); if (F.lane >= o) inc += y; }
        if (F.lane == 63) wtot[F.wave] = inc;
        __syncthreads();
        float base = inc - v[7];
        for (int w = 0; w < F.wave; ++w) base += wtot[w];
        f32x4 o0, o1;
#pragma unroll
        for (int j = 0; j < 4; ++j) { o0[j] = (base + v[j]) * LOG2E; o1[j] = (base + v[4 + j]) * LOG2E; }
        float* dst = (float*)(ws + WS_CUM) + (size_t)task * SEQ + 8 * F.tid;
        *(f32x4*)dst = o0; *(f32x4*)(dst + 4) = o1;
        __syncthreads();
        return;
    }
    LAS float* hid = (LAS float*)(F.lds);
    LAS float* w2s = (LAS float*)(F.lds + 32768 + 1024);
    const int fr = F.lane & 15, fq = F.lane >> 4;
    { const int u = item - NB * 8;
        const int kv = u >> 7, b = (u >> 5) & 3, h = (u >> 4) & 1, ig = u & 15;
        const bf16_t* src = (const bf16_t*)(R + (kv == 0 ? R_AKC : R_AVC)); const bf16_t* w1t = (const bf16_t*)(ws + WS_WC1 + (L * 2 + kv) * SZ_WC1);
        const float* cvec = (const float*)(ws + WS_CVEC) + (L * 2 + kv) * 256; const float* w2 = (const float*)A.in[IN_CW2] + (size_t)(L * 2 + kv) * 256 * 64;
        { f32x4 t[8];
#pragma unroll
          for (int q = 0; q < 8; ++q) t[q] = *(const f32x4*)(w2 + (size_t)(F.tid + 512 * q) * 4);
#pragma unroll
          for (int q = 0; q < 8; ++q) *(LAS f32x4*)(w2s + (F.tid + 512 * q) * 4) = t[q]; }
        int ic = 16 * ig + fr; if (ic > 254) ic = 254;
        const bf16_t* xp = src + ((size_t)b * SEQ + 16 * ic) * 128 + h * 64 + fq * 8;
        const bf16_t* wp = w1t + (size_t)(32 * F.wave + fr) * 2048 + fq * 8;
        f32x4 acc0 = {0.f, 0.f, 0.f, 0.f}, acc1 = {0.f, 0.f, 0.f, 0.f};
#pragma unroll 1
        for (int ks = 0; ks < 64; ks += 16) {
            bf16x8 a[16], b0[16], b1[16];
#pragma unroll
            for (int j = 0; j < 16; ++j) { const int k = ks + j; a[j] = *(const bf16x8*)(xp + (size_t)(k >> 1) * 128 + (k & 1) * 32); b0[j] = *(const bf16x8*)(wp + k * 32); b1[j] = *(const bf16x8*)(wp + (size_t)16 * 2048 + k * 32); }
            asm volatile("s_waitcnt vmcnt(0)" ::: "memory");
#pragma unroll
            for (int j = 0; j < 16; ++j) { acc0 = __builtin_amdgcn_mfma_f32_16x16x32_bf16(b0[j], a[j], acc0, 0, 0, 0); acc1 = __builtin_amdgcn_mfma_f32_16x16x32_bf16(b1[j], a[j], acc1, 0, 0, 0); }
        }
#pragma unroll
        for (int i = 0; i < 4; ++i) { const int c0 = 32 * F.wave + 4 * fq + i; hid[fr * 260 + c0] = gelu_tanh(acc0[i] + cvec[c0]); hid[fr * 260 + c0 + 16] = gelu_tanh(acc1[i] + cvec[c0 + 16]); }
        __syncthreads();
        { const int r = F.tid >> 5, c0 = 2 * (F.tid & 31); float o0 = 0.f, o1 = 0.f;
#pragma unroll 16
          for (int k = 0; k < 256; ++k) { const float hv = hid[r * 260 + k]; const f32x2 w = *(const LAS f32x2*)(w2s + k * 64 + c0); o0 += hv * w.x; o1 += hv * w.y; }
          const int i = 16 * ig + r; if (i == 255) { o0 = 0.f; o1 = 0.f; }
          if (kv == 0) { *(unsigned*)((bf16_t*)(ws + WS_KC) + ((size_t)(b * 2 + h) * 256 + i) * 64 + c0) = cvt_pk_bf16(o0, o1); }
          else { bf16_t* vt = (bf16_t*)(ws + WS_VCT) + ((size_t)(b * 2 + h) * 64 + c0) * 256 + perm23(i); vt[0] = f2bf(o0); vt[256] = f2bf(o1); } }
        __syncthreads();
    }
}

__device__ __forceinline__ void ln_finish(f32x4 (&v)[8], const float* g, const float* bt, float* outf, bf16_t* outb, int lane, unsigned char* out8 = nullptr) {
    float s = 0.f;
#pragma unroll
    for (int j = 0; j < 8; ++j) s += (v[j][0] + v[j][1]) + (v[j][2] + v[j][3]);
    const float mean = wave_sum(s) * (1.f / DM); float s2 = 0.f;
#pragma unroll
    for (int j = 0; j < 8; ++j) { v[j] = v[j] - mean; s2 += (v[j][0] * v[j][0] + v[j][1] * v[j][1]) + (v[j][2] * v[j][2] + v[j][3] * v[j][3]); }
    const float rstd = 1.f / sqrtf(wave_sum(s2) * (1.f / DM) + LN_EPS);
#pragma unroll
    for (int j = 0; j < 8; ++j) { const int c = 4 * lane + 256 * j; v[j] = v[j] * rstd * *(const f32x4*)(g + c) + *(const f32x4*)(bt + c);
        if (outf) *(f32x4*)(outf + c) = v[j];
        if (outb) *(u32x2*)(outb + c) = pack4(v[j]);
        if (out8) { unsigned w = 0u; w = __builtin_amdgcn_cvt_pk_fp8_f32(v[j][0], v[j][1], w, false); w = __builtin_amdgcn_cvt_pk_fp8_f32(v[j][2], v[j][3], w, true); *(unsigned*)(out8 + c) = w; } }
}

#if PRE_BF16
typedef u32x2 PRE_T;
#define LDPRE(base_, off_) (*(const u32x2*)((const bf16_t*)(base_) + (off_)))
__device__ __forceinline__ f32x4 CVPRE(u32x2 w) { f32x4 r; r[0] = bflo(w.x); r[1] = bfhi(w.x); r[2] = bflo(w.y); r[3] = bfhi(w.y); return r; }
#else
typedef f32x4 PRE_T;
#define LDPRE(base_, off_) (*(const f32x4*)((const float*)(base_) + (off_)))
__device__ __forceinline__ f32x4 CVPRE(f32x4 w) { return w; }
#endif
__device__ __forceinline__ void pf_phase(const Frame& F, const Args& A, int L, bool moe, const float* hin) {
    unsigned char* ws = A.ws; const float* pre = (const float*)(ws + WS_R + R_PRE);
    const float* g = (const float*)A.in[IN_LN1G] + L * DM; const float* bt = (const float*)A.in[IN_LN1B] + L * DM;
    float* hf = (float*)(ws + WS_HF); bf16_t* hb = (bf16_t*)(ws + WS_HB) + (size_t)MTOK * DM;
    LAS float* wr = (LAS float*)F.lds;
    LAS int* cnt = (LAS int*)(F.lds + 65536);
    if (moe) { const float* rw = (const float*)A.in[IN_ROUTER];
        for (int i = F.tid; i < DM * NEXP; i += NTHREADS) { const int d = i >> 3, e = i & 7; wr[e * DM + d] = rw[i]; }
    }
    for (int c = F.vcu; c < MTOK / 64; c += F.G) {
        if (moe) { if (F.tid < 8) cnt[F.tid] = 0; }
        __syncthreads();
        f32x4 na[8]; PRE_T nb[8];
        { const size_t o0 = (size_t)(64 * c + 8 * F.wave) * DM + 4 * F.lane;
#pragma unroll
          for (int q = 0; q < 8; ++q) { na[q] = *(const f32x4*)(hin + o0 + 256 * q); nb[q] = LDPRE(pre, o0 + 256 * q); } }
#pragma unroll 1
        for (int j = 0; j < 8; ++j) {
            const int row = 64 * c + 8 * F.wave + j;
            f32x4 v[8];
#pragma unroll
            for (int q = 0; q < 8; ++q) v[q] = na[q] * ALPHA + CVPRE(nb[q]);
            if (j + 1 < 8) { const size_t o1 = (size_t)(row + 1) * DM + 4 * F.lane;
#pragma unroll
                for (int q = 0; q < 8; ++q) { na[q] = *(const f32x4*)(hin + o1 + 256 * q); nb[q] = LDPRE(pre, o1 + 256 * q); } }
            ln_finish(v, g, bt, RES_BF16 ? nullptr : hf + (size_t)row * DM, (moe && !RES_BF16) ? nullptr : hb + (size_t)row * DM, F.lane, (moe || PLE0_FP8) ? ws + WS_HB8 + (size_t)row * DM : nullptr);
            if (moe) {
                float lg[8];
#pragma unroll
                for (int e = 0; e < 8; ++e) { float s = 0.f;
#pragma unroll
                    for (int q = 0; q < 8; ++q) { const f32x4 w = *(const LAS f32x4*)(wr + e * DM + 4 * F.lane + 256 * q); s += (v[q][0] * w[0] + v[q][1] * w[1]) + (v[q][2] * w[2] + v[q][3] * w[3]); }
                    lg[e] = wave_sum(s) + ((const float*)A.in[IN_ROUTERB])[e]; }
                int i0 = 0; float v0 = lg[0];
#pragma unroll
                for (int e = 1; e < 8; ++e) if (lg[e] > v0) { v0 = lg[e]; i0 = e; }
                int i1 = -1; float v1 = -3.0e38f;
#pragma unroll
                for (int e = 0; e < 8; ++e) if (e != i0 && lg[e] > v1) { v1 = lg[e]; i1 = e; }
                const float e1 = __expf(v1 - v0), w0 = 1.f / (1.f + e1), w1 = e1 * w0;
                if (F.lane == 0) { int* re = (int*)(ws + WS_ROUTE + RT_E); float* rwt = (float*)(ws + WS_ROUTE + RT_W);
                    re[2 * row] = i0; re[2 * row + 1] = i1; rwt[2 * row] = w0; rwt[2 * row + 1] = w1;
                    __hip_atomic_fetch_add(cnt + i0, 1, __ATOMIC_RELAXED, __HIP_MEMORY_SCOPE_WORKGROUP); __hip_atomic_fetch_add(cnt + i1, 1, __ATOMIC_RELAXED, __HIP_MEMORY_SCOPE_WORKGROUP); }
            }
        }
        __syncthreads();
        if (moe && F.tid < 8) ((int*)(ws + WS_ROUTE + RT_CNT))[c * 8 + F.tid] = cnt[F.tid];
    }
}

__device__ __forceinline__ void moe_scatter(const Frame& F, const Args& A) {
    unsigned char* ws = A.ws;
    const int* cntg = (const int*)(ws + WS_ROUTE + RT_CNT); const int* re = (const int*)(ws + WS_ROUTE + RT_E); const float* rwt = (const float*)(ws + WS_ROUTE + RT_W);
    int* toksrow = (int*)(ws + WS_ROUTE + RT_TOKSROW); float* sroww = (float*)(ws + WS_ROUTE + RT_SROWW); int* panel = (int*)(ws + WS_ROUTE + RT_PANEL);
    const bf16_t* hb = (const bf16_t*)(ws + WS_HB) + (size_t)MTOK * DM; unsigned char* hs = ws + WS_R + R_HS;
    LAS int* tot = (LAS int*)F.lds; LAS int* part = tot + 8; LAS int* off = tot + 16; LAS int* ee = tot + 32; LAS int* srow = tot + 160; LAS int* cnt0 = tot + 24;
    for (int c = F.vcu; c < MTOK / 64; c += F.G) {
        { const int e = F.wave; int t = 0, p = 0;
#pragma unroll
          for (int q = 0; q < 4; ++q) { const int cc = 4 * F.lane + q; const int v = cntg[cc * 8 + e]; t += v; p += (cc < c) ? v : 0; }
#pragma unroll
          for (int o = 1; o < 64; o <<= 1) { t += __shfl_xor(t, o); p += __shfl_xor(p, o); }
          if (F.lane == 0) { tot[e] = t; part[e] = p; } }
        if (F.tid < 128) ee[F.tid] = re[128 * c + F.tid];
        __syncthreads();
        if (F.tid == 0) { int o = 0, np = 0;
            for (int e = 0; e < 8; ++e) { off[e] = o; const int npan = (tot[e] + 255) >> 8;
                if (c == 0) for (int q = 0; q < npan; ++q) panel[1 + np + q] = e;
                np += npan; o += npan * 256; }
            if (c == 0) panel[0] = np; }
        __syncthreads();
        int rank_ = 0, e_ = 0;
        if (F.tid < 128) { e_ = ee[F.tid];
#pragma unroll
            for (int k = 0; k < 8; ++k) { const unsigned long long m_ = __ballot(e_ == k); if (e_ == k) rank_ = __popcll(m_ & ((1ull << F.lane) - 1ull)); if (F.tid == 0) cnt0[k] = __popcll(m_); } }
        __syncthreads();
        if (F.tid < 128) { const int e = e_; const int rank = rank_ + (F.tid >= 64 ? cnt0[e] : 0);
            const int sr = off[e] + part[e] + rank; srow[F.tid] = sr; toksrow[128 * c + F.tid] = sr; sroww[sr] = rwt[128 * c + F.tid]; }
        __syncthreads();
        for (int q = 0; q < 16; ++q) { const int ent = F.wave * 16 + q; const int tok = 64 * c + (ent >> 1); const int sr = srow[ent];
            const u32x4* s = (const u32x4*)(ws + WS_HB8 + (size_t)tok * DM); u32x4* d = (u32x4*)(hs + (size_t)sr * DM);
#pragma unroll
            for (int k = 0; k < 2; ++k) d[F.lane + 64 * k] = s[F.lane + 64 * k]; }
        __syncthreads();
    }
}

__device__ __forceinline__ void pi_phase(const Frame& F, const Args& A, int L, bool moe) {
    unsigned char* ws = A.ws;
    const float* g = (const float*)A.in[IN_LN2G] + L * DM; const float* bt = (const float*)A.in[IN_LN2B] + L * DM;
    const bool last = (L == NLAYER - 1);
    float* outf = last ? A.out : (float*)(ws + WS_HF) + (size_t)MTOK * DM; bf16_t* outb = last ? nullptr : (bf16_t*)(ws + WS_HB);
    const int gw = F.vcu * NWAVES + F.wave, NGW = F.G * NWAVES;
    const bf16_t* hb1 = (const bf16_t*)(ws + WS_HB) + (size_t)MTOK * DM; const float* hf1 = (const float*)(ws + WS_HF);
    const float* pre2 = (const float*)(ws + WS_R + R_PRE2); const bf16_t* ple = moe ? (const bf16_t*)(ws + WS_HF + (size_t)MTOK * DM * 4) : (const bf16_t*)(ws + WS_R + R_PLE);
    const int* ts = (const int*)(ws + WS_ROUTE + RT_TOKSROW); const bf16_t* ys = (const bf16_t*)(ws + WS_R + R_YS);
    u32x2 nh[8], np[8], ny0[8], ny1[8]; PRE_T nf[8]; f32x4 nhf[8]; int t0n = 0, t1n = 0;
#define PI_LOAD(row_, i0_, i1_) do { const size_t o_ = (size_t)(row_) * DM + 4 * F.lane; _Pragma("unroll") for (int q = 0; q < 8; ++q) { \
        if (RES_BF16) nh[q] = *(const u32x2*)(hb1 + o_ + 256 * q); else nhf[q] = *(const f32x4*)(hf1 + o_ + 256 * q); \
        np[q] = *(const u32x2*)(ple + o_ + 256 * q); \
        if (!moe) nf[q] = LDPRE(pre2, o_ + 256 * q); \
        else { ny0[q] = *(const u32x2*)(ys + (size_t)(i0_) * DM + 4 * F.lane + 256 * q); ny1[q] = *(const u32x2*)(ys + (size_t)(i1_) * DM + 4 * F.lane + 256 * q); } } } while (0)
    if (gw < MTOK) { if (moe) { t0n = ts[2 * gw]; t1n = ts[2 * gw + 1]; } PI_LOAD(gw, t0n, t1n); if (moe && gw + NGW < MTOK) { t0n = ts[2 * (gw + NGW)]; t1n = ts[2 * (gw + NGW) + 1]; } }
#pragma unroll 1
    for (int row = gw; row < MTOK; row += NGW) {
        f32x4 v[8];
#pragma unroll
        for (int q = 0; q < 8; ++q) { f32x4 h; if (RES_BF16) { h[0] = bflo(nh[q].x); h[1] = bfhi(nh[q].x); h[2] = bflo(nh[q].y); h[3] = bfhi(nh[q].y); } else h = nhf[q];
            f32x4 r; const u32x2 p = np[q];
            if (!moe) { r[0] = bflo(p.x); r[1] = bfhi(p.x); r[2] = bflo(p.y); r[3] = bfhi(p.y); r = CVPRE(nf[q]) + r; }
            else { const u32x2 a = ny0[q], b = ny1[q]; r[0] = (bflo(a.x) + bflo(b.x)) + bflo(p.x); r[1] = (bfhi(a.x) + bfhi(b.x)) + bfhi(p.x); r[2] = (bflo(a.y) + bflo(b.y)) + bflo(p.y); r[3] = (bfhi(a.y) + bfhi(b.y)) + bfhi(p.y); }
            v[q] = h * ALPHA + r; }
        const int nrow = row + NGW;
        if (nrow < MTOK) { PI_LOAD(nrow, t0n, t1n); if (moe && nrow + NGW < MTOK) { t0n = ts[2 * (nrow + NGW)]; t1n = ts[2 * (nrow + NGW) + 1]; } }
        ln_finish(v, g, bt, outf + (size_t)row * DM, outb ? outb + (size_t)row * DM : nullptr, F.lane, last ? nullptr : ws + WS_HB8 + (size_t)row * DM);
    }
#undef PI_LOAD
}

namespace att {
constexpr int TP = 144, TILE_B = 64 * TP, STAGE_B = 2 * TILE_B + 256;
constexpr int L_WS = 2 * STAGE_B;
constexpr int IMP_P = 68;
constexpr int L_IMP = L_WS + 8 * 256;
constexpr int L_SEL = L_IMP + 4 * 64 * IMP_P * 4;
constexpr int L_UID = L_SEL + 512;
static_assert(L_UID + 64 <= RING_BYTES, "attention LDS map");
constexpr int NEGBIG_I = -(1 << 29);
constexpr float NEG_INF = -__builtin_inff();

struct Stream { const bf16_t* K; const bf16_t* VT; const float* bias; int ldk, ldv; };
struct State { float m, l; f32x16 o0, o1; };
__device__ __forceinline__ void state_init(State& S) { S.m = 0.f; S.l = -1.f;
#pragma unroll
    for (int r = 0; r < 16; ++r) { S.o0[r] = 0.f; S.o1[r] = 0.f; } }
__device__ __forceinline__ float swap_max(float v) { auto rr = __builtin_amdgcn_permlane32_swap(__float_as_uint(v), __float_as_uint(v), false, false); return fmaxf(__uint_as_float(rr[0]), __uint_as_float(rr[1])); }
__device__ __forceinline__ float swap_sum(float v) { auto rr = __builtin_amdgcn_permlane32_swap(__float_as_uint(v), __float_as_uint(v), false, false); return __uint_as_float(rr[0]) + __uint_as_float(rr[1]); }

template <bool BIAS>
__device__ __forceinline__ void stage_issue(const Stream& s, int tile, int tid, u32x4& kr, u32x4& vr, f32x4& br) {
    const int row = tid >> 3, ch = tid & 7;
    kr = *(const u32x4*)(s.K + (size_t)(tile * 64 + row) * s.ldk + ch * 8);
    vr = *(const u32x4*)(s.VT + (size_t)row * s.ldv + tile * 64 + ch * 8);
    if (BIAS) { if (tid < 16) br = *(const f32x4*)(s.bias + tile * 64 + tid * 4); }
}
template <bool BIAS>
__device__ __forceinline__ void stage_write(LAS unsigned char* st, int tid, const u32x4& kr, const u32x4& vr, const f32x4& br) {
    const int row = tid >> 3, ch = tid & 7;
    *(LAS u32x4*)(st + row * TP + ch * 16) = kr; *(LAS u32x4*)(st + TILE_B + row * TP + ch * 16) = vr;
    if (BIAS) { if (tid < 16) *(LAS f32x4*)(st + 2 * TILE_B + tid * 16) = br; }
}
template <bool BIAS, int D0A, int D0B>
__device__ __forceinline__ void tile_scores(const LAS unsigned char* st, const bf16x8 (&qf)[4], int kb, int kv_lo, int kv_hi, bool need_lo, bool need_hi, float cinit, f32x16& p0, f32x16& p1, int r32, int hi) {
    const LAS unsigned char* kp = st + r32 * TP + hi * 16;
    bf16x8 kf0[D0B - D0A], kf1[D0B - D0A];
#pragma unroll
    for (int d0 = D0A; d0 < D0B; ++d0) { kf0[d0 - D0A] = *(const LAS bf16x8*)(kp + d0 * 32); kf1[d0 - D0A] = *(const LAS bf16x8*)(kp + 32 * TP + d0 * 32); }
    if (BIAS) {
        const LAS float* bp = (const LAS float*)(st + 2 * TILE_B) + 4 * hi; f32x4 b0[4], b1[4];
#pragma unroll
        for (int g = 0; g < 4; ++g) { b0[g] = *(const LAS f32x4*)(bp + 8 * g); b1[g] = *(const LAS f32x4*)(bp + 32 + 8 * g); }
        LDS_WAIT(); __builtin_amdgcn_sched_barrier(0);
#pragma unroll
        for (int g = 0; g < 4; ++g)
#pragma unroll
            for (int i = 0; i < 4; ++i) { p0[4 * g + i] = cinit - b0[g][i]; p1[4 * g + i] = cinit - b1[g][i]; }
    } else {
#pragma unroll
        for (int r = 0; r < 16; ++r) { p0[r] = cinit; p1[r] = cinit; }
        LDS_WAIT(); __builtin_amdgcn_sched_barrier(0);
    }
#pragma unroll
    for (int d0 = D0A; d0 < D0B; ++d0) { p0 = __builtin_amdgcn_mfma_f32_32x32x16_bf16(kf0[d0 - D0A], qf[d0], p0, 0, 0, 0); p1 = __builtin_amdgcn_mfma_f32_32x32x16_bf16(kf1[d0 - D0A], qf[d0], p1, 0, 0, 0); }
    if (need_hi) { asm volatile("; mask hi" ::: "memory"); const int thr = kv_hi - kb - 4 * hi;
#pragma unroll
        for (int r = 0; r < 16; ++r) { const int c = (r & 3) + 8 * (r >> 2); if (c > thr) p0[r] = NEG_INF; if (c + 32 > thr) p1[r] = NEG_INF; } }
    if (need_lo) { asm volatile("; mask lo" ::: "memory"); const int thr = kv_lo - kb - 4 * hi;
#pragma unroll
        for (int r = 0; r < 16; ++r) { const int c = (r & 3) + 8 * (r >> 2); if (c < thr) p0[r] = NEG_INF; if (c + 32 < thr) p1[r] = NEG_INF; } }
}
constexpr float RESC_THR = 8.0f;
#define MAX3F(a, b, c) __builtin_fmaxf(__builtin_fmaxf((a), (b)), (c))
template <bool BIAS, int D0A, int D0B, bool NOPV = false>
__device__ __forceinline__ void tile_compute(const LAS unsigned char* st, const bf16x8 (&qf)[4], int kb, int kv_lo, int kv_hi, bool need_lo, bool need_hi, float cinit, State& S, LAS float* wsf, int r32, int hi) {
    f32x16 p0, p1;
    tile_scores<BIAS, D0A, D0B>(st, qf, kb, kv_lo, kv_hi, need_lo, need_hi, cinit - S.m, p0, p1, r32, hi);
    __builtin_amdgcn_sched_barrier(0);
    bf16x8 vf0[4], vf1[4];
    if (!NOPV) { const LAS unsigned char* vp_ = st + TILE_B + r32 * TP + hi * 16;
#pragma unroll
        for (int s = 0; s < 4; ++s) { vf0[s] = *(const LAS bf16x8*)(vp_ + s * 32); vf1[s] = *(const LAS bf16x8*)(vp_ + 32 * TP + s * 32); }
        __builtin_amdgcn_sched_barrier(0); }
    float ma = MAX3F(p0[0], p0[1], p1[0]), mb = MAX3F(p0[2], p0[3], p1[1]); ma = MAX3F(ma, p1[2], p1[3]);
#pragma unroll
    for (int r = 4; r < 16; r += 4) { ma = MAX3F(ma, p0[r], p0[r + 1]); mb = MAX3F(mb, p0[r + 2], p0[r + 3]); ma = MAX3F(ma, p1[r], p1[r + 1]); mb = MAX3F(mb, p1[r + 2], p1[r + 3]); }
    const float mx = swap_max(fmaxf(ma, mb));
    const bool fresh = (S.l < 0.f);
    float dl = fresh ? (mx > -1.0e30f ? mx : 0.f) : fmaxf(mx, 0.f);
    const bool move = fresh ? (mx > -1.0e30f) : (dl > RESC_THR);
    if (__any(move)) {
        if (!move) dl = 0.f;
        S.m += dl;
#pragma unroll
        for (int r = 0; r < 16; ++r) { p0[r] -= dl; p1[r] -= dl; }
        const float alpha = fast_exp2(-dl);
        if (fresh) { if (mx > -1.0e30f) S.l = 0.f; } else S.l *= alpha;
        if (!NOPV) {
            if (hi == 0) wsf[r32] = fresh ? 1.f : alpha;
            LDS_WAIT();
#pragma unroll
            for (int g = 0; g < 4; ++g) { const f32x4 a = *(const LAS f32x4*)(wsf + 8 * g + 4 * hi);
#pragma unroll
                for (int i = 0; i < 4; ++i) { S.o0[4 * g + i] *= a[i]; S.o1[4 * g + i] *= a[i]; } }
            LDS_WAIT();
        }
    }
    float sum = 0.f;
#pragma unroll
    for (int r = 0; r < 16; ++r) { p0[r] = fast_exp2(p0[r]); p1[r] = fast_exp2(p1[r]); sum += p0[r] + p1[r]; }
    if (S.l >= 0.f) S.l += sum;
    if (NOPV) return;
    u32x4 pw[4];
#pragma unroll
    for (int k = 0; k < 4; ++k) { pw[0][k] = cvt_pk_bf16(p0[2 * k], p0[2 * k + 1]); pw[1][k] = cvt_pk_bf16(p0[8 + 2 * k], p0[9 + 2 * k]); pw[2][k] = cvt_pk_bf16(p1[2 * k], p1[2 * k + 1]); pw[3][k] = cvt_pk_bf16(p1[8 + 2 * k], p1[9 + 2 * k]); }
    LDS_WAIT(); __builtin_amdgcn_sched_barrier(0);
#pragma unroll
    for (int s = 0; s < 4; ++s) {
        const bf16x8 pa = __builtin_bit_cast(bf16x8, pw[s]);
        S.o0 = __builtin_amdgcn_mfma_f32_32x32x16_bf16(pa, vf0[s], S.o0, 0, 0, 0); S.o1 = __builtin_amdgcn_mfma_f32_32x32x16_bf16(pa, vf1[s], S.o1, 0, 0, 0);
    }
}
__device__ __forceinline__ void seg_finish(const State& S, float gate, float extra_l, f32x16& a0, f32x16& a1, LAS float* wsf, int r32, int hi) {
    const float lt = swap_sum(fmaxf(S.l, 0.f)) + extra_l; const float f = lt > 0.f ? gate / lt : 0.f;
    if (hi == 0) wsf[r32] = f;
    LDS_WAIT();
#pragma unroll
    for (int g = 0; g < 4; ++g) { const f32x4 a = *(const LAS f32x4*)(wsf + 8 * g + 4 * hi);
#pragma unroll
        for (int i = 0; i < 4; ++i) { a0[4 * g + i] += S.o0[4 * g + i] * a[i]; a1[4 * g + i] += S.o1[4 * g + i] * a[i]; } }
    LDS_WAIT();
}
__device__ __forceinline__ void seg_finish_lds(const State& S, float gate, LAS float* accl, bool first, LAS float* wsf, int r32, int hi) {
    const float lt = swap_sum(fmaxf(S.l, 0.f)); const float f = lt > 0.f ? gate / lt : 0.f;
    if (hi == 0) wsf[r32] = f;
    LDS_WAIT();
#pragma unroll
    for (int g = 0; g < 4; ++g) { const f32x4 a = *(const LAS f32x4*)(wsf + 8 * g + 4 * hi);
#pragma unroll
        for (int i = 0; i < 4; ++i) { LAS float* p = accl + (8 * g + 4 * hi + i) * 64 + r32; const float x0 = S.o0[4 * g + i] * a[i], x1 = S.o1[4 * g + i] * a[i];
            if (first) { p[0] = x0; p[32] = x1; } else { p[0] += x0; p[32] += x1; } } }
    LDS_WAIT();
}
template <bool BIAS, bool SEL, bool DUAL, bool NOPV = false>
__device__ __forceinline__ void run_seg(LAS unsigned char* lds, const Stream& s, int t_lo, int t_hi, const bf16x8 (&qf)[4], int kv_lo, int kv_hi, unsigned sel_lo, unsigned sel_hi,
                                        State& S, State& S2, LAS float* wsf, int tid, int r32, int hi) {
    asm volatile("" : "+v"(tid));
    u32x4 kr, vr; f32x4 br = {0.f, 0.f, 0.f, 0.f};
    const int hi_min = __builtin_amdgcn_readlane(kv_hi, 0), hi_max = __builtin_amdgcn_readlane(kv_hi, 31), lo_min = __builtin_amdgcn_readlane(kv_lo, 0), lo_max = __builtin_amdgcn_readlane(kv_lo, 31);
    stage_issue<BIAS>(s, t_lo, tid, kr, vr, br); stage_write<BIAS>(lds, tid, kr, vr, br);
    __syncthreads();
    for (int t = t_lo; t < t_hi; ++t) {
        const int cur = (t - t_lo) & 1; const bool more = (t + 1 < t_hi);
        if (more) stage_issue<BIAS>(s, t + 1, tid, kr, vr, br);
        const int kb = 64 * t;
        bool active = !(kb > hi_max || kb + 63 < lo_min);
        float cinit = 0.f;
        if (SEL) { const unsigned bit = (t < 32) ? ((sel_lo >> t) & 1u) : ((sel_hi >> (t - 32)) & 1u); cinit = bit ? 0.f : NEG_INF; active = active && __any(bit != 0u); }
        if (active) {
            const LAS unsigned char* st = lds + cur * STAGE_B; const bool nlo = kb < lo_max, nhi = kb + 63 > hi_min;
            if (DUAL) { tile_compute<false, 0, 2>(st, qf, kb, kv_lo, kv_hi, nlo, nhi, cinit, S, wsf, r32, hi); tile_compute<false, 2, 4>(st, qf, kb, kv_lo, kv_hi, nlo, nhi, cinit, S2, wsf, r32, hi); }
            else tile_compute<BIAS, 0, 4, NOPV>(st, qf, kb, kv_lo, kv_hi, nlo, nhi, cinit, S, wsf, r32, hi);
        }
        if (more) stage_write<BIAS>(lds + (cur ^ 1) * STAGE_B, tid, kr, vr, br);
        __syncthreads();
    }
}
__device__ __forceinline__ void load_q(bf16x8 (&qf)[4], const bf16_t* qrow, int hi) {
#pragma unroll
    for (int d0 = 0; d0 < 4; ++d0) qf[d0] = *(const bf16x8*)(qrow + d0 * 16 + hi * 8);
}
#if PD_FP8
typedef unsigned char br_t;
__device__ __forceinline__ void store_o(const f32x16& a0, const f32x16& a1, br_t* base, int hi, int r32) {
#pragma unroll
    for (int r = 0; r < 16; ++r) { const int q = (r & 3) + 8 * (r >> 2) + 4 * hi; br_t* p = base + (size_t)q * DM + r32; const unsigned w = __builtin_amdgcn_cvt_pk_fp8_f32(a0[r] * BR8_SCALE, a1[r] * BR8_SCALE, 0u, false); p[0] = (br_t)(w & 0xffu); p[32] = (br_t)((w >> 8) & 0xffu); }
}
#else
typedef bf16_t br_t;
#endif
#if !PD_FP8
__device__ __forceinline__ void store_o(const f32x16& a0, const f32x16& a1, bf16_t* base, int hi, int r32) {
#pragma unroll
    for (int r = 0; r < 16; ++r) { const int q = (r & 3) + 8 * (r >> 2) + 4 * hi; bf16_t* p = base + (size_t)q * DM + r32; p[0] = f2bf(a0[r]); p[32] = f2bf(a1[r]); }
}
#endif

struct Ctx { LAS unsigned char* lds; unsigned char* ws; unsigned char* R; const float* dlam; const float* dgain; const float* sink; int L, tid, lane, wave, r32, hi; LAS float* wsf; };

__device__ __forceinline__ void fox_unit(const Ctx& C, int b, int h, int qb) {
    const int tq = 256 * qb + 32 * C.wave + C.r32;
    bf16x8 qf[4]; load_q(qf, (const bf16_t*)(C.R + R_CQ) + ((size_t)b * SEQ + tq) * 512 + h * 64, C.hi);
    Stream s; s.K = (const bf16_t*)(C.R + R_CK) + (size_t)b * SEQ * 512 + h * 64; s.ldk = 512; s.VT = (const bf16_t*)(C.R + R_CVT) + (size_t)(b * 8 + h) * 64 * SEQ; s.ldv = SEQ;
    s.bias = (const float*)(C.ws + WS_CUM) + (size_t)(b * 8 + h) * SEQ;
    State S; state_init(S);
    run_seg<true, false, false>(C.lds, s, 0, 4 * (qb + 1), qf, NEGBIG_I, tq, 0u, 0u, S, S, C.wsf, C.tid, C.r32, C.hi);
    f32x16 a0, a1;
#pragma unroll
    for (int r = 0; r < 16; ++r) { a0[r] = 0.f; a1[r] = 0.f; }
    seg_finish(S, 1.f, 0.f, a0, a1, C.wsf, C.r32, C.hi);
    store_o(a0, a1, (br_t*)(C.R + R_BR) + ((size_t)b * SEQ + 256 * qb + 32 * C.wave) * DM + 2 * 512 + h * 64, C.hi, C.r32);
}
__device__ __forceinline__ void diff_unit(const Ctx& C, int b, int h, int qb) {
    const int tq = 256 * qb + 32 * C.wave + C.r32;
    bf16x8 qf[4]; load_q(qf, (const bf16_t*)(C.R + R_DQ) + ((size_t)b * SEQ + tq) * 512 + h * 64, C.hi);
    Stream s; s.K = (const bf16_t*)(C.R + R_DK) + (size_t)b * SEQ * 512 + h * 64; s.ldk = 512; s.VT = (const bf16_t*)(C.R + R_DVT) + (size_t)(b * 8 + h) * 64 * SEQ; s.ldv = SEQ; s.bias = nullptr;
    const float* lf = C.dlam + C.L * 128; const int j = C.lane & 31;
    const float sa = wave_sum(C.lane < 32 ? lf[j] * lf[32 + j] : 0.f), sb = wave_sum(C.lane < 32 ? lf[64 + j] * lf[96 + j] : 0.f);
    const float lam_init = C.L == 0 ? 0.2f : 0.35550906759096314f;
    const float lam = __expf(sa) - __expf(sb) + lam_init;
    State S0, S1; state_init(S0); state_init(S1);
    run_seg<false, false, true>(C.lds, s, 0, 4 * (qb + 1), qf, NEGBIG_I, tq, 0u, 0u, S0, S1, C.wsf, C.tid, C.r32, C.hi);
    f32x16 a0, a1;
#pragma unroll
    for (int r = 0; r < 16; ++r) { a0[r] = 0.f; a1[r] = 0.f; }
    seg_finish(S0, 1.f, 0.f, a0, a1, C.wsf, C.r32, C.hi);
    seg_finish(S1, -lam, 0.f, a0, a1, C.wsf, C.r32, C.hi);
    const float* gain = C.dgain + C.L * 64; const float g0 = gain[C.r32] * (1.f - lam_init), g1 = gain[32 + C.r32] * (1.f - lam_init);
#pragma unroll
    for (int r = 0; r < 16; ++r) { float ss = a0[r] * a0[r] + a1[r] * a1[r];
#pragma unroll
        for (int o = 1; o < 32; o <<= 1) ss += __shfl_xor(ss, o);
        const float rs = 1.f / sqrtf(ss * (1.f / 64.f) + LN_EPS); a0[r] = a0[r] * rs * g0; a1[r] = a1[r] * rs * g1; }
    store_o(a0, a1, (br_t*)(C.R + R_BR) + ((size_t)b * SEQ + 256 * qb + 32 * C.wave) * DM + 3 * 512 + h * 64, C.hi, C.r32);
}
__device__ __forceinline__ void swa_unit(const Ctx& C, int b, int kvh, int tt) {
    const int g = C.wave & 3, sub = C.wave >> 2, hq = kvh * 4 + g; const int tq = 64 * tt + 32 * sub + C.r32;
    bf16x8 qf[4]; load_q(qf, (const bf16_t*)(C.R + R_BQ) + ((size_t)b * SEQ + tq) * 512 + hq * 64, C.hi);
    Stream s; s.K = (const bf16_t*)(C.R + R_BK) + (size_t)b * SEQ * 128 + kvh * 64; s.ldk = 128; s.VT = (const bf16_t*)(C.R + R_BVT) + (size_t)(b * 2 + kvh) * 64 * SEQ; s.ldv = SEQ; s.bias = nullptr;
    State S; state_init(S);
    run_seg<false, false, false>(C.lds, s, tt >= 2 ? tt - 2 : 0, tt + 1, qf, tq - 127, tq, 0u, 0u, S, S, C.wsf, C.tid, C.r32, C.hi);
    const float sink2 = C.sink[C.L * 8 + hq] * LOG2E;
    f32x16 a0, a1;
#pragma unroll
    for (int r = 0; r < 16; ++r) { a0[r] = 0.f; a1[r] = 0.f; }
    seg_finish(S, 1.f, fast_exp2(sink2 - S.m), a0, a1, C.wsf, C.r32, C.hi);
    store_o(a0, a1, (br_t*)(C.R + R_BR) + ((size_t)b * SEQ + 64 * tt + 32 * sub) * DM + 1 * 512 + hq * 64, C.hi, C.r32);
}
__device__ __forceinline__ void nsa_unit(const Ctx& C, int b, int kvh, int tt) {
    const int g = C.wave & 3, sub = C.wave >> 2, hq = kvh * 4 + g; const int tq = 64 * tt + 32 * sub + C.r32;
    const int tid = C.tid, r32 = C.r32, hi = C.hi;
    bf16x8 qf[4]; load_q(qf, (const bf16_t*)(C.R + R_AQ) + ((size_t)b * SEQ + tq) * 512 + hq * 64, hi);
    LAS float* tbl = (LAS float*)(C.lds + L_IMP); LAS unsigned* selw = (LAS unsigned*)(C.lds + L_SEL);
    LAS float* accl = tbl + C.wave * 2048;
    unsigned char* wsb; { unsigned long long x_ = (unsigned long long)C.ws; asm volatile("" : "+s"(x_)); wsb = (unsigned char*)(GAS unsigned char*)x_; }
    Stream sc; sc.K = (const bf16_t*)(wsb + WS_KC) + (size_t)(b * 2 + kvh) * 256 * 64; sc.ldk = 64; sc.VT = (const bf16_t*)(wsb + WS_VCT) + (size_t)(b * 2 + kvh) * 64 * 256; sc.ldv = 256; sc.bias = nullptr;
    const int kvhi_c = (tq - 31) >> 4; const int ntc = ((4 * tt + 2) >> 6) + 1;
    State S; state_init(S);
    run_seg<false, false, false>(C.lds, sc, 0, ntc, qf, NEGBIG_I, kvhi_c, 0u, 0u, S, S, C.wsf, tid, r32, hi);
    const float m1 = S.m; const float l1 = swap_sum(fmaxf(S.l, 0.f)); const float rl1 = l1 > 0.f ? 1.f / l1 : 0.f;
    for (int i = tid; i < 4 * 64 * IMP_P; i += NTHREADS) tbl[i] = 0.f;
    {
        int tid2 = C.tid; asm volatile("" : "+v"(tid2));
        u32x4 kr, vr; f32x4 br = {0.f, 0.f, 0.f, 0.f};
        const int hi_min = __builtin_amdgcn_readlane(kvhi_c, 0), hi_max = __builtin_amdgcn_readlane(kvhi_c, 31);
        stage_issue<false>(sc, 0, tid2, kr, vr, br); stage_write<false>(C.lds, tid2, kr, vr, br);
        __syncthreads();
        LAS float* trow = tbl + (g * 64 + 32 * sub + r32) * IMP_P;
        for (int t = 0; t < ntc; ++t) {
            const int cur = t & 1; const bool more = (t + 1 < ntc);
            if (more) stage_issue<false>(sc, t + 1, tid2, kr, vr, br);
            const int kb = 64 * t;
            if (kb <= hi_max) {
                f32x16 p0, p1;
                tile_scores<false, 0, 4>(C.lds + cur * STAGE_B, qf, kb, NEGBIG_I, kvhi_c, false, kb + 63 > hi_min, 0.f, p0, p1, r32, hi);
#pragma unroll
                for (int r = 0; r < 16; ++r) { p0[r] = fast_exp2(p0[r] - m1) * rl1; p1[r] = fast_exp2(p1[r] - m1) * rl1; }
#pragma unroll
                for (int g4 = 0; g4 < 4; ++g4) {
                    const float x0 = 2.f * ((p0[4 * g4] + p0[4 * g4 + 1]) + p0[4 * g4 + 2]) + p0[4 * g4 + 3], x1 = 2.f * ((p1[4 * g4] + p1[4 * g4 + 1]) + p1[4 * g4 + 2]) + p1[4 * g4 + 3];
                    const int j = 16 * t + 2 * g4 + hi;
                    __hip_atomic_fetch_add(trow + j, x0, __ATOMIC_RELAXED, __HIP_MEMORY_SCOPE_WORKGROUP); __hip_atomic_fetch_add(trow + j + 8, x1, __ATOMIC_RELAXED, __HIP_MEMORY_SCOPE_WORKGROUP);
                    asm volatile("" ::: "memory");
                    __hip_atomic_fetch_add(trow + j + 1, p0[4 * g4 + 3], __ATOMIC_RELAXED, __HIP_MEMORY_SCOPE_WORKGROUP); __hip_atomic_fetch_add(trow + j + 9, p1[4 * g4 + 3], __ATOMIC_RELAXED, __HIP_MEMORY_SCOPE_WORKGROUP);
                    asm volatile("" ::: "memory");
                }
            }
            if (more) stage_write<false>(C.lds + (cur ^ 1) * STAGE_B, tid2, kr, vr, br);
            __syncthreads();
        }
    }
    {
        const int tok = tid >> 3, part = tid & 7; LAS float* t0 = tbl + tok * IMP_P;
        float my[8];
#pragma unroll
        for (int jj = 0; jj < 8; ++jj) { const int j = 8 * part + jj; float v = ((t0[j] + t0[64 * IMP_P + j]) + t0[2 * 64 * IMP_P + j]) + t0[3 * 64 * IMP_P + j];
            if (j == 0 || j == tt || j == tt - 1) v = 1.0e9f; else if (j > tt) v = -1.0e9f; my[jj] = v; }
        __syncthreads();
#pragma unroll
        for (int jj = 0; jj < 8; ++jj) t0[8 * part + jj] = my[jj];
        __syncthreads();
        int cnt[8];
#pragma unroll
        for (int jj = 0; jj < 8; ++jj) cnt[jj] = 0;
        for (int k4 = 0; k4 < 16; ++k4) { const f32x4 x = *(const LAS f32x4*)(t0 + 4 * k4);
#pragma unroll
            for (int i = 0; i < 4; ++i) { const int k = 4 * k4 + i;
#pragma unroll
                for (int jj = 0; jj < 8; ++jj) { const int j = 8 * part + jj; cnt[jj] += (x[i] > my[jj] || (x[i] == my[jj] && k < j)) ? 1 : 0; } } }
        unsigned bits = 0u;
#pragma unroll
        for (int jj = 0; jj < 8; ++jj) bits |= (cnt[jj] < 16 ? 1u : 0u) << jj;
        unsigned wlo = part < 4 ? bits << (8 * part) : 0u, whi = part >= 4 ? bits << (8 * (part - 4)) : 0u;
#pragma unroll
        for (int o = 1; o < 8; o <<= 1) { wlo |= __shfl_xor(wlo, o); whi |= __shfl_xor(whi, o); }
        if (part == 0) { selw[2 * tok] = wlo; selw[2 * tok + 1] = whi; }
        __syncthreads();
    }
    const float* gp = (const float*)(C.ws + WS_GA) + ((size_t)b * SEQ + tq) * 32 + hq * 3;
    seg_finish_lds(S, gp[0], accl, true, C.wsf, r32, hi);
    {
        const unsigned sel_lo = selw[2 * (32 * sub + r32)], sel_hi = selw[2 * (32 * sub + r32) + 1];
        unsigned char* Rb; { unsigned long long x_ = (unsigned long long)C.R; asm volatile("" : "+s"(x_)); Rb = (unsigned char*)(GAS unsigned char*)x_; }
        Stream ss; ss.K = (const bf16_t*)(Rb + R_AKS) + (size_t)b * SEQ * 128 + kvh * 64; ss.ldk = 128; ss.VT = (const bf16_t*)(Rb + R_AVST) + (size_t)(b * 2 + kvh) * 64 * SEQ; ss.ldv = SEQ; ss.bias = nullptr;
        state_init(S);
        run_seg<false, true, false>(C.lds, ss, 0, tt + 1, qf, NEGBIG_I, tq, sel_lo, sel_hi, S, S, C.wsf, tid, r32, hi);
        seg_finish_lds(S, gp[1], accl, false, C.wsf, r32, hi);
    }
    {
        unsigned char* Rb; { unsigned long long x_ = (unsigned long long)C.R; asm volatile("" : "+s"(x_)); Rb = (unsigned char*)(GAS unsigned char*)x_; }
        Stream sw; sw.K = (const bf16_t*)(Rb + R_AKW) + (size_t)b * SEQ * 128 + kvh * 64; sw.ldk = 128; sw.VT = (const bf16_t*)(Rb + R_AVWT) + (size_t)(b * 2 + kvh) * 64 * SEQ; sw.ldv = SEQ; sw.bias = nullptr;
        state_init(S);
        run_seg<false, false, false>(C.lds, sw, tt >= 8 ? tt - 8 : 0, tt + 1, qf, tq - 511, tq, 0u, 0u, S, S, C.wsf, tid, r32, hi);
        seg_finish_lds(S, gp[2], accl, false, C.wsf, r32, hi);
    }
    { unsigned char* Rb; { unsigned long long x_ = (unsigned long long)C.R; asm volatile("" : "+s"(x_)); Rb = (unsigned char*)(GAS unsigned char*)x_; }
      br_t* ob = (br_t*)(Rb + R_BR) + ((size_t)b * SEQ + 64 * tt + 32 * sub) * DM + 0 * 512 + hq * 64;
#pragma unroll
      for (int i = 0; i < 4; ++i) { const int row = 8 * i + (C.lane >> 3), ch = C.lane & 7; const f32x4 x0 = *(const LAS f32x4*)(accl + row * 64 + ch * 8), x1 = *(const LAS f32x4*)(accl + row * 64 + ch * 8 + 4);
#if PD_FP8
          *(u32x2*)(ob + (size_t)row * DM + ch * 8) = pack8_fp8(x0 * BR8_SCALE, x1 * BR8_SCALE); } }
#else
          *(u32x4*)(ob + (size_t)row * DM + ch * 8) = pack8(x0, x1); } }
#endif
    __syncthreads();
}
constexpr int CONV_ITEMS_PER_MAT = (DM / 128) * (DFE / 64), CONV_BATCHES = 12 * CONV_ITEMS_PER_MAT / 32;
__device__ __forceinline__ void conv_batch(LAS unsigned char* lds0, const Args& A, int L, int batch, int wave, int lane) {
    LAS unsigned char* scr = lds0 + wave * 9216;
#pragma unroll 1
    for (int j = 0; j < 4; ++j) {
        const int item = batch * 32 + wave * 4 + j; const int mat = item / CONV_ITEMS_PER_MAT, local = item - mat * CONV_ITEMS_PER_MAT; const int e = 4 * L + mat / 3, which = mat - (mat / 3) * 3;
        TrSeg s; s.item0 = 0; s.pad = 0; s.aoff = 0;
        if (which < 2) { s.W = (const float*)A.in[which == 0 ? IN_MWG : IN_MWU] + (size_t)e * DM * DFE; s.ldw = DFE; s.K = DM; s.ncols = DFE; s.WT = (bf16_t*)(A.ws + WS_WMGU + (size_t)e * 2 * DFE * DM); s.ldt = DM; s.kind = MAP_GU; s.vbase = which * 128; s.f8scale = MOE_WGU_SCALE; }
        else { s.W = (const float*)A.in[IN_MWD] + (size_t)e * DFE * DM; s.ldw = DM; s.K = DFE; s.ncols = DM; s.WT = (bf16_t*)(A.ws + WS_WMD + (size_t)e * DM * DFE); s.ldt = DFE; s.kind = MAP_PLAIN; s.vbase = 0; s.f8scale = MOE_WD_SCALE; }
        tr_item_f8(s, local, scr, lane);
    }
}
constexpr int DEF_ITEMS = 3 * (DM / 64) * (DFF / 64) + (4 * 8 * 32 + 32 * 32 + 4 * 32 + 32 * 32) + (80 * 32 + 128 * 32 + 2 * 128 + 4 * 8 * 32 + 32 * 32 + 4 * 32 + 32 * 32), SMALL_BATCHES = (DEF_ITEMS + 31) / 32;
__device__ __forceinline__ void conv_small(LAS unsigned char* lds0, const Args& A, int batch, int wave, int lane) {
    LAS unsigned char* scr = lds0 + wave * 9216;
    const int* gh = (const int*)(A.ws + WS_CTL + DEFTAB_OFF); const TrSeg* gtab = (const TrSeg*)(gh + 4);
    const int nseg = gh[0], nitems = gh[1];
    int si = 0;
#pragma unroll 1
    for (int j = 0; j < 4; ++j) {
        const int item = batch * 32 + wave * 4 + j; if (item >= nitems) break;
        while (si + 1 < nseg && item >= gtab[si + 1].item0) ++si;
        const TrSeg* t = gtab + si; TrSeg s; s.W = t->W; s.WT = t->WT; s.ldw = t->ldw; s.K = t->K; s.ncols = t->ncols; s.ldt = t->ldt; s.kind = t->kind; s.vbase = t->vbase; s.aoff = t->aoff; s.item0 = t->item0; s.f8scale = t->f8scale; s.pad = 0;
        tr_item(s, item - s.item0, scr, lane);
    }
}
constexpr int NUNITS = 2048, NPB = NB * 8 + 256, QLEN = NPB + NUNITS + CONV_BATCHES;
#ifndef ATT_MASK
#define ATT_MASK 15
#endif
#define ATT_CTX() Ctx C; { int t_ = wave0 * 64 + lane_id(); asm volatile("" : "+v"(t_)); C.tid = t_; C.lane = t_ & 63; C.wave = __builtin_amdgcn_readfirstlane(t_ >> 6); C.r32 = C.lane & 31; C.hi = C.lane >> 5; \
      unsigned l_ = 0u; asm volatile("" : "+s"(l_)); C.lds = lds0 + l_; unsigned long long w_ = (unsigned long long)A.ws; asm volatile("" : "+s"(w_)); C.ws = (unsigned char*)(GAS unsigned char*)w_; C.R = C.ws + WS_R; \
      C.dlam = (const float*)A.in[IN_DLAM]; C.dgain = (const float*)A.in[IN_DGAIN]; C.sink = (const float*)A.in[IN_SINK]; C.L = L; C.wsf = (LAS float*)(C.lds + L_WS) + C.wave * 64; }
#define ATT_FETCH() do { if (wave0 == 0 && lane_id() == 0) uidp[0] = (int)__hip_atomic_fetch_add(qhead, 1u, __ATOMIC_RELAXED, __HIP_MEMORY_SCOPE_AGENT); __syncthreads(); pos = uidp[0]; __syncthreads(); } while (0)
#define ATT_NEXT_FROM(have) do { bool have_ = (have); const int cb_ = (L == 0) ? CONV_BATCHES + SMALL_BATCHES : CONV_BATCHES, per_ = (L == 0) ? 2 : 4; for (;;) { if (!have_) ATT_FETCH(); have_ = false; const int p_ = pos - NPB; \
      if (p_ >= NUNITS + cb_) { id = NUNITS; break; } \
      if (p_ < per_ * cb_) { const int q_ = p_ / per_, r_ = p_ - q_ * per_; \
          if (r_ == per_ - 1) { if (L == 0 && q_ < SMALL_BATCHES) conv_small(lds0, A, q_, wave0, lane_id()); else conv_batch(lds0, A, L, L == 0 ? q_ - SMALL_BATCHES : q_, wave0, lane_id()); __syncthreads(); continue; } \
          id = (per_ - 1) * q_ + r_; break; } \
      id = p_ - cb_; break; } } while (0)
#define ATT_NEXT() ATT_NEXT_FROM(false)
__device__ __forceinline__ void attn_phase(const Frame& F, const Args& A, int L, int rep) {
    LAS unsigned char* lds0 = F.lds; const int wave0 = F.wave;
    LAS int* uidp = (LAS int*)(lds0 + L_UID);
    unsigned* qhead = (unsigned*)(A.ws + WS_CTL) + CW_ATTQ + 64 * L + 128 * rep;
    unsigned* pbdone = (unsigned*)(A.ws + WS_CTL) + CW_PBDONE + 64 * L + 128 * rep;
    int pos, id; ATT_FETCH();
    while (pos < NPB) {
        pb_item(F, A, L, pos);
        asm volatile("s_waitcnt vmcnt(0)" ::: "memory"); __syncthreads();
        if (wave0 == 0 && lane_id() == 0) { __builtin_amdgcn_fence(__ATOMIC_RELEASE, "agent"); asm volatile("s_waitcnt vmcnt(0)" ::: "memory"); (void)__hip_atomic_fetch_add(pbdone, 1u, __ATOMIC_RELAXED, __HIP_MEMORY_SCOPE_AGENT); }
        ATT_FETCH();
    }
    ATT_NEXT_FROM(true);
    { ATT_CTX(); while (id < 512) { if (ATT_MASK & 1) diff_unit(C, (id & 31) >> 3, id & 7, 15 - (id >> 5)); ATT_NEXT(); } }
    { if (wave0 == 0 && lane_id() == 0) { unsigned sp = 0u; while (__hip_atomic_load(pbdone, __ATOMIC_RELAXED, __HIP_MEMORY_SCOPE_AGENT) < (unsigned)NPB) { __builtin_amdgcn_s_sleep(2); if (++sp > (1u << 22)) break; }
          __builtin_amdgcn_fence(__ATOMIC_ACQUIRE, "agent"); asm volatile("s_waitcnt vmcnt(0)" ::: "memory"); }
      __syncthreads(); }
    { ATT_CTX(); while (id < 1024) { const int q = id - 512; if (ATT_MASK & 2) fox_unit(C, (q & 31) >> 3, q & 7, 15 - (q >> 5)); ATT_NEXT(); } }
    { ATT_CTX(); while (id < 1536) { const int q = id - 1024; if (ATT_MASK & 4) nsa_unit(C, (q & 7) >> 1, q & 1, 63 - (q >> 3)); ATT_NEXT(); } }
    { ATT_CTX(); while (id < 2048) { const int q = id - 1536; if (ATT_MASK & 8) swa_unit(C, (q & 7) >> 1, q & 1, q >> 3); ATT_NEXT(); } }
}
}

constexpr int NPHASE = 20;
__device__ __forceinline__ Args load_args() {
    Args a;
#if defined(__HIP_DEVICE_COMPILE__)
    const unsigned long long __attribute__((address_space(4)))* kp = (const unsigned long long __attribute__((address_space(4)))*)__builtin_amdgcn_kernarg_segment_ptr(); asm volatile("" : "+s"(kp));
#pragma unroll
    for (int i = 0; i < 28; ++i) a.in[i] = (const void*)(const GAS void*)kp[i];
    a.out = (float*)(GAS float*)kp[28]; a.ws = (unsigned char*)(GAS unsigned char*)kp[29]; const unsigned long long w = kp[30]; a.ph_lo = (int)(unsigned)w; a.ph_hi = (int)(unsigned)(w >> 32);
#else
    for (int i = 0; i < 28; ++i) a.in[i] = nullptr; a.out = nullptr; a.ws = nullptr; a.ph_lo = 0; a.ph_hi = 0;
#endif
    return a;
}
static_assert(sizeof(Args) == 31 * 8, "Args layout");
#ifndef KMASK
#define KMASK 0xffff
#endif
#define KEN(kind) (KIND < 0 ? (((KMASK) >> (kind)) & 1) != 0 : KIND == (kind))
#define PHASE_ENV() \
    Frame F; { int t_ = wave_s * 64 + lane_id(); asm volatile("" : "+v"(t_)); F.tid = t_; F.lane = t_ & 63; F.wave = __builtin_amdgcn_readfirstlane(t_ >> 6); \
      unsigned l_ = 0u; asm volatile("" : "+s"(l_)); F.lds = (LAS unsigned char*)lds_raw + l_; F.G = gridDim.x; const int bx_ = blockIdx.x; F.vcu = (F.G % 8 == 0) ? (bx_ % 8) * (F.G / 8) + bx_ / 8 : bx_; } \
    const Args args = load_args(); \
    unsigned char* ws = args.ws; unsigned char* R = ws + WS_R; const int c = (int)blockIdx.x; (void)R; (void)c; \
    const float* hin = (L == 0) ? (const float*)args.in[IN_X] : (const float*)(ws + WS_HF) + (size_t)MTOK * DM; (void)hin; \
    const bf16_t* hbin = (const bf16_t*)(ws + WS_HB); (void)hbin; const bf16_t* hb1 = (const bf16_t*)(ws + WS_HB) + (size_t)MTOK * DM; (void)hb1;

#if MK_PER_PHASE
#define GRID_BAR() do { } while (0)
#else
#define GRID_BAR() do { XcdBarrier b_ = bar; { unsigned long long p_ = (unsigned long long)b_.bar; asm volatile("" : "+s"(p_)); b_.bar = (unsigned*)(GAS unsigned*)p_; } xcd_barrier_impl(b_.bar, b_.x, b_.st); } while (0)
#endif
#if MK_PER_PHASE
#define IN(k) (lo <= (k) && (k) < hi)
#else
#define IN(k) true
#endif
#define SEAM(k) do { if (IN(k) && IN((k) + 1)) GRID_BAR(); } while (0)
#ifndef REPEAT_KIND
#define REPEAT_KIND -1
#endif
#define REP(kind) for (int rep_ = 0; rep_ < ((REPEAT_KIND == (kind)) ? 2 : 1); ++rep_)


template <int KIND, int L> __device__ __forceinline__ void layer_phases(const int lo, const int hi, const XcdBarrier bar, const int wave_s) {
    extern __shared__ __attribute__((aligned(16))) unsigned char lds_raw[];
    (void)lo; (void)hi; (void)bar;
        const int base = 1 + 9 * L;
        if (KEN(1) && IN(base + 0)) REP(1) { if (rep_) GRID_BAR();
            { PHASE_ENV(); small_gates(F, hbin, (const bf16_t*)(ws + WS_WS + L * SZ_WS), (const float*)args.in[IN_FOXB] + L * 8, (float*)(ws + WS_GA)); }
            { PHASE_ENV();
#if QKV_FP8
              pg8::StaticOrder8 S{ws + WS_HB8, ws + WS_WA + L * SZ_WA, DM, DM, MTOK / 256, 20, F.G, c};
              EpiA E{R, (const float*)(ws + WS_ROPE64), (const float*)(ws + WS_ROPE32), 1.f / WA_SCALE};
              pg8::gemm_phase<EpiA, pg8::StaticOrder8, true>(F.lds, F.tid, DM, DM, DM, S, E); }
#else
              pg8::StaticOrder S{hbin, (const bf16_t*)(ws + WS_WA + L * SZ_WA), DM, DM, MTOK / 256, 20, F.G, c};
              EpiA E{R, (const float*)(ws + WS_ROPE64), (const float*)(ws + WS_ROPE32), 1.f};
              pg8::gemm_phase(F.lds, F.tid, DM, DM, DM, S, E); }
#endif
            { PHASE_ENV();
              pg8::StaticOrder8 S{ws + WS_HB8, ws + WS_WAG8 + L * SZ_WAG8, DM, DM, MTOK / 256, 8192 / 256, F.G, c};
              EpiGate8 E{R + R_GATES, 1.f / GATE_W_SCALE};
              pg8::gemm_phase<EpiGate8, pg8::StaticOrder8, true>(F.lds, F.tid, DM, DM, DM, S, E); }
        }
        SEAM(base + 0);
        if (KEN(3) && IN(base + 2)) REP(3) { if (rep_) GRID_BAR(); PHASE_ENV(); att::attn_phase(F, args, L, rep_); }
        SEAM(base + 2);
        if (KEN(4) && IN(base + 3)) REP(4) { if (rep_) GRID_BAR(); PHASE_ENV();
            pg8::MergeOrder S{(const bf16_t*)(R + R_BR), (const bf16_t*)(ws + WS_WB + L * SZ_WB), F.G, c};
#if MERGE_CHAIN
#if PD_FP8
            pg8::MergeOrder8 S8{R + R_BR, ws + WS_WB + L * SZ_WB, F.G, c};
            EpiMergeChain E{R + R_GATES, R + R_MERGED8, 1.f / (BR8_SCALE * WB_SCALE)};
            pg8::gemm_phase<EpiMergeChain, pg8::MergeOrder8, true, true>(F.lds, F.tid, 512, DM, 512, S8, E);
#else
            EpiMergeChain E{R + R_GATES, R + R_MERGED8, 1.f};
            pg8::gemm_phase<EpiMergeChain, pg8::MergeOrder, false, true>(F.lds, F.tid, 512, DM, 512, S, E);
#endif
#else
            EpiMerge E{R + R_GATES, (bf16_t*)(R + R_MERGED), R + R_MERGED8};
            pg8::gemm_phase(F.lds, F.tid, 512, DM, 512, S, E);
#endif
        }
        SEAM(base + 3);
        if (KEN(5) && IN(base + 4)) { PHASE_ENV();
            pg8::StaticOrder8 S{R + R_MERGED8, ws + WS_WO + L * SZ_WO, DM, DM, MTOK / 256, DM / 256, F.G, c};
#if PRE_BF16
            EpiBf16S E{(bf16_t*)(R + R_PRE), 1.f / (WO_SCALE * MERGED8_SCALE)};
            pg8::gemm_phase<EpiBf16S, pg8::StaticOrder8, true>(F.lds, F.tid, DM, DM, DM, S, E);
#else
            EpiF32 E{(float*)(R + R_PRE), 1.f / (WO_SCALE * MERGED8_SCALE)};
            pg8::gemm_phase<EpiF32, pg8::StaticOrder8, true>(F.lds, F.tid, DM, DM, DM, S, E);
#endif
        }
        SEAM(base + 4);
        if (KEN(6) && IN(base + 5)) REP(6) { if (rep_) GRID_BAR(); PHASE_ENV(); pf_phase(F, args, L, L == 1, hin); }
        SEAM(base + 5);
        if (L == 0) {
            if (KEN(7) && IN(base + 6)) {
#if DENSE_DOWN_FP8
                { PHASE_ENV(); for (int i = F.vcu * NTHREADS + F.tid; i < MTOK * 8; i += F.G * NTHREADS) *(u32x4*)(R + R_ACT + (size_t)(i >> 3) * DFF8 + DFF + (i & 7) * 16) = (u32x4){0u, 0u, 0u, 0u}; }
#endif
                { PHASE_ENV(); pg8::StaticOrder S{hb1, (const bf16_t*)(ws + WS_WFGU), DM, DM, MTOK / 256, 2 * DFF / 256, F.G, c};
#if DENSE_DOWN_FP8
                  EpiSwigluF8 E{R + R_ACT, DFF8, 1.f};
#else
                  EpiSwiglu E{(bf16_t*)(R + R_ACT), DFF};
#endif
                  pg8::gemm_phase(F.lds, F.tid, DM, DM, DM, S, E); }
                { PHASE_ENV(); pg8::StaticOrder S{(const bf16_t*)(ws + WS_PB16) + (size_t)L * MTOK * PLE, (const bf16_t*)(ws + WS_WPP + L * SZ_WPP), PLE, PLE, MTOK / 256, DM / 256, F.G, c}; EpiBf16 E{(bf16_t*)(R + R_PTMP)}; int kp = PLE; asm volatile("" : "+s"(kp)); pg8::gemm_phase(F.lds, F.tid, kp, PLE, PLE, S, E); }
#if PLE0_FP8
                { PHASE_ENV(); pg8::StaticOrder8 S{ws + WS_HB8, ws + WS_WPG + L * SZ_WPG, DM, DM, MTOK / 256, DM / 256, F.G, c}; EpiPleGate E{(const bf16_t*)(R + R_PTMP), (bf16_t*)(R + R_PLE), 1.f / PG_SCALE}; pg8::gemm_phase<EpiPleGate, pg8::StaticOrder8, true>(F.lds, F.tid, DM, DM, DM, S, E); }
#else
                { PHASE_ENV(); pg8::StaticOrder S{hb1, (const bf16_t*)(ws + WS_WPG + L * SZ_WPG), DM, DM, MTOK / 256, DM / 256, F.G, c}; EpiPleGate E{(const bf16_t*)(R + R_PTMP), (bf16_t*)(R + R_PLE), 1.f}; pg8::gemm_phase(F.lds, F.tid, DM, DM, DM, S, E); }
#endif
            }
            SEAM(base + 6);
            if (KEN(8) && IN(base + 7)) { PHASE_ENV();
#if DENSE_DOWN_FP8
                pg8::StaticOrder8 S{R + R_ACT, ws + WS_WFD, DFF8, DFF8, MTOK / 256, DM / 256, F.G, c};
                EpiF32 E{(float*)(R + R_PRE2), 1.f / WFD_SCALE};
                pg8::gemm_phase<EpiF32, pg8::StaticOrder8, true>(F.lds, F.tid, DFF8, DFF8, DFF8, S, E);
#else
                pg8::StaticOrder S{(const bf16_t*)(R + R_ACT), (const bf16_t*)(ws + WS_WFD), DFF, DFF, MTOK / 256, DM / 256, F.G, c};
#if PRE_BF16
                EpiBf16S E{(bf16_t*)(R + R_PRE2), 1.f};
#else
                EpiF32 E{(float*)(R + R_PRE2), 1.f};
#endif
                pg8::gemm_phase(F.lds, F.tid, DFF, DFF, DFF, S, E);
#endif
            }
            SEAM(base + 7);
            if (KEN(9) && IN(base + 8)) { PHASE_ENV(); pi_phase(F, args, L, false); }
            SEAM(base + 8);
        } else {
            if (KEN(10) && IN(base + 6)) {
                { PHASE_ENV(); moe_scatter(F, args); }
                { PHASE_ENV(); bf16_t* ptmp = (bf16_t*)(ws + WS_HF + (size_t)MTOK * DM * 4) + (size_t)MTOK * DM;
                  pg8::StaticOrder S{(const bf16_t*)(ws + WS_PB16) + (size_t)L * MTOK * PLE, (const bf16_t*)(ws + WS_WPP + L * SZ_WPP), PLE, PLE, MTOK / 256, DM / 256, F.G, c}; EpiBf16 E{ptmp}; int kp = PLE; asm volatile("" : "+s"(kp)); pg8::gemm_phase(F.lds, F.tid, kp, PLE, PLE, S, E); }
                { PHASE_ENV(); bf16_t* ple = (bf16_t*)(ws + WS_HF + (size_t)MTOK * DM * 4); bf16_t* ptmp = ple + (size_t)MTOK * DM;
                  pg8::StaticOrder8 S{ws + WS_HB8, ws + WS_WPG + L * SZ_WPG, DM, DM, MTOK / 256, DM / 256, F.G, c}; EpiPleGate E{ptmp, ple, 1.f / PG_SCALE}; pg8::gemm_phase<EpiPleGate, pg8::StaticOrder8, true>(F.lds, F.tid, DM, DM, DM, S, E); }
            }
            SEAM(base + 6);
            if (KEN(11) && IN(base + 7)) REP(11) { if (rep_) GRID_BAR(); PHASE_ENV(); const int* panel = (const int*)(ws + WS_ROUTE + RT_PANEL);
                pg8::MoeOrder S{R + R_HS, ws + WS_WMGU, panel, DM, DM, 2 * DFE / 256, F.G, c}; EpiSwigluF8 E{R + R_ACTS, DFE, 1.f / MOE_WGU_SCALE};
                pg8::gemm_phase<EpiSwigluF8, pg8::MoeOrder, true>(F.lds, F.tid, DM, DM, DM, S, E);
            }
            SEAM(base + 7);
            if (KEN(12) && IN(base + 8)) REP(12) { if (rep_) GRID_BAR(); PHASE_ENV(); const int* panel = (const int*)(ws + WS_ROUTE + RT_PANEL);
                pg8::MoeOrder S{R + R_ACTS, ws + WS_WMD, panel, DFE, DFE, DM / 256, F.G, c}; EpiMoeDown E{(const float*)(ws + WS_ROUTE + RT_SROWW), (bf16_t*)(R + R_YS), 1.f / MOE_WD_SCALE};
                pg8::gemm_phase<EpiMoeDown, pg8::MoeOrder, true>(F.lds, F.tid, DFE, DFE, DFE, S, E);
            }
            SEAM(base + 8);
            if (KEN(13) && IN(base + 9)) { PHASE_ENV(); pi_phase(F, args, L, true); }
        }
}

template <int KIND> __global__ void __launch_bounds__(NTHREADS, 2) mk_fwd(Args args0) {
    extern __shared__ __attribute__((aligned(16))) unsigned char lds_raw[];
    const int wave_s = __builtin_amdgcn_readfirstlane((int)threadIdx.x >> 6);
    for (int u = threadIdx.x; u < 64; u += NTHREADS) ((LAS unsigned*)((LAS unsigned char*)lds_raw + RING_BYTES))[u + 64] = 0u;
    __syncthreads();
    const int lo = args0.ph_lo, hi = args0.ph_hi; (void)lo; (void)hi;
#if !MK_PER_PHASE
    XcdBarrier bar = xcd_barrier_post((unsigned*)(args0.ws + WS_CTL) + CW_BAR, (volatile LAS unsigned*)((LAS unsigned char*)lds_raw + MISC_OFF) + 8);
#else
    XcdBarrier bar; bar.bar = nullptr; bar.x = 0u; bar.st = nullptr;
#endif
    if (KEN(0) && IN(0)) REP(0) { if (rep_) GRID_BAR(); const int L = 0; PHASE_ENV(); p0_prologue(F, args); } SEAM(0);

    layer_phases<KIND, 0>(lo, hi, bar, wave_s);
    layer_phases<KIND, 1>(lo, hi, bar, wave_s);
}

__global__ void dbg_bf16_out(const bf16_t* src, float* out, size_t n) { for (size_t i = (size_t)blockIdx.x * blockDim.x + threadIdx.x; i < n; i += (size_t)gridDim.x * blockDim.x) out[i] = bf2f(src[i]); }
__global__ void fill_const(float* out, int n, float v) { for (int i = blockIdx.x * blockDim.x + threadIdx.x; i < n; i += gridDim.x * blockDim.x) out[i] = v; }

typedef void (*kern_t)(Args);
static kern_t kernel_of_kind(int k) {
    switch (k) { case 0: return mk_fwd<0>; case 1: return mk_fwd<1>; case 2: return mk_fwd<2>; case 3: return mk_fwd<3>; case 4: return mk_fwd<4>; case 5: return mk_fwd<5>; case 6: return mk_fwd<6>;
                 case 7: return mk_fwd<7>; case 8: return mk_fwd<8>; case 9: return mk_fwd<9>; case 10: return mk_fwd<10>; case 11: return mk_fwd<11>; case 12: return mk_fwd<12>; default: return mk_fwd<13>; }
}
static const int kind_of_phase[NPHASE] = {0, 1, 2, 3, 4, 5, 6, 7, 8, 9, 1, 2, 3, 4, 5, 6, 10, 11, 12, 13};
extern "C" void kernel_launch(void* const* d_in, const int* in_sizes, int n_in, void* d_out, int out_size, void* d_ws, size_t ws_size, hipStream_t stream) {
    static int grid = 0;
    if (grid == 0) {
        int dev = 0, cus = 0; bool ok = true;
        if (hipGetDevice(&dev) != hipSuccess || hipDeviceGetAttribute(&cus, hipDeviceAttributeMultiprocessorCount, dev) != hipSuccess) { fprintf(stderr, "kernel_launch: device query failed\n"); ok = false; }
#if MK_PER_PHASE
        for (int k = 0; k < 14 && ok; ++k) if (hipFuncSetAttribute((const void*)kernel_of_kind(k), hipFuncAttributeMaxDynamicSharedMemorySize, LDS_BYTES) != hipSuccess) { fprintf(stderr, "kernel_launch: hipFuncSetAttribute failed\n"); ok = false; }
#else
        if (ok && hipFuncSetAttribute((const void*)mk_fwd<-1>, hipFuncAttributeMaxDynamicSharedMemorySize, LDS_BYTES) != hipSuccess) { fprintf(stderr, "kernel_launch: hipFuncSetAttribute failed\n"); ok = false; }
        if (ok) { int per_cu = 0; (void)hipOccupancyMaxActiveBlocksPerMultiprocessor(&per_cu, (const void*)mk_fwd<-1>, NTHREADS, LDS_BYTES); (void)hipGetLastError(); }
#endif
        grid = ok ? cus : -1;
    }
    if (grid < 0 || n_in != 28 || out_size != MTOK * DM || ws_size < WS_END) {
        fprintf(stderr, "kernel_launch: bad configuration (grid %d, n_in %d, out %d, ws %zu, need %zu)\n", grid, n_in, out_size, ws_size, (size_t)WS_END);
        hipLaunchKernelGGL(fill_const, dim3(1024), dim3(256), 0, stream, (float*)d_out, out_size, ws_size < WS_END ? 1000.0f : 100.0f);
        return;
    }
    (void)hipMemsetAsync((char*)d_ws + WS_CTL, 0, CTL_BYTES, stream);
    Args a{};
    for (int i = 0; i < 28; ++i) a.in[i] = d_in[i];
    a.out = (float*)d_out; a.ws = (unsigned char*)d_ws;
#if MK_PER_PHASE
#ifndef DBG_STOP_AFTER
#define DBG_STOP_AFTER (NPHASE - 1)
#endif
#ifndef DBG_REPEAT_PHASE
#define DBG_REPEAT_PHASE -1
#endif
    for (int p = 0; p <= DBG_STOP_AFTER; ++p) { a.ph_lo = p; a.ph_hi = p + 1; hipLaunchKernelGGL(kernel_of_kind(kind_of_phase[p]), dim3(grid), dim3(NTHREADS), LDS_BYTES, stream, a);
        if (p == DBG_REPEAT_PHASE) { (void)hipMemsetAsync((char*)d_ws + WS_CTL, 0, CTL_BYTES, stream); hipLaunchKernelGGL(kernel_of_kind(kind_of_phase[p]), dim3(grid), dim3(NTHREADS), LDS_BYTES, stream, a); } }
#ifdef DBG_BF16_OFF
    hipLaunchKernelGGL(dbg_bf16_out, dim3(2048), dim3(256), 0, stream, (const bf16_t*)((char*)d_ws + (DBG_BF16_OFF)), (float*)d_out, (size_t)MTOK * DM);
#endif
#ifdef DBG_COPY_OFF
    (void)hipMemcpyAsync(d_out, (char*)d_ws + (DBG_COPY_OFF), (size_t)MTOK * DM * 4, hipMemcpyDeviceToDevice, stream);
#endif
#else
    a.ph_lo = 0; a.ph_hi = NPHASE;
    hipLaunchKernelGGL(mk_fwd<-1>, dim3(grid), dim3(NTHREADS), LDS_BYTES, stream, a);
#endif
}
```
